# Optimizing an MI355X kernel written in HIP

```python
import jax, jax.numpy as jnp
from jax import lax
import numpy as np

D_MODEL = 4096
BATCH = 2
SEQ = 4096
DEPTH = 1
DEC_BATCH = 16
DEC_SEQ = 32
PAST_LEN = 1024

CHUNK = 64
N_PREV_CHUNKS = 8
BAND = N_PREV_CHUNKS * CHUNK
ATTN_WIDTH = D_MODEL // 2
LRU_WIDTH = D_MODEL - ATTN_WIDTH
HEAD_DIM = 128
N_HEADS = ATTN_WIDTH // HEAD_DIM
LRU_BLOCKS = 16
LRU_BLOCK = LRU_WIDTH // LRU_BLOCKS
CONV_W = 4
LRU_C = 8.0
REL_CLIP = 128
N_REL = 2 * REL_CLIP + 1
D_FF = -(-8 * D_MODEL // (3 * 256)) * 256
IN_COLS = 3 * ATTN_WIDTH + 2 * LRU_WIDTH
N_MOD = 6
NEG_INF = -1e30

kernel_name = "hymba_style_streaming_attn_rglru_encoder_step"


def rms_norm(x, g, eps=1e-6):
    xf = x.astype(jnp.float32)
    y = xf * lax.rsqrt(jnp.mean(xf * xf, axis=-1, keepdims=True) + eps)
    return (y * g.astype(jnp.float32)).astype(x.dtype)


def band_attention(q, k, v, q_pos, k_pos, k_valid, rel_bias):
    s = jnp.einsum("bqhd,bkhd->bhqk", q, k).astype(jnp.float32) * (HEAD_DIM ** -0.5)
    rel = jnp.clip(q_pos[:, None] - k_pos[None, :], -REL_CLIP, REL_CLIP) + REL_CLIP
    s = s + rel_bias[:, rel].astype(jnp.float32)[None]
    s = jnp.where(k_valid[None, None, None, :], s, NEG_INF)
    p = jax.nn.softmax(s, axis=-1).astype(v.dtype)
    return jnp.einsum("bhqk,bkhd->bqhd", p, v)


def prompt_attention(q, k, v, rel_bias):
    B, S = q.shape[0], q.shape[1]
    n_chunks = S // CHUNK
    span = BAND + CHUNK
    pad = ((0, 0), (BAND, 0), (0, 0), (0, 0))
    kp = jnp.pad(k, pad)
    vp = jnp.pad(v, pad)

    def one_chunk(ci):
        start = ci * CHUNK
        qc = lax.dynamic_slice_in_dim(q, start, CHUNK, axis=1)
        kc = lax.dynamic_slice_in_dim(kp, start, span, axis=1)
        vc = lax.dynamic_slice_in_dim(vp, start, span, axis=1)
        q_pos = start + jnp.arange(CHUNK)
        k_pos = start - BAND + jnp.arange(span)
        return band_attention(qc, kc, vc, q_pos, k_pos, k_pos >= 0, rel_bias)

    out = lax.map(one_chunk, jnp.arange(n_chunks))
    return jnp.moveaxis(out, 0, 1).reshape(q.shape)


def sample_attention(q, k_new, v_new, k_cache, v_cache, rel_bias):
    T = q.shape[1]
    R = k_cache.shape[1]
    k = jnp.concatenate([k_cache.astype(k_new.dtype), k_new], axis=1)
    v = jnp.concatenate([v_cache.astype(v_new.dtype), v_new], axis=1)
    q_pos = PAST_LEN + jnp.arange(T)
    k_pos = PAST_LEN - R + jnp.arange(R + T)
    return band_attention(q, k, v, q_pos, k_pos, k_pos >= 0, rel_bias)


def causal_conv(x, x_prev, w, b):
    T = x.shape[1]
    xc = jnp.concatenate([x_prev.astype(x.dtype), x], axis=1)
    y = b + sum(xc[:, i:i + T] * w[i] for i in range(CONV_W))
    return y, xc[:, -(CONV_W - 1):]


def rg_lru(x, h0, w_a, b_a, w_x, b_x, lam):
    B, T, _ = x.shape
    xb = x.reshape(B, T, LRU_BLOCKS, LRU_BLOCK)
    r = jax.nn.sigmoid(jnp.einsum("btni,nij->btnj", xb, w_a).reshape(B, T, LRU_WIDTH) + b_a)
    i = jax.nn.sigmoid(jnp.einsum("btni,nij->btnj", xb, w_x).reshape(B, T, LRU_WIDTH) + b_x)
    log_a = -LRU_C * r.astype(jnp.float32) * jax.nn.softplus(-lam.astype(jnp.float32))
    a = jnp.exp(log_a)
    b_in = jnp.sqrt(-jnp.expm1(2.0 * log_a)) * (i * x).astype(jnp.float32)
    b_in = b_in.at[:, 0].add(a[:, 0] * h0.astype(jnp.float32))

    def combine(left, right):
        a1, b1 = left
        a2, b2 = right
        return a1 * a2, a2 * b1 + b2

    _, h = lax.associative_scan(combine, (a, b_in), axis=1)
    return h.astype(x.dtype), h[:, -1].astype(x.dtype)


def hybrid_layer(x, c, k_cache, v_cache, conv_prev, h0, lw):
    (norm_mix_g, norm_ffn_g, w_mod, b_mod, w_in, q_norm_g, k_norm_g, rel_bias,
     conv_w, conv_b, w_rg_a, b_rg_a, w_rg_x, b_rg_x, lru_lambda, w_out,
     w_ffn_gate, w_ffn_up, w_ffn_down) = lw
    B, T, _ = x.shape
    mod = jax.nn.silu(c) @ w_mod + b_mod
    sh1, sc1, g1, sh2, sc2, g2 = jnp.split(mod[:, None, :], N_MOD, axis=-1)

    u = rms_norm(x, norm_mix_g) * (1 + sc1) + sh1
    z = u @ w_in
    q, k, v, xr, gr = jnp.split(
        z, [ATTN_WIDTH, 2 * ATTN_WIDTH, 3 * ATTN_WIDTH, 3 * ATTN_WIDTH + LRU_WIDTH], axis=-1)
    q = rms_norm(q.reshape(B, T, N_HEADS, HEAD_DIM), q_norm_g)
    k = rms_norm(k.reshape(B, T, N_HEADS, HEAD_DIM), k_norm_g)
    v = v.reshape(B, T, N_HEADS, HEAD_DIM)

    if k_cache is None:
        attn = prompt_attention(q, k, v, rel_bias)
        keep = min(BAND, T)
        k_state, v_state = k[:, -keep:], v[:, -keep:]
        conv_prev = jnp.zeros((B, CONV_W - 1, LRU_WIDTH), x.dtype)
        h0 = jnp.zeros((B, LRU_WIDTH), x.dtype)
    else:
        attn = sample_attention(q, k, v, k_cache, v_cache, rel_bias)
        k_state, v_state = k, v

    xc, conv_state = causal_conv(xr, conv_prev, conv_w, conv_b)
    hr, h_state = rg_lru(xc, h0, w_rg_a, b_rg_a, w_rg_x, b_rg_x, lru_lambda)
    lru_out = hr * jax.nn.gelu(gr)

    mix = jnp.concatenate([attn.reshape(B, T, ATTN_WIDTH), lru_out], axis=-1) @ w_out
    x = x + g1 * mix

    u2 = rms_norm(x, norm_ffn_g) * (1 + sc2) + sh2
    ff = (jax.nn.silu(u2 @ w_ffn_gate) * (u2 @ w_ffn_up)) @ w_ffn_down
    x = x + g2 * ff
    return x, k_state, v_state, conv_state, h_state


def setup_inputs(seed: int = 0) -> dict:
    key = jax.random.key(seed)
    ks = jax.random.split(key, 32)
    f32 = jnp.float32
    nrm = lambda k, shape, s: (jax.random.normal(k, shape, f32) * s).astype(f32)
    cache_rows = min(BAND, PAST_LEN)
    a0 = jax.random.uniform(ks[20], (DEPTH, LRU_WIDTH), f32, 0.9, 0.999)
    sig = a0 ** (1.0 / LRU_C)
    lam = jnp.log(sig) - jnp.log1p(-sig)
    return {
        "x_prompt": nrm(ks[0], (BATCH, SEQ, D_MODEL), 1.0),
        "x_sample": nrm(ks[1], (DEC_BATCH, DEC_SEQ, D_MODEL), 1.0),
        "cache_k": nrm(ks[2], (DEPTH, DEC_BATCH, cache_rows, N_HEADS, HEAD_DIM), 1.0),
        "cache_v": nrm(ks[3], (DEPTH, DEC_BATCH, cache_rows, N_HEADS, HEAD_DIM), 1.0),
        "state_conv": nrm(ks[4], (DEPTH, DEC_BATCH, CONV_W - 1, LRU_WIDTH), 1.0),
        "state_h": nrm(ks[5], (DEPTH, DEC_BATCH, LRU_WIDTH), 0.5),
        "c_prompt": nrm(ks[6], (BATCH, D_MODEL), 1.0),
        "c_sample": nrm(ks[7], (DEC_BATCH, D_MODEL), 1.0),
        "norm_mix_g": 1.0 + nrm(ks[8], (DEPTH, D_MODEL), 0.02),
        "norm_ffn_g": 1.0 + nrm(ks[9], (DEPTH, D_MODEL), 0.02),
        "w_mod": nrm(ks[10], (DEPTH, D_MODEL, N_MOD * D_MODEL), 0.3 * D_MODEL ** -0.5),
        "b_mod": nrm(ks[11], (DEPTH, N_MOD * D_MODEL), 0.1),
        "w_in": nrm(ks[12], (DEPTH, D_MODEL, IN_COLS), D_MODEL ** -0.5),
        "q_norm_g": 1.0 + nrm(ks[13], (DEPTH, HEAD_DIM), 0.02),
        "k_norm_g": 1.0 + nrm(ks[14], (DEPTH, HEAD_DIM), 0.02),
        "rel_bias": nrm(ks[15], (DEPTH, N_HEADS, N_REL), 0.1),
        "conv_w": nrm(ks[16], (DEPTH, CONV_W, LRU_WIDTH), 0.5),
        "conv_b": nrm(ks[17], (DEPTH, LRU_WIDTH), 0.01),
        "w_rg_a": nrm(ks[18], (DEPTH, LRU_BLOCKS, LRU_BLOCK, LRU_BLOCK), LRU_BLOCK ** -0.5),
        "b_rg_a": nrm(ks[19], (DEPTH, LRU_WIDTH), 0.01),
        "w_rg_x": nrm(ks[21], (DEPTH, LRU_BLOCKS, LRU_BLOCK, LRU_BLOCK), LRU_BLOCK ** -0.5),
        "b_rg_x": nrm(ks[22], (DEPTH, LRU_WIDTH), 0.01),
        "lru_lambda": lam,
        "w_out": nrm(ks[23], (DEPTH, D_MODEL, D_MODEL), D_MODEL ** -0.5),
        "w_ffn_gate": nrm(ks[24], (DEPTH, D_MODEL, D_FF), D_MODEL ** -0.5),
        "w_ffn_up": nrm(ks[25], (DEPTH, D_MODEL, D_FF), D_MODEL ** -0.5),
        "w_ffn_down": nrm(ks[26], (DEPTH, D_FF, D_MODEL), D_FF ** -0.5),
    }


def reference(x_prompt, x_sample, cache_k, cache_v, state_conv, state_h, c_prompt, c_sample,
              norm_mix_g, norm_ffn_g, w_mod, b_mod, w_in, q_norm_g, k_norm_g, rel_bias,
              conv_w, conv_b, w_rg_a, b_rg_a, w_rg_x, b_rg_x, lru_lambda, w_out,
              w_ffn_gate, w_ffn_up, w_ffn_down):
    yp, ys = x_prompt, x_sample
    kp_l, vp_l, cp_l, hp_l = [], [], [], []
    ks_l, vs_l, cs_l, hs_l = [], [], [], []
    for l in range(DEPTH):
        lw = (norm_mix_g[l], norm_ffn_g[l], w_mod[l], b_mod[l], w_in[l], q_norm_g[l], k_norm_g[l],
              rel_bias[l], conv_w[l], conv_b[l], w_rg_a[l], b_rg_a[l], w_rg_x[l], b_rg_x[l],
              lru_lambda[l], w_out[l], w_ffn_gate[l], w_ffn_up[l], w_ffn_down[l])
        yp, kp, vp, cp, hp = hybrid_layer(yp, c_prompt, None, None, None, None, lw)
        ys, k_s, v_s, c_s, h_s = hybrid_layer(ys, c_sample, cache_k[l], cache_v[l],
                                              state_conv[l], state_h[l], lw)
        kp_l.append(kp); vp_l.append(vp); cp_l.append(cp); hp_l.append(hp)
        ks_l.append(k_s); vs_l.append(v_s); cs_l.append(c_s); hs_l.append(h_s)
    return (yp, ys,
            jnp.stack(kp_l), jnp.stack(vp_l), jnp.stack(cp_l), jnp.stack(hp_l),
            jnp.stack(ks_l), jnp.stack(vs_l), jnp.stack(cs_l), jnp.stack(hs_l))
```

```cpp
#include <hip/hip_runtime.h>
#include <cstdio>
#include <cstdint>
namespace pg8 {
#define PG8_LAS __attribute__((address_space(3)))
typedef unsigned short bf16_t;
typedef short bf16x8 __attribute__((ext_vector_type(8)));
typedef float f32x4 __attribute__((ext_vector_type(4)));
typedef unsigned u32x4 __attribute__((ext_vector_type(4)));
typedef int i32x4 __attribute__((ext_vector_type(4)));
typedef int i32x8 __attribute__((ext_vector_type(8)));
constexpr int BM = 256, BK = 64, HALF = 128, HTB = HALF * BK * 2  , STAGE_BYTES = 8 * HTB, NXCD = 8, WGM = 8;

__host__ __device__ __forceinline__ int lds_byte(int r, int c) { const int st = (r >> 4) * 2 + (c >> 5), rr = r & 15, cc = c & 31, ob = rr * 64 + cc * 2; return st * 1024 + (ob ^ (((ob >> 9) & 1) << 5)); }
__host__ __device__ __forceinline__ void stage_rc(int b, int& R, int& C) { const int st = b / 1024, sb = b % 1024, swz = sb ^ (((sb >> 9) & 1) << 5); R = (st >> 1) * 16 + swz / 64; C = (st & 1) * 32 + (swz % 64) / 2; }
__host__ __device__ __forceinline__ int perm32(int rho) { const int n = rho >> 4, i = rho & 15; return 8 * (i >> 2) + 4 * n + (i & 3); }

struct Unit { int pm, pn, kb, nt, part; };
struct Gemm { const bf16_t* A; const bf16_t* Bt; int M, N, K; };

struct StaticOrder {
    int nM, nN, nwg, G, c, ntf;
    __host__ __device__ void init(int M, int N, int K, int G_, int c_) { nM = M / BM; nN = N / BM; nwg = nM * nN; G = G_; c = c_; ntf = K / BK; }
    __host__ __device__ bool next(int i, Unit& u) const {
        const long L = (long)i * G + c; if (L >= nwg) return false;
        int wgid = (int)L; { const int q = nwg / NXCD, r = nwg % NXCD, xcd = wgid % NXCD, off = wgid / NXCD; wgid = (xcd < r ? xcd * (q + 1) : r * (q + 1) + (xcd - r) * q) + off; }
        const int nig = WGM * nN, gid = wgid / nig, fm = gid * WGM, gsz = (nM - fm) < WGM ? (nM - fm) : WGM;
        u.pm = fm + ((wgid % nig) % gsz); u.pn = (wgid % nig) / gsz; u.kb = 0; u.nt = ntf; u.part = -1; return true;
    }
    __device__ __forceinline__ void a_ready(const Unit&) const {}
    __device__ __forceinline__ void done(const Unit&) const {}
};
__device__ __forceinline__ unsigned cvt_pk_bf16(float lo, float hi) { unsigned r; asm volatile("v_cvt_pk_bf16_f32 %0, %1, %2" : "=v"(r) : "v"(lo), "v"(hi)); return r; }
typedef float f32x2 __attribute__((ext_vector_type(2)));
#ifndef F8_DOWN
#define F8_DOWN true
#endif
constexpr float W8_SCALE = 512.f, W8_INV = 1.f / 512.f;
__device__ __forceinline__ unsigned pk4_fp8(float a, float b, float c, float d) {
    a = __builtin_amdgcn_fmed3f(a, -448.f, 448.f); b = __builtin_amdgcn_fmed3f(b, -448.f, 448.f); c = __builtin_amdgcn_fmed3f(c, -448.f, 448.f); d = __builtin_amdgcn_fmed3f(d, -448.f, 448.f);
    int w = __builtin_amdgcn_cvt_pk_fp8_f32(a, b, 0, false); w = __builtin_amdgcn_cvt_pk_fp8_f32(c, d, w, true); return (unsigned)w; }
__device__ __forceinline__ unsigned pk4_i8(float a, float b, float c, float d, float inv) {
    const unsigned ua = __builtin_bit_cast(unsigned, __builtin_fmaf(a, inv, 12582912.f)), ub = __builtin_bit_cast(unsigned, __builtin_fmaf(b, inv, 12582912.f)),
                   uc = __builtin_bit_cast(unsigned, __builtin_fmaf(c, inv, 12582912.f)), ud = __builtin_bit_cast(unsigned, __builtin_fmaf(d, inv, 12582912.f));
    return (ua & 0xffu) | ((ub & 0xffu) << 8) | ((uc & 0xffu) << 16) | (ud << 24); }
#ifndef PG8_KOUTER
#define PG8_KOUTER 1
#endif
template <class Epi, class Sched, bool ALIGN_EPI = false, bool SP2 = false, int VAR = 0, int QM = 0>
__device__ __forceinline__ void gemm_phase(PG8_LAS unsigned char* lds, const Gemm g, const Sched& S, const Epi& E) {
    const int tid = threadIdx.x, wid = __builtin_amdgcn_readfirstlane(tid >> 6), lane = tid & 63, wr = wid >> 2, wc = wid & 3, fr = lane & 15, fq = lane >> 4;
    const int K = g.K; int nt;
    unsigned voffA[2], voffB[2];
#pragma unroll
    for (int i = 0; i < 2; ++i) { int R, C; stage_rc(tid * 16 + i * 8192, R, C); const int Rb = Epi::PERM ? ((R & ~31) + perm32(R & 31)) : R;
        voffA[i] = (unsigned)(R * K + C) * 2u; voffB[i] = (unsigned)(Rb * K + C) * 2u; }
    const size_t kstep = (size_t)(BK * 2);
    const size_t hstep = (size_t)HALF * K * 2;
    const size_t tstep = 2 * hstep;
    const unsigned ldsw = (unsigned)wid * 1024u;
    const int aoff = lds_byte(wr * 64 + fr, fq * 8), boff = lds_byte(wc * 32 + fr, fq * 8);
#define PG8_SA(b, h) (((b) * 2 + (h)) * HTB)
#define PG8_SB(b, h) ((4 + (b) * 2 + (h)) * HTB)
#define PG8_STAGE(bufoff, gbase, voff) do { if constexpr (VAR != 3) { _Pragma("unroll") for (int _i = 0; _i < 2; ++_i) \
        __builtin_amdgcn_global_load_lds((const unsigned*)((const char*)(gbase) + (voff)[_i]), (PG8_LAS unsigned*)(lds + (bufoff) + ldsw + _i * 8192), 16, 0, 0); } } while (0)
#define PG8_LDA(dst, b, h) do { if constexpr (VAR != 2) _Pragma("unroll") for (int m = 0; m < 4; ++m) _Pragma("unroll") for (int k = 0; k < 2; ++k) dst[m][k] = *(const PG8_LAS bf16x8*)(lds + PG8_SA(b, h) + aoff + m * 2048 + k * 1024); } while (0)
#define PG8_LDB(dst, b, h) do { if constexpr (VAR != 2) _Pragma("unroll") for (int n = 0; n < 2; ++n) _Pragma("unroll") for (int k = 0; k < 2; ++k) dst[n][k] = *(const PG8_LAS bf16x8*)(lds + PG8_SB(b, h) + boff + n * 2048 + k * 1024); } while (0)
#define PG8_MMA(ai, bj, At, Bt) do { if constexpr (VAR != 5) __builtin_amdgcn_s_setprio(1); \
        if constexpr (QM == 2) { _Pragma("unroll") for (int k = 0; k < 2; ++k) _Pragma("unroll") for (int m = 0; m < 4; ++m) _Pragma("unroll") for (int n = 0; n < 2; ++n) \
            acc[ai][bj][m][n] = __builtin_bit_cast(f32x4, __builtin_amdgcn_mfma_i32_16x16x64_i8(__builtin_bit_cast(i32x4, Bt[n][k]), __builtin_bit_cast(i32x4, At[m][k]), __builtin_bit_cast(i32x4, acc[ai][bj][m][n]), 0, 0, 0)); } \
        else if constexpr (QM == 1) { _Pragma("unroll") for (int m = 0; m < 4; ++m) _Pragma("unroll") for (int n = 0; n < 2; ++n) \
            asm volatile("v_mfma_f32_16x16x128_f8f6f4 %0, %1, %2, %0" : "+v"(acc[ai][bj][m][n]) : "v"(__builtin_shufflevector(__builtin_bit_cast(i32x4, Bt[n][0]), __builtin_bit_cast(i32x4, Bt[n][1]), 0, 1, 2, 3, 4, 5, 6, 7)), \
                "v"(__builtin_shufflevector(__builtin_bit_cast(i32x4, At[m][0]), __builtin_bit_cast(i32x4, At[m][1]), 0, 1, 2, 3, 4, 5, 6, 7))); } \
        else if constexpr (VAR == 4 || (VAR == 0 && PG8_KOUTER)) { _Pragma("unroll") for (int k = 0; k < 2; ++k) _Pragma("unroll") for (int m = 0; m < 4; ++m) _Pragma("unroll") for (int n = 0; n < 2; ++n) \
            acc[ai][bj][m][n] = __builtin_amdgcn_mfma_f32_16x16x32_bf16(Bt[n][k], At[m][k], acc[ai][bj][m][n], 0, 0, 0); } \
        else { _Pragma("unroll") for (int m = 0; m < 4; ++m) _Pragma("unroll") for (int n = 0; n < 2; ++n) _Pragma("unroll") for (int k = 0; k < (VAR == 1 ? 1 : 2); ++k) \
            acc[ai][bj][m][n] = __builtin_amdgcn_mfma_f32_16x16x32_bf16(Bt[n][k], At[m][k], acc[ai][bj][m][n], 0, 0, 0); } \
        if constexpr (VAR != 5) __builtin_amdgcn_s_setprio(0); } while (0)
#define PG8_WAIT_V(n) asm volatile("s_waitcnt vmcnt(" #n ")" ::: "memory")
#define PG8_WAIT_L(n) asm volatile("s_waitcnt lgkmcnt(" #n ")" ::: "memory")
#define PG8_BAR __builtin_amdgcn_s_barrier()
#define PG8_SCHED __builtin_amdgcn_sched_barrier(0)
    Unit cur, nxt; int ui = 0;
    if (!S.next(0, cur)) return;
    nt = cur.nt;
    f32x4 acc[2][2][4][2];
#pragma unroll
    for (int a = 0; a < 2; ++a)
#pragma unroll
        for (int b = 0; b < 2; ++b)
#pragma unroll
            for (int m = 0; m < 4; ++m)
#pragma unroll
                for (int n = 0; n < 2; ++n) acc[a][b][m][n] = (f32x4){0.f, 0.f, 0.f, 0.f};
    bf16x8 At[4][2], B0[2][2], B1[2][2];
    const char* cA = (const char*)g.A + (size_t)cur.pm * tstep + (size_t)cur.kb * kstep; const char* cB = (const char*)g.Bt + (size_t)cur.pn * tstep + (size_t)cur.kb * kstep;
    S.a_ready(cur);
    if constexpr (SP2) {
        PG8_STAGE(PG8_SB(0, 0), cB, voffB); PG8_STAGE(PG8_SB(0, 1), cB + hstep, voffB); PG8_STAGE(PG8_SA(0, 0), cA, voffA); PG8_STAGE(PG8_SA(0, 1), cA + hstep, voffA);
        if (wr == 1) PG8_BAR;
        PG8_WAIT_V(2); PG8_BAR;
        PG8_STAGE(PG8_SB(1, 0), cB + kstep, voffB); PG8_STAGE(PG8_SA(1, 0), cA + kstep, voffA); PG8_STAGE(PG8_SB(1, 1), cB + hstep + kstep, voffB);
        PG8_WAIT_V(6); PG8_BAR;
    } else {
        PG8_STAGE(PG8_SB(0, 0), cB, voffB); PG8_STAGE(PG8_SA(0, 0), cA, voffA); PG8_STAGE(PG8_SB(0, 1), cB + hstep, voffB); PG8_STAGE(PG8_SA(0, 1), cA + hstep, voffA);
        if (wr == 1) PG8_BAR;
        PG8_WAIT_V(4); PG8_BAR;
        PG8_STAGE(PG8_SB(1, 0), cB + kstep, voffB); PG8_STAGE(PG8_SA(1, 0), cA + kstep, voffA); PG8_STAGE(PG8_SB(1, 1), cB + hstep + kstep, voffB);
        PG8_WAIT_V(6); PG8_BAR;
    }
    for (;;) {
        const bool has_next = S.next(ui + 1, nxt);
        const char* nA = has_next ? (const char*)g.A + (size_t)nxt.pm * tstep + (size_t)nxt.kb * kstep : cA; const char* nB = has_next ? (const char*)g.Bt + (size_t)nxt.pn * tstep + (size_t)nxt.kb * kstep : cB;
        for (int t = 0; t < nt; t += 2) {
            const bool last = (t == nt - 2);
            const char* a1 = cA + (size_t)(t + 1) * kstep;
            const char* a2 = last ? nA : cA + (size_t)(t + 2) * kstep; const char* b2 = last ? nB : cB + (size_t)(t + 2) * kstep;
            const char* a3 = a2 + kstep; const char* b3 = b2 + kstep;
            if (last && has_next) S.a_ready(nxt);
            if constexpr (SP2) {
            PG8_LDB(B0, 0, 0); PG8_LDB(B1, 0, 1); PG8_SCHED; PG8_LDA(At, 0, 0); PG8_STAGE(PG8_SA(1, 1), a1 + hstep, voffA);
            PG8_WAIT_V(8); PG8_WAIT_L(0); PG8_BAR; PG8_MMA(0, 0, At, B0); PG8_MMA(0, 1, At, B1); PG8_BAR; PG8_SCHED;
            PG8_LDA(At, 0, 1); PG8_STAGE(PG8_SB(0, 0), b2, voffB); PG8_STAGE(PG8_SB(0, 1), b2 + hstep, voffB); PG8_STAGE(PG8_SA(0, 0), a2, voffA);
            PG8_WAIT_V(8); PG8_WAIT_L(0); PG8_BAR; PG8_MMA(1, 0, At, B0); PG8_MMA(1, 1, At, B1); PG8_BAR; PG8_SCHED;
            PG8_LDB(B0, 1, 0); PG8_LDB(B1, 1, 1); PG8_SCHED; PG8_LDA(At, 1, 0); PG8_STAGE(PG8_SA(0, 1), a2 + hstep, voffA);
            PG8_WAIT_V(8); PG8_WAIT_L(0); PG8_BAR; PG8_MMA(0, 0, At, B0); PG8_MMA(0, 1, At, B1); PG8_BAR; PG8_SCHED;
            PG8_LDA(At, 1, 1); PG8_STAGE(PG8_SB(1, 0), b3, voffB); PG8_STAGE(PG8_SB(1, 1), b3 + hstep, voffB); PG8_STAGE(PG8_SA(1, 0), a3, voffA);
            PG8_WAIT_V(8); PG8_WAIT_L(0); PG8_BAR; PG8_MMA(1, 0, At, B0); PG8_MMA(1, 1, At, B1); PG8_BAR; PG8_SCHED;
            } else {
            PG8_LDB(B0, 0, 0); PG8_SCHED; PG8_LDA(At, 0, 0); PG8_STAGE(PG8_SA(1, 1), a1 + hstep, voffA);
            PG8_WAIT_L(8); PG8_BAR; PG8_WAIT_L(0); PG8_MMA(0, 0, At, B0); PG8_BAR; PG8_SCHED;
            PG8_LDB(B1, 0, 1); PG8_STAGE(PG8_SB(0, 0), b2, voffB);
            PG8_BAR; PG8_WAIT_L(0); PG8_MMA(0, 1, At, B1); PG8_BAR;
            PG8_LDA(At, 0, 1); PG8_STAGE(PG8_SA(0, 0), a2, voffA);
            PG8_BAR; PG8_WAIT_L(0); PG8_MMA(1, 0, At, B0); PG8_BAR; PG8_SCHED;
            PG8_STAGE(PG8_SB(0, 1), b2 + hstep, voffB);
            PG8_WAIT_V(6); PG8_BAR; PG8_MMA(1, 1, At, B1); PG8_BAR;
            PG8_LDB(B0, 1, 0); PG8_SCHED; PG8_LDA(At, 1, 0); PG8_STAGE(PG8_SA(0, 1), a2 + hstep, voffA);
            PG8_WAIT_L(8); PG8_BAR; PG8_WAIT_L(0); PG8_MMA(0, 0, At, B0); PG8_BAR; PG8_SCHED;
            PG8_LDB(B1, 1, 1); PG8_STAGE(PG8_SB(1, 0), b3, voffB);
            PG8_BAR; PG8_WAIT_L(0); PG8_MMA(0, 1, At, B1); PG8_BAR;
            PG8_LDA(At, 1, 1); PG8_STAGE(PG8_SA(1, 0), a3, voffA);
            PG8_BAR; PG8_WAIT_L(0); PG8_MMA(1, 0, At, B0); PG8_BAR; PG8_SCHED;
            PG8_STAGE(PG8_SB(1, 1), b3 + hstep, voffB);
            PG8_WAIT_V(6); PG8_BAR; PG8_MMA(1, 1, At, B1); PG8_BAR;
            }
        }
        if constexpr (ALIGN_EPI) { if (wr == 0) PG8_BAR; }
        if constexpr (QM == 1) { PG8_SCHED; asm volatile("s_nop 15\n\ts_nop 7" ::: "memory"); PG8_SCHED; }
        if constexpr (!Epi::AFTER_DRAIN) { E(acc, cur, wr, wc, fr, fq); S.done(cur); }
        if (!has_next) break;
#pragma unroll
        for (int a = 0; a < 2; ++a)
#pragma unroll
            for (int b = 0; b < 2; ++b)
#pragma unroll
                for (int m = 0; m < 4; ++m)
#pragma unroll
                    for (int n = 0; n < 2; ++n) acc[a][b][m][n] = (f32x4){0.f, 0.f, 0.f, 0.f};
        cur = nxt; cA = nA; cB = nB; ++ui; nt = cur.nt;
        if constexpr (ALIGN_EPI) { if (wr == 1) PG8_BAR; }
    }
    PG8_WAIT_V(0);
    if constexpr (!ALIGN_EPI) { if (wr == 0) PG8_BAR; }
    PG8_BAR;
    if constexpr (Epi::AFTER_DRAIN) { E.fused(acc, cur, wr, wc, fr, fq, lds, wid, lane); S.done(cur); }
#undef PG8_SA
#undef PG8_SB
#undef PG8_STAGE
#undef PG8_LDA
#undef PG8_LDB
#undef PG8_MMA
#undef PG8_WAIT_V
#undef PG8_WAIT_L
#undef PG8_BAR
#undef PG8_SCHED
}
}
constexpr int D = 4096, T = 4096, NB = 2, NPR = NB * T, SB = 16, ST = 32, NSA = SB * ST, NTOK = NPR + NSA;
constexpr int NSEQ = NB + SB, AW = 2048, LW = 2048, HD = 128, NH = 16, DFF = 11008, INC = 10240, NMOD = 6 * D;
constexpr int CROWS = 512, KS_LD = 544;
constexpr float RMS_EPS = 1e-6f;
constexpr float QSCALE = 0.08838834764831845f * 1.4426950408889634f;
constexpr float LOG2E = 1.4426950408889634f;
constexpr size_t O_Y = 0, O_KP = (size_t)NTOK * D, O_VP = O_KP + (size_t)NB * 512 * AW, O_CP = O_VP + (size_t)NB * 512 * AW, O_HP = O_CP + (size_t)NB * 3 * LW,
                 O_KS = O_HP + (size_t)NB * LW, O_VS = O_KS + (size_t)NSA * AW, O_CS = O_VS + (size_t)NSA * AW, O_HS = O_CS + (size_t)SB * 3 * LW, O_END = O_HS + (size_t)SB * LW;
static_assert(O_END == 42090496, "output size");
constexpr size_t MiB = 1u << 20;
constexpr size_t WS_CTL = 0, CTL_ZERO_BYTES = 32768 + 90112, WS_AMAX = 32768  , WS_SU = 131072  ;
constexpr size_t WS_MOD = 1 * MiB, WS_LSUM = 3 * MiB, WS_WRG = 5 * MiB, WS_WIN = 6 * MiB, WS_WOUT = 86 * MiB, WS_WGU = 118 * MiB, WS_WD = 290 * MiB, WS_U = 376 * MiB,
                 WS_Q = 444 * MiB, WS_K = 478 * MiB, WS_KC = 512 * MiB, WS_VTP = 544 * MiB, WS_VTS = 576 * MiB, WS_XR = 610 * MiB, WS_GG = 678 * MiB, WS_MIX = 712 * MiB,
                 WS_X1 = 780 * MiB, WS_H = 916 * MiB, WS_END = 1099 * MiB;
static_assert(WS_H + (size_t)NTOK * DFF * 2 <= WS_END && WS_X1 + (size_t)NTOK * D * 4 <= WS_H && WS_WGU + (size_t)2 * DFF * D * 2 <= WS_WD && WS_WD + (size_t)D * DFF * 2 <= WS_U, "d_ws map");
constexpr size_t WS_AB = WS_END;
constexpr size_t WS_END2 = WS_END + 128 * MiB;
constexpr size_t WS_SLAB = WS_Q;
static_assert(WS_SLAB + (size_t)8 * NSA * D * 4 <= WS_KC, "slab overlay");
static_assert((4096 + 3456) * 4 <= 32768, "control words inside the zeroed region");
constexpr int CW_BAR = 4096, CW_ARRIVE = 64, CW_LQ = 128, CW_TMO2 = 192;
constexpr int RING_BYTES = 131072;
constexpr int XCH_OFF = RING_BYTES;
constexpr int MISC_OFF = XCH_OFF + 8192;
constexpr int LDS_BYTES = 147456;

#define LAS __attribute__((address_space(3)))
typedef unsigned short bf16;
typedef float f32x4 __attribute__((ext_vector_type(4)));
typedef float f32x2 __attribute__((ext_vector_type(2)));
typedef short bf16x8 __attribute__((ext_vector_type(8)));
typedef unsigned u32x4 __attribute__((ext_vector_type(4)));
typedef unsigned u32x2 __attribute__((ext_vector_type(2)));
using pg8::cvt_pk_bf16; using pg8::pk4_fp8; using pg8::pk4_i8; using pg8::W8_SCALE; using pg8::W8_INV;
#define LDS_WAIT() asm volatile("s_waitcnt lgkmcnt(0)" ::: "memory")
#define VM_WAIT() asm volatile("s_waitcnt vmcnt(0)" ::: "memory")

__device__ __forceinline__ float fast_sigmoid(float x) { return __builtin_amdgcn_rcpf(1.0f + __builtin_amdgcn_exp2f(-LOG2E * x)); }
__device__ __forceinline__ float gelu_tanh(float x) { return x * __builtin_amdgcn_rcpf(1.0f + __builtin_amdgcn_exp2f(-2.302208198f * (x + 0.044715f * x * x * x))); }

__device__ __forceinline__ float xrow16_max(float x) {
    auto s = __builtin_amdgcn_permlane16_swap(__float_as_uint(x), __float_as_uint(x), false, false); x = fmaxf(__uint_as_float(s[0]), __uint_as_float(s[1]));
    auto t = __builtin_amdgcn_permlane32_swap(__float_as_uint(x), __float_as_uint(x), false, false); return fmaxf(__uint_as_float(t[0]), __uint_as_float(t[1]));
}
__device__ __forceinline__ float xrow16_sum(float x) {
    auto s = __builtin_amdgcn_permlane16_swap(__float_as_uint(x), __float_as_uint(x), false, false); x = __uint_as_float(s[0]) + __uint_as_float(s[1]);
    auto t = __builtin_amdgcn_permlane32_swap(__float_as_uint(x), __float_as_uint(x), false, false); return __uint_as_float(t[0]) + __uint_as_float(t[1]);
}
struct EpiIn {
    static constexpr bool PERM = true, AFTER_DRAIN = false;
    bf16* Q; bf16* K; bf16* VtP; bf16* VtS; float* XR; bf16* GG; float* out; const float* qg; const float* kg; LAS float* xch;
    __device__ __forceinline__ void operator()(const f32x4 (&acc)[2][2][4][2], const pg8::Unit& u, int wr, int wc, int fr, int fq) const {
        asm volatile("" : "+v"(fr), "+v"(fq));
        const int region = u.pn >> 3, pl = u.pn & 7;
        const int rl0 = wr * 64 + fr, cl0 = wc * 32 + 8 * fq;
        const bool prompt = u.pm < 32;
        const int pb = u.pm >> 4, pt0 = (u.pm & 15) * 256, s0 = (u.pm - 32) * 256;
#ifndef RMASK
#define RMASK 31
#endif
        if ((RMASK & 3) && region < 2) {
#pragma unroll
            for (int ai = 0; ai < 2; ++ai)
#pragma unroll
                for (int m = 0; m < 4; ++m)
#pragma unroll
                    for (int bj = 0; bj < 2; ++bj) {
                        const f32x4 a = acc[ai][bj][m][0], b = acc[ai][bj][m][1];
                        float s = (a[0] * a[0] + a[1] * a[1]) + (a[2] * a[2] + a[3] * a[3]) + (b[0] * b[0] + b[1] * b[1]) + (b[2] * b[2] + b[3] * b[3]);
                        s = xrow16_sum(s);
                        if (fq == 0) xch[((ai * 128 + m * 16 + rl0) * 2 + bj) * 4 + wc] = s;
                    }
            asm volatile("s_waitcnt lgkmcnt(0)" ::: "memory"); __builtin_amdgcn_s_barrier(); asm volatile("" ::: "memory");
            const float* gp = (region == 0 ? qg : kg) + cl0;
            const float osc = region == 0 ? QSCALE : 1.0f;
            const f32x4 g0 = *(const f32x4*)gp * osc, g1 = *(const f32x4*)(gp + 4) * osc;
            bf16* dst = region == 0 ? Q : K;
            const bool newk = (region == 1) && (!prompt || (u.pm & 15) >= 14);
            float* ok = prompt ? out + O_KP + (size_t)(pb * 512 + pt0 - 3584) * AW : out + O_KS + (size_t)s0 * AW;
#pragma unroll
            for (int ai = 0; ai < 2; ++ai)
#pragma unroll
                for (int m = 0; m < 4; ++m) {
                    const int rl = ai * 128 + m * 16 + rl0; const size_t mrow = (size_t)u.pm * 256 + rl;
#pragma unroll
                    for (int bj = 0; bj < 2; ++bj) {
                        const f32x4 p = *(const LAS f32x4*)&xch[(rl * 2 + bj) * 4];
                        const float rs = __builtin_amdgcn_rsqf(((p[0] + p[1]) + (p[2] + p[3])) * (1.0f / 128.0f) + RMS_EPS);
                        const f32x4 v0 = acc[ai][bj][m][0] * rs * g0, v1 = acc[ai][bj][m][1] * rs * g1;
                        const int col = (pl * 2 + bj) * 128 + cl0;
                        u32x4 w; w.x = cvt_pk_bf16(v0[0], v0[1]); w.y = cvt_pk_bf16(v0[2], v0[3]); w.z = cvt_pk_bf16(v1[0], v1[1]); w.w = cvt_pk_bf16(v1[2], v1[3]);
                        const size_t hidx = prompt ? ((size_t)(pb * NH + pl * 2 + bj) * T + pt0 + rl) * HD + cl0 : (size_t)NPR * AW + ((size_t)(((s0 + rl) >> 5) * NH + pl * 2 + bj) * ST + ((s0 + rl) & 31)) * HD + cl0;
                        *(u32x4*)(dst + hidx) = w;
                        if (newk) { float* o = ok + (size_t)rl * AW + col; *(f32x4*)o = v0; *(f32x4*)(o + 4) = v1; }
                    }
                    asm volatile("" ::: "memory");
                }
        } else if ((RMASK & 4) && region == 2) {
            const bool newv = !prompt || (u.pm & 15) >= 14;
            float* ov = prompt ? out + O_VP + (size_t)(pb * 512 + pt0 - 3584) * AW : out + O_VS + (size_t)s0 * AW;
#pragma unroll
            for (int bj = 0; bj < 2; ++bj) {
                const int h = pl * 2 + bj;
#pragma unroll
                for (int n = 0; n < 2; ++n)
#pragma unroll
                    for (int j = 0; j < 4; j += 2) {
                        const int d = cl0 + 4 * n + j;
                        if (prompt) {
                            bf16* p0 = VtP + (((size_t)(pb * NH + h) * (T / 32) + (pt0 >> 5)) * HD + d) * 32 + (rl0 & 31) + (size_t)(rl0 >> 5) * (HD * 32);
#pragma unroll
                            for (int ai = 0; ai < 2; ++ai)
#pragma unroll
                                for (int m = 0; m < 4; ++m) { const unsigned w = cvt_pk_bf16(acc[ai][bj][m][n][j], acc[ai][bj][m][n][j + 1]); bf16* q0 = p0 + (ai * 4 + (m >> 1)) * (HD * 32) + (m & 1) * 16; q0[0] = (bf16)(w & 0xffffu); q0[32] = (bf16)(w >> 16); }
                        } else {
#pragma unroll
                            for (int ai = 0; ai < 2; ++ai)
#pragma unroll
                                for (int m = 0; m < 4; ++m) { const int s = s0 + ai * 128 + m * 16 + rl0; bf16* q0 = VtS + (((size_t)((s >> 5) * NH + h) * (KS_LD / 32) + CROWS / 32) * HD + d) * 32 + (s & 31);
                                    const unsigned w = cvt_pk_bf16(acc[ai][bj][m][n][j], acc[ai][bj][m][n][j + 1]); q0[0] = (bf16)(w & 0xffffu); q0[32] = (bf16)(w >> 16); }
                        }
                    }
            }
            if (newv) {
#pragma unroll
                for (int ai = 0; ai < 2; ++ai)
#pragma unroll
                    for (int m = 0; m < 4; ++m) { const int rl = ai * 128 + m * 16 + rl0;
#pragma unroll
                        for (int bj = 0; bj < 2; ++bj) { float* o = ov + (size_t)rl * AW + (pl * 2 + bj) * 128 + cl0; *(f32x4*)o = acc[ai][bj][m][0]; *(f32x4*)(o + 4) = acc[ai][bj][m][1]; } }
            }
        } else if ((RMASK & 8) && region == 3) {
#pragma unroll
            for (int ai = 0; ai < 2; ++ai)
#pragma unroll
                for (int m = 0; m < 4; ++m) { const int rl = ai * 128 + m * 16 + rl0; const size_t mrow = (size_t)u.pm * 256 + rl;
                    int ci = -1; float* oc = out;
                    if (prompt) { if ((u.pm & 15) == 15 && rl >= 253) { ci = rl - 253; oc = out + O_CP + (size_t)(pb * 3 + ci) * LW; } }
                    else { const int s = s0 + rl; if ((s & 31) >= 29) { ci = (s & 31) - 29; oc = out + O_CS + (size_t)((s >> 5) * 3 + ci) * LW; } }
#pragma unroll
                    for (int bj = 0; bj < 2; ++bj) { const int col = pl * 256 + bj * 128 + cl0; float* o = XR + mrow * LW + col; *(f32x4*)o = acc[ai][bj][m][0]; *(f32x4*)(o + 4) = acc[ai][bj][m][1];
                        if (ci >= 0) { *(f32x4*)(oc + col) = acc[ai][bj][m][0]; *(f32x4*)(oc + col + 4) = acc[ai][bj][m][1]; } } }
        } else if (RMASK & 16) {
#pragma unroll
            for (int ai = 0; ai < 2; ++ai)
#pragma unroll
                for (int m = 0; m < 4; ++m) { const size_t mrow = (size_t)u.pm * 256 + ai * 128 + m * 16 + rl0;
#pragma unroll
                    for (int bj = 0; bj < 2; ++bj) { const f32x4 a = acc[ai][bj][m][0], b = acc[ai][bj][m][1];
                        u32x4 w; w.x = cvt_pk_bf16(a[0], a[1]); w.y = cvt_pk_bf16(a[2], a[3]); w.z = cvt_pk_bf16(b[0], b[1]); w.w = cvt_pk_bf16(b[2], b[3]);
                        *(u32x4*)(GG + mrow * LW + pl * 256 + bj * 128 + cl0) = w; } }
        }
    }
};
struct SplitOrder {
    pg8::StaticOrder full; int G, c, np;
    __device__ __forceinline__ void init(int K, int G_, int c_) { full.init(NPR, D, K, G_, c_); G = G_; c = c_; np = K / 128; }
    __device__ __forceinline__ bool next(int i, pg8::Unit& u) const {
        const int L = i * G + c;
        if (L < full.nwg) return full.next(i, u);
        const int j = L - full.nwg; if (j >= 256) return false;
        const int tile = j >> 3, part = j & 7, base = np >> 3, rem = np & 7;
        u.pm = 32 + (tile >> 4); u.pn = tile & 15; u.kb = 2 * (part * base + (part < rem ? part : rem)); u.nt = 2 * (base + (part < rem ? 1 : 0)); u.part = part; return true;
    }
    __device__ __forceinline__ void a_ready(const pg8::Unit&) const {}
    __device__ __forceinline__ void done(const pg8::Unit&) const {}
};
struct InOrder {
    pg8::StaticOrder full; int G, c, mode;
    __device__ __forceinline__ void init(int G_, int c_) { full.init(NPR, INC, D, G_, c_); G = G_; c = c_; mode = 0; }
    __device__ __forceinline__ bool next(int i, pg8::Unit& u) const {
        if (mode == 0) return full.next(i, u);
        const int L = i * G + c; if (L >= 2 * (INC / 256)) return false;
        u.pm = 32 + L / (INC / 256); u.pn = L % (INC / 256); u.kb = 0; u.nt = D / 64; u.part = -1; return true;
    }
    __device__ __forceinline__ void a_ready(const pg8::Unit&) const {}
    __device__ __forceinline__ void done(const pg8::Unit&) const {}
};
struct GluOrder {
    pg8::StaticOrder full; int G, c, mode;
    __device__ __forceinline__ void init(int K, int G_, int c_) { full.init(NPR, 2 * DFF, K, G_, c_); G = G_; c = c_; mode = 0; }
    __device__ __forceinline__ bool next(int i, pg8::Unit& u) const {
        if (mode == 0) return full.next(i, u);
        const int cc = (G == 256) ? ((c + 256 - 84) & 255) : c, L = i * G + cc; if (L >= 2 * (2 * DFF / 256)) return false;
        u.pm = 32 + L / (2 * DFF / 256); u.pn = L % (2 * DFF / 256); u.kb = 0; u.nt = full.ntf; u.part = -1; return true;
    }
    __device__ __forceinline__ void a_ready(const pg8::Unit&) const {}
    __device__ __forceinline__ void done(const pg8::Unit&) const {}
};
struct TailSplit {
    int rank, nrank, np;
    __device__ __forceinline__ void init(int K, int G, int c) { np = K / 128; if (G == 256) { rank = c < 84 ? c : (c >= 192 ? 84 + (c - 192) : -1); nrank = 148; } else { rank = c; nrank = G; } }
    __device__ __forceinline__ bool next(int i, pg8::Unit& u) const {
        if (rank < 0) return false;
        const int j = rank + i * nrank; if (j >= 256) return false;
        const int tile = j >> 3, part = j & 7, base = np >> 3, rem = np & 7;
        u.pm = 32 + (tile >> 4); u.pn = tile & 15; u.kb = 2 * (part * base + (part < rem ? part : rem)); u.nt = 2 * (base + (part < rem ? 1 : 0)); u.part = part; return true;
    }
    __device__ __forceinline__ void a_ready(const pg8::Unit&) const {}
    __device__ __forceinline__ void done(const pg8::Unit&) const {}
};
template <bool BASE_BF16, bool OUT_BF16> struct EpiRes {
    static constexpr bool PERM = false, AFTER_DRAIN = false;
    const void* base; void* outp; const float* gate; float* slab; int probe_skip; float wsc;
    __device__ __forceinline__ void operator()(const f32x4 (&acc)[2][2][4][2], const pg8::Unit& u, int wr, int wc, int fr, int fq) const {
        asm volatile("" : "+v"(fr), "+v"(fq));
        const int col0 = u.pn * 256 + wc * 32 + 4 * fq;
        if (probe_skip) return;
        if (u.part < 0) {
            const float* gp = gate + (size_t)(u.pm >> 4) * NMOD + col0;
            f32x4 gv[2][2];
#pragma unroll
            for (int bj = 0; bj < 2; ++bj)
#pragma unroll
                for (int n = 0; n < 2; ++n) gv[bj][n] = *(const f32x4*)(gp + bj * 128 + n * 16) * wsc;
#pragma unroll
            for (int ai = 0; ai < 2; ++ai) {
                const size_t row0 = (size_t)u.pm * 256 + ai * 128 + wr * 64 + fr;
                f32x4 bs[4][2][2]; u32x2 bw[4][2][2];
#pragma unroll
                for (int m = 0; m < 4; ++m)
#pragma unroll
                    for (int bj = 0; bj < 2; ++bj)
#pragma unroll
                        for (int n = 0; n < 2; ++n) { const size_t off = (row0 + m * 16) * D + col0 + bj * 128 + n * 16;
                            if (BASE_BF16) bw[m][bj][n] = *(const u32x2*)((const bf16*)base + off); else bs[m][bj][n] = *(const f32x4*)((const float*)base + off); }
#pragma unroll
                for (int m = 0; m < 4; ++m)
#pragma unroll
                    for (int bj = 0; bj < 2; ++bj)
#pragma unroll
                        for (int n = 0; n < 2; ++n) { const size_t off = (row0 + m * 16) * D + col0 + bj * 128 + n * 16;
                            f32x4 bsv;
                            if (BASE_BF16) { const u32x2 w = bw[m][bj][n]; bsv = (f32x4){__uint_as_float(w.x << 16), __uint_as_float(w.x & 0xffff0000u), __uint_as_float(w.y << 16), __uint_as_float(w.y & 0xffff0000u)}; }
                            else bsv = bs[m][bj][n];
                            const f32x4 o = bsv + gv[bj][n] * acc[ai][bj][m][n];
                            if (OUT_BF16) { u32x2 w; w.x = cvt_pk_bf16(o[0], o[1]); w.y = cvt_pk_bf16(o[2], o[3]); *(u32x2*)((bf16*)outp + off) = w; }
                            else __builtin_nontemporal_store(o, (f32x4*)((float*)outp + off)); }
                asm volatile("" ::: "memory");
            }
        } else {
#pragma unroll
            for (int ai = 0; ai < 2; ++ai)
#pragma unroll
                for (int m = 0; m < 4; ++m) {
                    const int rl = ai * 128 + wr * 64 + m * 16 + fr; const size_t mrow = (size_t)u.pm * 256 + rl;
                    const int seq = NB + (((u.pm - 32) * 256 + rl) >> 5);
                    const float* gp = gate + (size_t)seq * NMOD;
#pragma unroll
                    for (int bj = 0; bj < 2; ++bj)
#pragma unroll
                        for (int n = 0; n < 2; ++n) { const int c = col0 + bj * 128 + n * 16; *(f32x4*)(slab + ((size_t)u.part * NSA + (mrow - NPR)) * D + c) = *(const f32x4*)(gp + c) * wsc * acc[ai][bj][m][n]; }
                    if (m & 1) asm volatile("" ::: "memory");
                }
        }
    }
};
template <int QM> struct EpiGlu {
    static constexpr bool PERM = true, AFTER_DRAIN = false;
    bf16* H; float wsc; const float* su; const float* sw;
    __device__ __forceinline__ void operator()(const f32x4 (&acc)[2][2][4][2], const pg8::Unit& u, int wr, int wc, int fr, int fq) const {
        asm volatile("" : "+v"(fr), "+v"(fq));
        const int col = u.pn * 128 + wc * 32 + 8 * fq;
        f32x4 sg[2], sp[2]; float rs[2][4];
        if (QM == 2) { const float* p = sw + u.pn * 256 + wc * 32 + 8 * fq; sg[0] = *(const f32x4*)p * (1.f / 127.f); sg[1] = *(const f32x4*)(p + 4) * (1.f / 127.f); sp[0] = *(const f32x4*)(p + 128) * (1.f / 127.f); sp[1] = *(const f32x4*)(p + 132) * (1.f / 127.f);
#pragma unroll
            for (int ai = 0; ai < 2; ++ai)
#pragma unroll
                for (int m = 0; m < 4; ++m) rs[ai][m] = su[(size_t)u.pm * 256 + ai * 128 + wr * 64 + m * 16 + fr]; }
#pragma unroll
        for (int ai = 0; ai < 2; ++ai)
#pragma unroll
            for (int m = 0; m < 4; ++m) { const size_t mrow = (size_t)u.pm * 256 + ai * 128 + wr * 64 + m * 16 + fr;
                f32x4 v[2];
#pragma unroll
                for (int n = 0; n < 2; ++n) { f32x4 g, up;
                    if (QM == 2) {
#pragma unroll
                        for (int j = 0; j < 4; ++j) { const float ga = acc[ai][0][m][n][j], ua = acc[ai][1][m][n][j];
                            g[j] = (float)__builtin_bit_cast(int, ga) * (rs[ai][m] * sg[n][j]); up[j] = (float)__builtin_bit_cast(int, ua) * (rs[ai][m] * sp[n][j]); } }
                    else { g = acc[ai][0][m][n] * wsc; up = acc[ai][1][m][n] * wsc; }
#pragma unroll
                    for (int j = 0; j < 4; ++j) v[n][j] = g[j] * fast_sigmoid(g[j]) * up[j]; }
                if (F8_DOWN) { u32x2 w; w.x = pk4_fp8(v[0][0], v[0][1], v[0][2], v[0][3]); w.y = pk4_fp8(v[1][0], v[1][1], v[1][2], v[1][3]); *(u32x2*)((unsigned char*)H + mrow * DFF + col) = w; }
                else { u32x4 w; w.x = cvt_pk_bf16(v[0][0], v[0][1]); w.y = cvt_pk_bf16(v[0][2], v[0][3]); w.z = cvt_pk_bf16(v[1][0], v[1][1]); w.w = cvt_pk_bf16(v[1][2], v[1][3]);
                    *(u32x4*)(H + mrow * DFF + col) = w; } }
    }
};
#define XB_TMO      128
#define XB_XCNT(j)  (256  + 64 * (j))
#define XB_XSUB(j)  (1280 + 64 * (j))
#define XB_XGEN(j)  (2304 + 64 * (j))
#define XB_TOP      3328
#define XB_TOPGEN   3392
#define XCD_BAR_WORDS 3456
#define XB_SPIN_CAP (1u << 18)
#define LAS __attribute__((address_space(3)))

__device__ __forceinline__ unsigned xb_ld(unsigned* p)              { return __hip_atomic_load(p, __ATOMIC_RELAXED, __HIP_MEMORY_SCOPE_AGENT); }
__device__ __forceinline__ unsigned xb_add(unsigned* p, unsigned v) { return __hip_atomic_fetch_add(p, v, __ATOMIC_RELAXED, __HIP_MEMORY_SCOPE_AGENT); }
__device__ __forceinline__ unsigned xb_xcc_id() { return (unsigned)__builtin_amdgcn_s_getreg((3 << 11) | 20) & 0xFu; }
#define XB_SPIN(cond, bar) do { unsigned _sp = 0; while (cond) { __builtin_amdgcn_s_sleep(1); \
    if ((++_sp & 255u) == 0u) { if (xb_ld(&(bar)[XB_TMO])) break; if (_sp > XB_SPIN_CAP) { atomicAdd(&(bar)[XB_TMO], 1u); break; } } } } while (0)

struct XcdBarrier {
    unsigned* bar; unsigned x;
    volatile LAS unsigned* st;
};

__device__ __forceinline__ XcdBarrier xcd_barrier_post(unsigned* bar, volatile LAS unsigned* st) {
    XcdBarrier b; b.bar = bar; b.x = xb_xcc_id(); b.st = st;
    if (threadIdx.x == 0) (void)xb_add(&bar[XB_XCNT(b.x)], 1u);
    return b;
}
__device__ __forceinline__ void xcd_barrier_complete(unsigned* bar, unsigned x, unsigned& nloc, unsigned& nx) {
    const unsigned G = gridDim.x * gridDim.y * gridDim.z;
    unsigned sum, cnt, mine, sp = 0u;
    for (;;) {
        sum = 0u; cnt = 0u; mine = 0u;
#pragma unroll
        for (unsigned j = 0; j < 16; ++j) { const unsigned c = xb_ld(&bar[XB_XCNT(j)]); sum += c; cnt += (c > 0u) ? 1u : 0u; mine = (j == x) ? c : mine; }
        if (sum == G) break;
        __builtin_amdgcn_s_sleep(1);
        if ((++sp & 255u) == 0u) { if (xb_ld(&bar[XB_TMO])) break; if (sp > XB_SPIN_CAP) { atomicAdd(&bar[XB_TMO], 1u); break; } }
    }
    nloc = mine > 0u ? mine : 1u; nx = cnt > 0u ? cnt : 1u;
}

__device__ __forceinline__ void xcd_barrier(const XcdBarrier& b) {
    asm volatile("s_waitcnt vmcnt(0)" ::: "memory");
    __syncthreads();
    if (threadIdx.x == 0) {
        unsigned* bar = b.bar;
        __builtin_amdgcn_s_waitcnt(0);
        unsigned nloc = b.st[0], nx = b.st[1];
        if (nloc == 0u) { xcd_barrier_complete(bar, b.x, nloc, nx); b.st[0] = nloc; b.st[1] = nx; }
        const unsigned old = xb_add(&bar[XB_XSUB(b.x)], 1u);
        const unsigned gen = old / nloc;
        if (old + 1u == (gen + 1u) * nloc) {
            __builtin_amdgcn_fence(__ATOMIC_RELEASE, "agent");
            asm volatile("s_waitcnt vmcnt(0)" ::: "memory");
            const unsigned og = xb_add(&bar[XB_TOP], 1u);
            const unsigned tg = og / nx;
            if (og + 1u == (tg + 1u) * nx) xb_add(&bar[XB_TOPGEN], 1u);
            else XB_SPIN(xb_ld(&bar[XB_TOPGEN]) == tg, bar);
            __builtin_amdgcn_fence(__ATOMIC_ACQUIRE, "agent");
            xb_add(&bar[XB_XGEN(b.x)], 1u);
            asm volatile("s_waitcnt vmcnt(0)" ::: "memory");
        } else {
            XB_SPIN(xb_ld(&bar[XB_XGEN(b.x)]) == gen, bar);
            __builtin_amdgcn_fence(__ATOMIC_ACQUIRE, "agent");
            asm volatile("s_waitcnt vmcnt(0)" ::: "memory");
        }
    }
    __syncthreads();
}
constexpr int NWAVES = 8;
struct Params {
    const float* in[27];
    float* out; unsigned char* ws;
    int ph_lo, ph_hi;
    int sub, pad;
};
enum { I_XP = 0, I_XS, I_CK, I_CV, I_SCONV, I_SH, I_CP, I_CS, I_G1, I_G2, I_WMOD, I_BMOD, I_WIN, I_QG, I_KG, I_RELB, I_CONVW, I_CONVB, I_WRA, I_BRA, I_WRX, I_BRX, I_LAM, I_WOUT, I_WG, I_WU, I_WD };

__device__ __forceinline__ float wave_sum(float v) {
#pragma unroll
    for (int o = 1; o < 64; o <<= 1) v += __shfl_xor(v, o);
    return v;
}
__device__ __forceinline__ unsigned f2bf(float f) { unsigned u = __builtin_bit_cast(unsigned, f); return (u + 0x7fffu + ((u >> 16) & 1u)) >> 16; }
__device__ __forceinline__ unsigned pk2(float lo, float hi) { return f2bf(lo) | (f2bf(hi) << 16); }

#ifndef NT_WEIGHTS
#define NT_WEIGHTS 0
#endif
#if NT_WEIGHTS
#define NT_LOAD(p) __builtin_nontemporal_load(p)
#else
#define NT_LOAD(p) (*(p))
#endif
__device__ __forceinline__ void transpose_item(const float* src, size_t sld, bf16* dst, size_t dld, LAS float* scr, int lane, size_t blk = 32) {
    { f32x4 v[8]; const int r8 = lane >> 3, c4 = lane & 7;
#pragma unroll
      for (int i = 0; i < 8; ++i) v[i] = NT_LOAD((const f32x4*)(src + (size_t)(8 * i + r8) * sld + 4 * c4));
#pragma unroll
      for (int i = 0; i < 8; ++i) { LAS float* d = scr + (8 * i + r8) * 33 + 4 * c4; d[0] = v[i][0]; d[1] = v[i][1]; d[2] = v[i][2]; d[3] = v[i][3]; } }
    LDS_WAIT(); asm volatile("" ::: "memory");
    const int c = lane & 7;
#pragma unroll
    for (int j = 0; j < 4; ++j) { const int n = (lane >> 3) + 8 * j; const LAS float* s = scr + (8 * c) * 33 + n;
        u32x4 o; o.x = pk2(s[0 * 33], s[1 * 33]); o.y = pk2(s[2 * 33], s[3 * 33]); o.z = pk2(s[4 * 33], s[5 * 33]); o.w = pk2(s[6 * 33], s[7 * 33]);
        *(u32x4*)(dst + (size_t)n * dld + (size_t)(c >> 2) * blk + 8 * (c & 3)) = o; }
    LDS_WAIT(); asm volatile("" ::: "memory");
}
__device__ __forceinline__ void transpose_item_f8(const float* src, size_t sld, unsigned char* dst, size_t dld, LAS float* scr, int lane) {
    { f32x4 v[8]; const int r8 = lane >> 3, c4 = lane & 7;
#pragma unroll
      for (int i = 0; i < 8; ++i) v[i] = NT_LOAD((const f32x4*)(src + (size_t)(8 * i + r8) * sld + 4 * c4));
#pragma unroll
      for (int i = 0; i < 8; ++i) { LAS float* d = scr + (8 * i + r8) * 33 + 4 * c4; d[0] = v[i][0]; d[1] = v[i][1]; d[2] = v[i][2]; d[3] = v[i][3]; } }
    LDS_WAIT(); asm volatile("" ::: "memory");
#pragma unroll
    for (int j = 0; j < 2; ++j) { const int p = lane + 64 * j, n = p >> 2, c = p & 3; const LAS float* s = scr + (16 * c) * 33 + n;
        u32x4 o; o.x = pk4_fp8(s[0 * 33] * W8_SCALE, s[1 * 33] * W8_SCALE, s[2 * 33] * W8_SCALE, s[3 * 33] * W8_SCALE); o.y = pk4_fp8(s[4 * 33] * W8_SCALE, s[5 * 33] * W8_SCALE, s[6 * 33] * W8_SCALE, s[7 * 33] * W8_SCALE);
        o.z = pk4_fp8(s[8 * 33] * W8_SCALE, s[9 * 33] * W8_SCALE, s[10 * 33] * W8_SCALE, s[11 * 33] * W8_SCALE); o.w = pk4_fp8(s[12 * 33] * W8_SCALE, s[13 * 33] * W8_SCALE, s[14 * 33] * W8_SCALE, s[15 * 33] * W8_SCALE);
        *(u32x4*)(dst + (size_t)n * dld + 16 * c) = o; }
    LDS_WAIT(); asm volatile("" ::: "memory");
}
__device__ __forceinline__ void transpose_item_i8(const float* src, size_t sld, unsigned char* dst, size_t dld, LAS float* scr, int lane, const float* amax) {
    { f32x4 v[8]; const int r8 = lane >> 3, c4 = lane & 7;
#pragma unroll
      for (int i = 0; i < 8; ++i) v[i] = NT_LOAD((const f32x4*)(src + (size_t)(8 * i + r8) * sld + 4 * c4));
#pragma unroll
      for (int i = 0; i < 8; ++i) { LAS float* d = scr + (8 * i + r8) * 33 + 4 * c4; d[0] = v[i][0]; d[1] = v[i][1]; d[2] = v[i][2]; d[3] = v[i][3]; } }
    LDS_WAIT(); asm volatile("" ::: "memory");
#pragma unroll
    for (int j = 0; j < 2; ++j) { const int p = lane + 64 * j, n = p >> 2, c = p & 3; const LAS float* s = scr + (16 * c) * 33 + n;
        const float a = amax[n], inv = a > 0.f ? 127.f / a : 0.f;
        u32x4 o; o.x = pk4_i8(s[0 * 33], s[1 * 33], s[2 * 33], s[3 * 33], inv); o.y = pk4_i8(s[4 * 33], s[5 * 33], s[6 * 33], s[7 * 33], inv);
        o.z = pk4_i8(s[8 * 33], s[9 * 33], s[10 * 33], s[11 * 33], inv); o.w = pk4_i8(s[12 * 33], s[13 * 33], s[14 * 33], s[15 * 33], inv);
        *(u32x4*)(dst + (size_t)n * dld + 16 * c) = o; }
    LDS_WAIT(); asm volatile("" ::: "memory");
}
__device__ __forceinline__ void p0_amax(const Params& P, int gw, int NGW, int lane) {
    unsigned* amax = (unsigned*)(P.ws + WS_CTL + WS_AMAX);
    constexpr int CC = DFF / 256, KC = D / 32, NIT = 2 * KC * CC;
    for (int it = gw; it < NIT; it += NGW) {
        const int up = it >= KC * CC, r = up ? it - KC * CC : it, kc = r / CC, cc = r % CC;
        const float* src = P.in[up ? I_WU : I_WG] + (size_t)kc * 32 * DFF + cc * 256 + 4 * lane;
        f32x4 m = (f32x4){0.f, 0.f, 0.f, 0.f};
#pragma unroll
        for (int h = 0; h < 2; ++h) { f32x4 v[16];
#pragma unroll
            for (int i = 0; i < 16; ++i) v[i] = NT_LOAD((const f32x4*)(src + (size_t)(h * 16 + i) * DFF));
#pragma unroll
            for (int i = 0; i < 16; ++i) { m[0] = fmaxf(m[0], fabsf(v[i][0])); m[1] = fmaxf(m[1], fabsf(v[i][1])); m[2] = fmaxf(m[2], fabsf(v[i][2])); m[3] = fmaxf(m[3], fabsf(v[i][3])); } }
        const int n = cc * 256 + 4 * lane, ni = 256 * (n >> 7) + (n & 127) + (up ? 128 : 0);
#pragma unroll
        for (int j = 0; j < 4; ++j) { const float mj = m[j]; __hip_atomic_fetch_max(amax + ni + j, __builtin_bit_cast(unsigned, mj), __ATOMIC_RELAXED, __HIP_MEMORY_SCOPE_AGENT); }
    }
}
__device__ __forceinline__ void cvt_item(const float* src, bf16* dst, int lane) {
#pragma unroll
    for (int j = 0; j < 4; ++j) { const f32x4 a = *(const f32x4*)(src + j * 512 + lane * 8), b = *(const f32x4*)(src + j * 512 + lane * 8 + 4);
        u32x4 o; o.x = pk2(a[0], a[1]); o.y = pk2(a[2], a[3]); o.z = pk2(b[0], b[1]); o.w = pk2(b[2], b[3]); *(u32x4*)(dst + j * 512 + lane * 8) = o; }
}
__device__ __forceinline__ void p0_convert(const Params& P, LAS unsigned char* lds, int gw, int NGW, int wave, int lane) {
    LAS float* scr = (LAS float*)(lds + wave * 8704);
    unsigned char* ws = P.ws;
    bf16* WinT = (bf16*)(ws + WS_WIN); bf16* WoutT = (bf16*)(ws + WS_WOUT); bf16* WguT = (bf16*)(ws + WS_WGU); bf16* WdT = (bf16*)(ws + WS_WD); bf16* WrgT = (bf16*)(ws + WS_WRG);
    bf16* VtS = (bf16*)(ws + WS_VTS); bf16* Kc = (bf16*)(ws + WS_KC);
    constexpr int I_IN = (D / 64) * (INC / 32), I_OUT = (D / 64) * (D / 32), I_GA = (D / 64) * (DFF / 32), I_DN = (DFF / 64) * (D / 32), I_CVT = SB * NH * (CROWS / 64) * (HD / 32), I_RG = 16 * (128 / 64) * (128 / 32),
                  I_KC = SB * NH * (CROWS / 16);
    constexpr int NITEMS = I_IN + I_OUT + I_DN + I_CVT + 2 * I_RG + I_KC;
    for (int it = gw; it < NITEMS; it += NGW) {
        int r = it;
        if (r < I_IN) { const int nb = r % (INC / 32), kb = r / (INC / 32); transpose_item(P.in[I_WIN] + (size_t)kb * 64 * INC + nb * 32, INC, WinT + (size_t)nb * 32 * D + kb * 64, D, scr, lane); continue; } r -= I_IN;
        if (r < I_OUT) { const int nb = r % (D / 32), kb = r / (D / 32); transpose_item(P.in[I_WOUT] + (size_t)kb * 64 * D + nb * 32, D, WoutT + (size_t)nb * 32 * D + kb * 64, D, scr, lane); continue; } r -= I_OUT;
        if (r < I_DN) { const int nb = r % (D / 32), kb = r / (D / 32);
            if (F8_DOWN) transpose_item_f8(P.in[I_WD] + (size_t)kb * 64 * D + nb * 32, D, (unsigned char*)WdT + (size_t)nb * 32 * DFF + kb * 64, DFF, scr, lane);
            else transpose_item(P.in[I_WD] + (size_t)kb * 64 * D + nb * 32, D, WdT + (size_t)nb * 32 * DFF + kb * 64, DFF, scr, lane); continue; } r -= I_DN;
        if (r < I_CVT) { const int sub = r & 31, bh = r >> 5, b = bh >> 4, h = bh & 15, kb = sub >> 2, nb = sub & 3;
            transpose_item(P.in[I_CV] + ((size_t)(b * CROWS + kb * 64) * NH + h) * HD + nb * 32, (size_t)NH * HD, VtS + (((size_t)(b * NH + h) * (KS_LD / 32) + kb * 2) * HD + nb * 32) * 32, 32, scr, lane, HD * 32); continue; } r -= I_CVT;
        if (r < 2 * I_RG) { const int x = r >= I_RG; if (x) r -= I_RG; const int sub = r & 7, n = r >> 3, kb = sub >> 2, nb = sub & 3;
            transpose_item(P.in[x ? I_WRX : I_WRA] + (size_t)n * 16384 + kb * 64 * 128 + nb * 32, 128, WrgT + ((size_t)n * 256 + x * 128 + nb * 32) * 128 + kb * 64, 128, scr, lane); continue; } r -= 2 * I_RG;
        { const int kc = r & 31, bh = r >> 5, b = bh >> 4, h = bh & 15;
#pragma unroll
          for (int j = 0; j < 4; ++j) { const int key = kc * 16 + 4 * j + (lane >> 4), d8 = (lane & 15) * 8; const float* sp = P.in[I_CK] + ((size_t)(b * CROWS + key) * NH + h) * HD + d8;
              const f32x4 a = *(const f32x4*)sp, c4 = *(const f32x4*)(sp + 4); u32x4 o; o.x = pk2(a[0], a[1]); o.y = pk2(a[2], a[3]); o.z = pk2(c4[0], c4[1]); o.w = pk2(c4[2], c4[3]);
              *(u32x4*)(Kc + ((size_t)bh * CROWS + key) * HD + d8) = o; } }
    }
    { unsigned* ctl = (unsigned*)(ws + WS_CTL);
      if (threadIdx.x == 0) {
          unsigned sp = 0;
          while (__hip_atomic_load(ctl + CW_ARRIVE + 896, __ATOMIC_RELAXED, __HIP_MEMORY_SCOPE_AGENT) < gridDim.x) { __builtin_amdgcn_s_sleep(2);
              if ((++sp & 255u) == 0u) { if (__hip_atomic_load(ctl + CW_TMO2, __ATOMIC_RELAXED, __HIP_MEMORY_SCOPE_AGENT)) break; if (sp > (1u << 20)) { __hip_atomic_store(ctl + CW_TMO2, 1u, __ATOMIC_RELAXED, __HIP_MEMORY_SCOPE_AGENT); break; } } }
          __builtin_amdgcn_fence(__ATOMIC_ACQUIRE, "agent"); VM_WAIT();
      }
      __syncthreads(); }
    const float* amax = (const float*)(ws + WS_CTL + WS_AMAX);
    for (int it = gw; it < 2 * I_GA; it += NGW) {
        int r = it; const int up = r >= I_GA; if (up) r -= I_GA; const int nb = r % (DFF / 32), kb = r / (DFF / 32); const int n0 = nb * 32, row0 = 256 * (n0 >> 7) + (n0 & 127) + (up ? 128 : 0);
        transpose_item_i8(P.in[up ? I_WU : I_WG] + (size_t)kb * 64 * DFF + n0, DFF, (unsigned char*)WguT + (size_t)row0 * D + kb * 64, D, scr, lane, amax + row0);
    }
}
__device__ __forceinline__ void p0_mod(const Params& P, LAS unsigned char* lds, int tid, int wave, int lane) {
    LAS float* Sw = (LAS float*)lds + wave * 640;
    LAS float* Rb = (LAS float*)(lds + 20480);
    const float* Wm = P.in[I_WMOD]; float* mod = (float*)(P.ws + WS_MOD);
    for (int cb = blockIdx.x; cb < NMOD / 96; cb += gridDim.x) {
        const int n0 = cb * 96, rs = lane / 24, c4 = lane % 24;
        f32x4 acc[NSEQ];
#pragma unroll
        for (int s = 0; s < NSEQ; ++s) acc[s] = (f32x4){0.f, 0.f, 0.f, 0.f};
        __syncthreads();
        for (int idx = lane; idx < NSEQ * 16; idx += 64) { const int sq = idx >> 4, r = idx & 15; const float v = sq < NB ? P.in[I_CP][sq * D + wave * 16 + r] : P.in[I_CS][(sq - NB) * D + wave * 16 + r]; Sw[r * 20 + sq] = v * fast_sigmoid(v); }
        f32x4 w[8];
        if (lane < 48) {
#pragma unroll
            for (int p = 0; p < 8; ++p) w[p] = NT_LOAD((const f32x4*)(Wm + (size_t)(wave * 16 + 2 * p + rs) * NMOD + n0 + 4 * c4)); }
        for (int ch = 0; ch < D / 128; ++ch) {
            const int k0 = ch * 128; LAS float* Sc = Sw + (ch & 1) * 320; LAS float* Sn = Sw + ((ch + 1) & 1) * 320;
            const int kn = (ch + 1 < D / 128) ? k0 + 128 : k0;
            for (int idx = lane; idx < NSEQ * 16; idx += 64) { const int sq = idx >> 4, r = idx & 15; const float v = sq < NB ? P.in[I_CP][sq * D + kn + wave * 16 + r] : P.in[I_CS][(sq - NB) * D + kn + wave * 16 + r]; Sn[r * 20 + sq] = v * fast_sigmoid(v); }
            LDS_WAIT(); asm volatile("" ::: "memory");
            if (lane < 48) {
                f32x4 wn[8];
#pragma unroll
                for (int p = 0; p < 8; ++p) wn[p] = NT_LOAD((const f32x4*)(Wm + (size_t)(kn + wave * 16 + 2 * p + rs) * NMOD + n0 + 4 * c4));
#pragma unroll
                for (int p = 0; p < 8; ++p) { const LAS float* sp = Sc + (2 * p + rs) * 20;
                    const f32x4 s0 = *(const LAS f32x4*)sp, s1 = *(const LAS f32x4*)(sp + 4), s2 = *(const LAS f32x4*)(sp + 8), s3 = *(const LAS f32x4*)(sp + 12); const f32x2 s4 = *(const LAS f32x2*)(sp + 16);
#pragma unroll
                    for (int j = 0; j < 4; ++j) { acc[j] += w[p] * s0[j]; acc[4 + j] += w[p] * s1[j]; acc[8 + j] += w[p] * s2[j]; acc[12 + j] += w[p] * s3[j]; }
                    acc[16] += w[p] * s4[0]; acc[17] += w[p] * s4[1]; }
#pragma unroll
                for (int p = 0; p < 8; ++p) w[p] = wn[p];
            }
            LDS_WAIT(); asm volatile("" ::: "memory");
        }
        if (lane < 48) {
#pragma unroll
            for (int s = 0; s < NSEQ; ++s) *(LAS f32x4*)(Rb + ((wave * 2 + rs) * NSEQ + s) * 96 + 4 * c4) = acc[s];
        }
        __syncthreads();
        for (int idx = tid; idx < NSEQ * 96; idx += NWAVES * 64) { const int s = idx / 96, c = idx % 96; float v = P.in[I_BMOD][n0 + c];
#pragma unroll
            for (int q = 0; q < 16; ++q) v += Rb[(q * NSEQ + s) * 96 + c];
            mod[(size_t)s * NMOD + n0 + c] = v; }
    }
    __syncthreads();
}
template <bool X0_BF16, int UQ = 0> __device__ __forceinline__ void norm_rows(const float* __restrict__ x0, const float* __restrict__ x1, const float* __restrict__ gain, const float* __restrict__ mod, int sh_off, int sc_off, bf16* __restrict__ U, const float* __restrict__ slab, float* __restrict__ x1out, int nrows, int gw, int NGW, int lane, float* __restrict__ su = nullptr) {
    for (int m = gw; m < nrows; m += NGW) {
        const float* xr = m < NPR ? x0 + (X0_BF16 ? 0 : (size_t)m * D) : x1 + (size_t)(m - NPR) * D;
        const int seq = m < NPR ? m / T : NB + (m - NPR) / ST;
        const float* mp = mod + (size_t)seq * NMOD;
        f32x4 v[16]; float ss = 0.f;
#pragma unroll
        for (int j = 0; j < 16; ++j) {
            if (X0_BF16 && m < NPR) { const u32x2 w = *(const u32x2*)((const bf16*)x0 + (size_t)m * D + 4 * (lane + 64 * j)); v[j] = (f32x4){__uint_as_float(w.x << 16), __uint_as_float(w.x & 0xffff0000u), __uint_as_float(w.y << 16), __uint_as_float(w.y & 0xffff0000u)}; }
            else v[j] = *(const f32x4*)(xr + 4 * (lane + 64 * j)); }
        if (slab && m >= NPR) {
            for (int q = 0; q < 8; ++q) {
#pragma unroll
                for (int j = 0; j < 16; ++j) v[j] += *(const f32x4*)(slab + ((size_t)q * NSA + (m - NPR)) * D + 4 * (lane + 64 * j)); }
#pragma unroll
            for (int j = 0; j < 16; ++j) *(f32x4*)(x1out + (size_t)(m - NPR) * D + 4 * (lane + 64 * j)) = v[j];
        }
#pragma unroll
        for (int j = 0; j < 16; ++j) ss += (v[j][0] * v[j][0] + v[j][1] * v[j][1]) + (v[j][2] * v[j][2] + v[j][3] * v[j][3]);
        const float rstd = __builtin_amdgcn_rsqf(wave_sum(ss) * (1.0f / D) + RMS_EPS);
        bf16* up = U + (size_t)m * D; unsigned char* up8 = (unsigned char*)U + (size_t)m * D;
        constexpr int JB = UQ ? 4 : 8;
        float amx = 0.f;
#pragma unroll
        for (int jb = 0; jb < 16; jb += JB) {
            f32x4 g[JB], sc[JB], sh[JB];
#pragma unroll
            for (int j = 0; j < JB; ++j) { const int c = 4 * (lane + 64 * (jb + j)); g[j] = *(const f32x4*)(gain + c); sc[j] = *(const f32x4*)(mp + sc_off + c); sh[j] = *(const f32x4*)(mp + sh_off + c); }
#pragma unroll
            for (int j = 0; j < JB; ++j) { const int c = 4 * (lane + 64 * (jb + j));
                const f32x4 o = v[jb + j] * rstd * g[j] * (sc[j] + 1.0f) + sh[j];
                if (UQ == 2) { v[jb + j] = o; amx = fmaxf(fmaxf(amx, fmaxf(fabsf(o[0]), fabsf(o[1]))), fmaxf(fabsf(o[2]), fabsf(o[3]))); }
                else { u32x2 w; w.x = cvt_pk_bf16(o[0], o[1]); w.y = cvt_pk_bf16(o[2], o[3]); *(u32x2*)(up + c) = w; } }
            if (UQ) asm volatile("" ::: "memory");
        }
        if (UQ == 2) {
#pragma unroll
            for (int o = 1; o < 64; o <<= 1) amx = fmaxf(amx, __shfl_xor(amx, o));
            const float inv = amx > 0.f ? 127.f / amx : 0.f;
            if (lane == 0) su[m] = amx * (1.f / 127.f);
#pragma unroll
            for (int j = 0; j < 16; ++j) *(unsigned*)(up8 + 4 * (lane + 64 * j)) = pk4_i8(v[j][0], v[j][1], v[j][2], v[j][3], inv);
        }
    }
}

template <bool SLAB, int UQ = 0> __device__ __forceinline__ void norm_sample_split(const Params& P, LAS unsigned char* lds, const float* __restrict__ xs, const float* __restrict__ gain, const float* __restrict__ mod, int sh_off, int sc_off,
                                                  bf16* __restrict__ U, const float* __restrict__ slab, float* __restrict__ x1out, int wave, int lane, float* __restrict__ su = nullptr) {
    LAS float* part = (LAS float*)lds;
    for (int rb = blockIdx.x; rb < NSA / 2; rb += gridDim.x) {
        const int r = 2 * rb + (wave >> 2), col0 = 1024 * (wave & 3), seq = NB + r / ST;
        const float* mp = mod + (size_t)seq * NMOD;
        f32x4 v[4];
#pragma unroll
        for (int j = 0; j < 4; ++j) v[j] = *(const f32x4*)(xs + (size_t)r * D + col0 + 4 * (lane + 64 * j));
        if (SLAB) {
#pragma unroll
            for (int q = 0; q < 8; ++q)
#pragma unroll
                for (int j = 0; j < 4; ++j) v[j] += *(const f32x4*)(slab + ((size_t)q * NSA + r) * D + col0 + 4 * (lane + 64 * j)); }
        float ss = 0.f;
#pragma unroll
        for (int j = 0; j < 4; ++j) { if (SLAB) *(f32x4*)(x1out + (size_t)r * D + col0 + 4 * (lane + 64 * j)) = v[j]; ss += (v[j][0] * v[j][0] + v[j][1] * v[j][1]) + (v[j][2] * v[j][2] + v[j][3] * v[j][3]); }
        ss = wave_sum(ss);
        __syncthreads();
        if (lane == 0) part[wave] = ss;
        __syncthreads();
        const int w0 = wave & 4; const float tot = (part[w0] + part[w0 + 1]) + (part[w0 + 2] + part[w0 + 3]);
        const float rstd = __builtin_amdgcn_rsqf(tot * (1.0f / D) + RMS_EPS);
        bf16* up = U + (size_t)(NPR + r) * D; unsigned char* up8 = (unsigned char*)U + (size_t)(NPR + r) * D;
        float amx = 0.f;
#pragma unroll
        for (int j = 0; j < 4; ++j) { const int c = col0 + 4 * (lane + 64 * j);
            const f32x4 o = v[j] * rstd * *(const f32x4*)(gain + c) * (*(const f32x4*)(mp + sc_off + c) + 1.0f) + *(const f32x4*)(mp + sh_off + c);
            if (UQ == 2) { v[j] = o; amx = fmaxf(fmaxf(amx, fmaxf(fabsf(o[0]), fabsf(o[1]))), fmaxf(fabsf(o[2]), fabsf(o[3]))); }
            else { u32x2 w; w.x = cvt_pk_bf16(o[0], o[1]); w.y = cvt_pk_bf16(o[2], o[3]); *(u32x2*)(up + c) = w; } }
        if (UQ == 2) {
#pragma unroll
            for (int o = 1; o < 64; o <<= 1) amx = fmaxf(amx, __shfl_xor(amx, o));
            if (lane == 0) part[8 + wave] = amx;
            __syncthreads();
            const float rmx = fmaxf(fmaxf(part[8 + w0], part[8 + w0 + 1]), fmaxf(part[8 + w0 + 2], part[8 + w0 + 3]));
            const float inv = rmx > 0.f ? 127.f / rmx : 0.f;
            if (lane == 0 && (wave & 3) == 0) su[NPR + r] = rmx * (1.f / 127.f);
#pragma unroll
            for (int j = 0; j < 4; ++j) *(unsigned*)(up8 + col0 + 4 * (lane + 64 * j)) = pk4_i8(v[j][0], v[j][1], v[j][2], v[j][3], inv);
        }
    }
}
__device__ __forceinline__ void attn_unit(const bf16* Qp, const bf16* Kp0, const bf16* Kp1, int nks, int ks_split, const bf16* Vt, int dq0, const LAS float* tab, bf16* Op, int lane) {
    const int c = lane & 15, g = lane >> 4;
    bf16x8 qf[2][4];
#pragma unroll
    for (int qt = 0; qt < 2; ++qt)
#pragma unroll
        for (int ds = 0; ds < 4; ++ds) qf[qt][ds] = *(const bf16x8*)(Qp + (unsigned)((16 * qt + c) * HD + 32 * ds + 8 * g));
    f32x4 o[8][2];
#pragma unroll
    for (int dt = 0; dt < 8; ++dt) { o[dt][0] = (f32x4){0.f, 0.f, 0.f, 0.f}; o[dt][1] = (f32x4){0.f, 0.f, 0.f, 0.f}; }
    float mrun[2] = {-1e30f, -1e30f}, lrun[2] = {0.f, 0.f};
    const int kr0 = 8 * (c >> 2) + (c & 3);
    const float bfar = tab[256];
    const unsigned koff = (unsigned)(kr0 * HD + 8 * g), voff = (unsigned)(c * 32 + 8 * g);
    bf16x8 kf[2][4], vf[8];
    {
        const bf16* kb = 0 < ks_split ? Kp0 : Kp1;
#pragma unroll
        for (int tau = 0; tau < 2; ++tau)
#pragma unroll
            for (int ds = 0; ds < 4; ++ds) kf[tau][ds] = *(const bf16x8*)(kb + tau * 4 * HD + 32 * ds + koff);
#pragma unroll
        for (int dt = 0; dt < 8; ++dt) vf[dt] = *(const bf16x8*)(Vt + dt * 512 + voff);
    }
    for (int ks = 0; ks < nks; ++ks) {
        f32x4 s[2][2];
#pragma unroll
        for (int qt = 0; qt < 2; ++qt)
#pragma unroll
            for (int tau = 0; tau < 2; ++tau) { f32x4 a = (f32x4){0.f, 0.f, 0.f, 0.f};
#pragma unroll
                for (int ds = 0; ds < 4; ++ds) a = __builtin_amdgcn_mfma_f32_16x16x32_bf16(kf[tau][ds], qf[qt][ds], a, 0, 0, 0);
                s[qt][tau] = a; }
        __builtin_amdgcn_sched_barrier(0);
        if (ks + 1 < nks) {
            const int kn = ks + 1; const bf16* kb = kn < ks_split ? Kp0 + (size_t)(32 * kn) * HD : Kp1 + (size_t)(32 * (kn - ks_split)) * HD;
#pragma unroll
            for (int tau = 0; tau < 2; ++tau)
#pragma unroll
                for (int ds = 0; ds < 4; ++ds) kf[tau][ds] = *(const bf16x8*)(kb + tau * 4 * HD + 32 * ds + koff);
        }
        __builtin_amdgcn_sched_barrier(0);
        const int dstep = dq0 - 32 * ks;
        if (dstep - 31 >= 128) {
#pragma unroll
            for (int qt = 0; qt < 2; ++qt)
#pragma unroll
                for (int tau = 0; tau < 2; ++tau) s[qt][tau] += bfar;
        } else {
#pragma unroll
            for (int qt = 0; qt < 2; ++qt)
#pragma unroll
                for (int tau = 0; tau < 2; ++tau)
#pragma unroll
                    for (int e = 0; e < 4; ++e) { int rel = dstep + 16 * qt + c - (8 * g + 4 * tau + e); rel = rel < -128 ? -128 : (rel > 128 ? 128 : rel); s[qt][tau][e] += tab[rel + 128]; }
        }
        bf16x8 pf[2];
#pragma unroll
        for (int qt = 0; qt < 2; ++qt) {
            float mx = fmaxf(fmaxf(fmaxf(s[qt][0][0], s[qt][0][1]), fmaxf(s[qt][0][2], s[qt][0][3])), fmaxf(fmaxf(s[qt][1][0], s[qt][1][1]), fmaxf(s[qt][1][2], s[qt][1][3])));
            mx = xrow16_max(mx);
            const float mn = fmaxf(mrun[qt], mx), alpha = __builtin_amdgcn_exp2f(mrun[qt] - mn);
            const bool grew = __any(mn > mrun[qt]); mrun[qt] = mn;
            f32x4 p0, p1;
#pragma unroll
            for (int e = 0; e < 4; ++e) { p0[e] = __builtin_amdgcn_exp2f(s[qt][0][e] - mn); p1[e] = __builtin_amdgcn_exp2f(s[qt][1][e] - mn); }
            lrun[qt] = lrun[qt] * alpha + ((p0[0] + p0[1]) + (p0[2] + p0[3])) + ((p1[0] + p1[1]) + (p1[2] + p1[3]));
            if (grew) {
#pragma unroll
                for (int dt = 0; dt < 8; ++dt) o[dt][qt] *= alpha; }
            u32x4 w; w.x = cvt_pk_bf16(p0[0], p0[1]); w.y = cvt_pk_bf16(p0[2], p0[3]); w.z = cvt_pk_bf16(p1[0], p1[1]); w.w = cvt_pk_bf16(p1[2], p1[3]);
            pf[qt] = __builtin_bit_cast(bf16x8, w);
        }
#pragma unroll
        for (int dt = 0; dt < 8; ++dt)
#pragma unroll
            for (int qt = 0; qt < 2; ++qt) o[dt][qt] = __builtin_amdgcn_mfma_f32_16x16x32_bf16(vf[dt], pf[qt], o[dt][qt], 0, 0, 0);
        __builtin_amdgcn_sched_barrier(0);
        if (ks + 1 < nks) {
            const bf16* vb = Vt + (size_t)(ks + 1) * (HD * 32);
#pragma unroll
            for (int dt = 0; dt < 8; ++dt) vf[dt] = *(const bf16x8*)(vb + dt * 512 + voff);
        }
        __builtin_amdgcn_sched_barrier(0);
    }
#pragma unroll
    for (int qt = 0; qt < 2; ++qt) {
        const float l = xrow16_sum(lrun[qt]);
        const float inv = 1.0f / l;
        bf16* op = Op + (unsigned)((16 * qt + c) * D + 4 * g);
#pragma unroll
        for (int dt = 0; dt < 8; ++dt) { const f32x4 v = o[dt][qt] * inv; u32x2 w; w.x = cvt_pk_bf16(v[0], v[1]); w.y = cvt_pk_bf16(v[2], v[3]); *(u32x2*)(op + 16 * dt) = w; }
    }
}
__device__ __forceinline__ void attn_block_unit(const bf16* Qh, const bf16* Kh, const bf16* VtP, bf16* MIX, int bh, int qb, const LAS float* tabh, LAS unsigned char* ring, int wave, int lane) {
    const int c = lane & 15, g = lane >> 4, b = bh >> 4, h = bh & 15;
    const int ci0 = 4 * qb, ci = ci0 + (wave >> 1), q0 = 64 * ci + 32 * (wave & 1);
    const int kt0 = ci0 > 8 ? ci0 - 8 : 0, nt = ci0 + 3 - kt0 + 1;
    const bf16* Qp = Qh + ((size_t)bh * T + q0) * HD;
    bf16x8 qf[2][4];
#pragma unroll
    for (int qt = 0; qt < 2; ++qt)
#pragma unroll
        for (int ds = 0; ds < 4; ++ds) qf[qt][ds] = *(const bf16x8*)(Qp + (unsigned)((16 * qt + c) * HD + 32 * ds + 8 * g));
    f32x4 o[8][2];
#pragma unroll
    for (int dt = 0; dt < 8; ++dt) { o[dt][0] = (f32x4){0.f, 0.f, 0.f, 0.f}; o[dt][1] = (f32x4){0.f, 0.f, 0.f, 0.f}; }
    float mrun[2] = {-1e30f, -1e30f};
    f32x4 ol[2] = {(f32x4){0.f, 0.f, 0.f, 0.f}, (f32x4){0.f, 0.f, 0.f, 0.f}};
    const bf16x8 ones = (bf16x8){0x3F80, 0x3F80, 0x3F80, 0x3F80, 0x3F80, 0x3F80, 0x3F80, 0x3F80};
    const float bfar = tabh[256];
    unsigned ksrc[2];
#pragma unroll
    for (int j = 0; j < 2; ++j) { const int r = 4 * (2 * wave + j) + (lane >> 4), pos = lane & 15, sw = (((r >> 3) & 3) << 2) | (r & 3); ksrc[j] = (unsigned)(r * HD + ((pos ^ sw) << 3)); }
    const unsigned vsrc = (unsigned)(wave * 1024 + lane * 8);
    const bf16* Kbase = Kh + (size_t)bh * T * HD; const bf16* Vbase = VtP + (size_t)bh * (T / 32) * HD * 32;
#define ATTN_DMA(kt, slot) do { const bf16* kp_ = Kbase + (size_t)(kt) * (64 * HD); const bf16* vp_ = Vbase + (size_t)(kt) * (64 * HD) + vsrc; LAS unsigned char* sl_ = ring + (slot) * 32768 + wave * 2048; \
        __builtin_amdgcn_global_load_lds((const unsigned*)(kp_ + ksrc[0]), (LAS unsigned*)(sl_), 16, 0, 0); \
        __builtin_amdgcn_global_load_lds((const unsigned*)(kp_ + ksrc[1]), (LAS unsigned*)(sl_ + 1024), 16, 0, 0); \
        __builtin_amdgcn_global_load_lds((const unsigned*)(vp_), (LAS unsigned*)(sl_ + 16384), 16, 0, 0); \
        __builtin_amdgcn_global_load_lds((const unsigned*)(vp_ + 512), (LAS unsigned*)(sl_ + 16384 + 1024), 16, 0, 0); } while (0)
    asm volatile("s_waitcnt vmcnt(0)" ::: "memory");
    ATTN_DMA(kt0, 0); ATTN_DMA(kt0 + 1, 1);
    const int kr0 = 8 * (c >> 2) + (c & 3);
    int slot = 0;
    for (int i = 0; i < nt; ++i) {
        asm volatile("s_waitcnt vmcnt(4)" ::: "memory");
        __builtin_amdgcn_s_barrier();
        asm volatile("" ::: "memory");
        { const int in = i + 2 < nt ? i + 2 : nt - 1; int sn = slot + 2; sn = sn >= 3 ? sn - 3 : sn; ATTN_DMA(kt0 + in, sn); }
        const int kt = kt0 + i;
        if (kt >= ci - 8 && kt <= ci) {
            const LAS unsigned char* ks_ = ring + slot * 32768; const LAS unsigned char* vs_ = ks_ + 16384;
#pragma unroll
            for (int st = 0; st < 2; ++st) {
                bf16x8 kf[2][4];
#pragma unroll
                for (int tau = 0; tau < 2; ++tau)
#pragma unroll
                    for (int ds = 0; ds < 4; ++ds) kf[tau][ds] = *(const LAS bf16x8*)(ks_ + (32 * st + kr0 + 4 * tau) * 256 + (((4 * ds + g) ^ c) << 4));
                f32x4 s[2][2];
#pragma unroll
                for (int qt = 0; qt < 2; ++qt)
#pragma unroll
                    for (int tau = 0; tau < 2; ++tau) { f32x4 a = (f32x4){0.f, 0.f, 0.f, 0.f};
#pragma unroll
                        for (int ds = 0; ds < 4; ++ds) a = __builtin_amdgcn_mfma_f32_16x16x32_bf16(kf[tau][ds], qf[qt][ds], a, 0, 0, 0);
                        s[qt][tau] = a; }
                bf16x8 vf[8];
#pragma unroll
                for (int dt = 0; dt < 8; ++dt) vf[dt] = *(const LAS bf16x8*)(vs_ + st * 8192 + (16 * dt + c) * 64 + g * 16);
                const int dstep = q0 - (64 * kt + 32 * st);
                const bool far = dstep - 31 >= 128;
                const float badd = far ? bfar : 0.f;
                if (!far) {
#pragma unroll
                    for (int qt = 0; qt < 2; ++qt)
#pragma unroll
                        for (int tau = 0; tau < 2; ++tau)
#pragma unroll
                            for (int e = 0; e < 4; ++e) { int rel = dstep + 16 * qt + c - (8 * g + 4 * tau + e); rel = rel < -128 ? -128 : (rel > 128 ? 128 : rel); s[qt][tau][e] += tabh[rel + 128]; }
                }
                bf16x8 pf[2];
#pragma unroll
                for (int qt = 0; qt < 2; ++qt) {
                    float mx = fmaxf(fmaxf(fmaxf(s[qt][0][0], s[qt][0][1]), fmaxf(s[qt][0][2], s[qt][0][3])), fmaxf(fmaxf(s[qt][1][0], s[qt][1][1]), fmaxf(s[qt][1][2], s[qt][1][3])));
                    mx = xrow16_max(mx) + badd;
                    const float mn = fmaxf(mrun[qt], mx), alpha = __builtin_amdgcn_exp2f(mrun[qt] - mn), coff = badd - mn;
                    const bool grew = __any(mn > mrun[qt]); mrun[qt] = mn;
                    f32x4 p0, p1;
#pragma unroll
                    for (int e = 0; e < 4; ++e) { p0[e] = __builtin_amdgcn_exp2f(s[qt][0][e] + coff); p1[e] = __builtin_amdgcn_exp2f(s[qt][1][e] + coff); }
                    if (grew) {
#pragma unroll
                        for (int dt = 0; dt < 8; ++dt) o[dt][qt] *= alpha;
                        ol[qt] *= alpha; }
                    u32x4 w; w.x = cvt_pk_bf16(p0[0], p0[1]); w.y = cvt_pk_bf16(p0[2], p0[3]); w.z = cvt_pk_bf16(p1[0], p1[1]); w.w = cvt_pk_bf16(p1[2], p1[3]);
                    pf[qt] = __builtin_bit_cast(bf16x8, w);
                }
#pragma unroll
                for (int dt = 0; dt < 8; ++dt)
#pragma unroll
                    for (int qt = 0; qt < 2; ++qt) o[dt][qt] = __builtin_amdgcn_mfma_f32_16x16x32_bf16(vf[dt], pf[qt], o[dt][qt], 0, 0, 0);
#pragma unroll
                for (int qt = 0; qt < 2; ++qt) ol[qt] = __builtin_amdgcn_mfma_f32_16x16x32_bf16(ones, pf[qt], ol[qt], 0, 0, 0);
            }
            asm volatile("s_waitcnt lgkmcnt(0)" ::: "memory");
        }
        slot = slot == 2 ? 0 : slot + 1;
    }
#undef ATTN_DMA
    bf16* Op = MIX + (size_t)(b * T + q0) * D + h * HD;
#pragma unroll
    for (int qt = 0; qt < 2; ++qt) {
        const float inv = 1.0f / ol[qt][0];
        bf16* op = Op + (unsigned)((16 * qt + c) * D + 4 * g);
#pragma unroll
        for (int dt = 0; dt < 8; ++dt) { const f32x4 v = o[dt][qt] * inv; u32x2 w; w.x = cvt_pk_bf16(v[0], v[1]); w.y = cvt_pk_bf16(v[2], v[3]); *(u32x2*)(op + 16 * dt) = w; }
    }
    asm volatile("s_waitcnt vmcnt(0)" ::: "memory");
    __builtin_amdgcn_s_barrier();
    asm volatile("" ::: "memory");
}
__device__ __forceinline__ void attn_phase(const Params& P, LAS unsigned char* lds, int tid, int wave, int lane) {
    LAS float* tab = (LAS float*)(lds + 98304);
    for (int i = tid; i < NH * 257; i += NWAVES * 64) { const int h = i / 257, r = i % 257; tab[h * 260 + r] = P.in[I_RELB][i] * LOG2E; }
    __syncthreads();
    const bf16* Q = (const bf16*)(P.ws + WS_Q); const bf16* K = (const bf16*)(P.ws + WS_K); const bf16* Kc = (const bf16*)(P.ws + WS_KC);
    const bf16* VtP = (const bf16*)(P.ws + WS_VTP); const bf16* VtS = (const bf16*)(P.ws + WS_VTS); bf16* MIX = (bf16*)(P.ws + WS_MIX);
    if (P.sub & 4) for (int u = blockIdx.x; u < NB * NH * 16; u += gridDim.x) {
        const int bh = u & 31, qb = u >> 5;
        attn_block_unit(Q, K, VtP, MIX, bh, qb, tab + (bh & 15) * 260, lds, wave, lane);
    }
    {
        unsigned* ctl = (unsigned*)(P.ws + WS_CTL);
        if (tid == 0) {
            unsigned sp = 0;
            while (__hip_atomic_load(ctl + CW_ARRIVE + 768, __ATOMIC_RELAXED, __HIP_MEMORY_SCOPE_AGENT) < gridDim.x) { __builtin_amdgcn_s_sleep(2);
                if ((++sp & 255u) == 0u) { if (__hip_atomic_load(ctl + CW_TMO2, __ATOMIC_RELAXED, __HIP_MEMORY_SCOPE_AGENT)) break; if (sp > (1u << 20)) { __hip_atomic_store(ctl + CW_TMO2, 1u, __ATOMIC_RELAXED, __HIP_MEMORY_SCOPE_AGENT); break; } } }
            __builtin_amdgcn_fence(__ATOMIC_ACQUIRE, "agent"); VM_WAIT();
        }
        __syncthreads();
    }
    if ((P.sub & 2) && wave == (int)(blockIdx.x & 7)) for (int su = blockIdx.x; su < SB * NH; su += gridDim.x) {
        const int b = su >> 4, h = su & 15; const size_t srow = (size_t)NPR * AW + (size_t)(b * NH + h) * ST * HD;
        attn_unit(Q + srow, Kc + (size_t)(b * NH + h) * CROWS * HD, K + srow, 17, 16, VtS + (size_t)(b * NH + h) * (KS_LD / 32) * HD * 32, 512, tab + h * 260, MIX + (size_t)(NPR + b * ST) * D + h * HD, lane);
    }
}
__device__ __forceinline__ float neg_expm1(float z, float ez) {
    float p = 1.0f + z * (1.0f / 7.0f); p = 1.0f + z * (1.0f / 6.0f) * p; p = 1.0f + z * 0.2f * p; p = 1.0f + z * 0.25f * p; p = 1.0f + z * (1.0f / 3.0f) * p; p = 1.0f + z * 0.5f * p;
    return z > -0.25f ? -z * p : 1.0f - ez;
}
template <int PASS> __device__ __forceinline__ void lru_unit(const Params& P, LAS unsigned char* lds, int unit, int tid, int wave, int lane) {
    int seq, chunk, n;
    if (unit < NB * 64 * 16) { n = unit & 15; chunk = (unit >> 4) & 63; seq = unit >> 10; } else { const int r = unit - NB * 64 * 16; n = r & 15; chunk = 0; seq = NB + (r >> 4); }
    const bool prompt = seq < NB; const int rows = prompt ? 64 : 32; const int m0 = prompt ? seq * T + chunk * 64 : NPR + (seq - NB) * ST;
    LAS float* XF = (LAS float*)lds;
    LAS bf16* XB = (LAS bf16*)(lds + 64 * 132 * 4);
    const float* XR = (const float*)(P.ws + WS_XR);
    const int c = lane & 15, g = lane >> 4, cw = wave * 16 + c, ch = n * 128 + cw;
    bf16x8 ba[4], bx[4];
    {
        const bf16* wp = (const bf16*)(P.ws + WS_WRG) + ((size_t)n * 256 + cw) * 128 + 8 * g;
#pragma unroll
        for (int ks = 0; ks < 4; ++ks) { ba[ks] = *(const bf16x8*)(wp + 32 * ks); bx[ks] = *(const bf16x8*)(wp + 128 * 128 + 32 * ks); }
    }
    const float bra = P.in[I_BRA][ch], brx = P.in[I_BRX][ch], lam = P.in[I_LAM][ch];
    float hin = 0.f;
    if (PASS == 2) {
        if (prompt) {
            const f32x2* ls = (const f32x2*)(P.ws + WS_LSUM) + (size_t)seq * 64 * LW + ch;
            f32x2 sm[16];
#pragma unroll
            for (int i = 0; i < 16; ++i) { const int ci = 16 * g + i; sm[i] = ci < chunk ? ls[(size_t)ci * LW] : (f32x2){1.f, 0.f}; }
            float Ag = 1.f, Hg = 0.f;
#pragma unroll
            for (int i = 0; i < 16; ++i) { Hg = sm[i][0] * Hg + sm[i][1]; Ag *= sm[i][0]; }
#pragma unroll
            for (int q = 0; q < 4; ++q) { const float Aq = __shfl(Ag, c + 16 * q), Hq = __shfl(Hg, c + 16 * q); hin = Aq * hin + Hq; }
        } else hin = P.in[I_SH][(seq - NB) * LW + ch];
    }
    {
        const int t = tid >> 3, cg = (tid & 7) * 16, col = n * 128 + cg;
        const bool live = t < rows;
        f32x4 xv[4][4], wv[4][4], xc[4];
#pragma unroll
        for (int i = 0; i < 4; ++i) { const int tt = t - 3 + i;
            const bool fromx = tt >= 0 || (prompt && chunk > 0), froms = !fromx && !prompt;
            const float* src = froms ? P.in[I_SCONV] + (size_t)((seq - NB) * 3 + 3 + tt) * LW : XR + (size_t)(m0 + ((fromx && live) ? tt : 0)) * LW;
            const float wsc = (live && (fromx || froms)) ? 1.f : 0.f;
#pragma unroll
            for (int q = 0; q < 4; ++q) { xv[i][q] = *(const f32x4*)(src + col + 4 * q); wv[i][q] = *(const f32x4*)(P.in[I_CONVW] + (size_t)i * LW + col + 4 * q) * wsc; } }
#pragma unroll
        for (int q = 0; q < 4; ++q) { xc[q] = live ? *(const f32x4*)(P.in[I_CONVB] + col + 4 * q) : (f32x4){0.f, 0.f, 0.f, 0.f};
#pragma unroll
            for (int i = 0; i < 4; ++i) xc[q] += wv[i][q] * xv[i][q]; }
#pragma unroll
        for (int q = 0; q < 4; ++q) *(LAS f32x4*)(XF + t * 132 + cg + 4 * q) = xc[q];
        u32x4 w0, w1; w0.x = cvt_pk_bf16(xc[0][0], xc[0][1]); w0.y = cvt_pk_bf16(xc[0][2], xc[0][3]); w0.z = cvt_pk_bf16(xc[1][0], xc[1][1]); w0.w = cvt_pk_bf16(xc[1][2], xc[1][3]);
        w1.x = cvt_pk_bf16(xc[2][0], xc[2][1]); w1.y = cvt_pk_bf16(xc[2][2], xc[2][3]); w1.z = cvt_pk_bf16(xc[3][0], xc[3][1]); w1.w = cvt_pk_bf16(xc[3][2], xc[3][3]);
        *(LAS u32x4*)(XB + t * 136 + cg) = w0; *(LAS u32x4*)(XB + t * 136 + cg + 8) = w1;
    }
    __syncthreads();
    f32x4 accA[4], accX[4];
#pragma unroll
    for (int mt = 0; mt < 4; ++mt) { accA[mt] = (f32x4){0.f, 0.f, 0.f, 0.f}; accX[mt] = (f32x4){0.f, 0.f, 0.f, 0.f};
#pragma unroll
        for (int ks = 0; ks < 4; ++ks) { const bf16x8 af = *(const LAS bf16x8*)(XB + (16 * mt + c) * 136 + 32 * ks + 8 * g);
            accA[mt] = __builtin_amdgcn_mfma_f32_16x16x32_bf16(af, ba[ks], accA[mt], 0, 0, 0); accX[mt] = __builtin_amdgcn_mfma_f32_16x16x32_bf16(af, bx[ks], accX[mt], 0, 0, 0); } }
    const float c8 = -8.0f * log1pf(__expf(-lam));
    float av[4][4], bv[4][4];
#pragma unroll
    for (int mt = 0; mt < 4; ++mt)
#pragma unroll
        for (int e = 0; e < 4; ++e) { const float r = fast_sigmoid(accA[mt][e] + bra), ig = fast_sigmoid(accX[mt][e] + brx), la = c8 * r;
            const float a = __builtin_amdgcn_exp2f(la * LOG2E); av[mt][e] = a; bv[mt][e] = __builtin_amdgcn_sqrtf(neg_expm1(2.0f * la, a * a)) * ig * XF[(16 * mt + 4 * g + e) * 132 + cw]; }
    if (PASS == 1) {
        float Am[4], Bm[4];
#pragma unroll
        for (int mt = 0; mt < 4; ++mt) { Am[mt] = av[mt][0] * av[mt][1] * av[mt][2] * av[mt][3]; Bm[mt] = ((bv[mt][0] * av[mt][1] + bv[mt][1]) * av[mt][2] + bv[mt][2]) * av[mt][3] + bv[mt][3]; }
#pragma unroll
        for (int mt = 0; mt < 4; ++mt) { const float Ao = __shfl_xor(Am[mt], 16), Bo = __shfl_xor(Bm[mt], 16);
            const float A1 = (g & 1) ? Ao : Am[mt], B1 = (g & 1) ? Bo : Bm[mt], A2 = (g & 1) ? Am[mt] : Ao, B2 = (g & 1) ? Bm[mt] : Bo; Am[mt] = A1 * A2; Bm[mt] = A2 * B1 + B2; }
#pragma unroll
        for (int mt = 0; mt < 4; ++mt) { const float Ao = __shfl_xor(Am[mt], 32), Bo = __shfl_xor(Bm[mt], 32);
            const float A1 = (g & 2) ? Ao : Am[mt], B1 = (g & 2) ? Bo : Bm[mt], A2 = (g & 2) ? Am[mt] : Ao, B2 = (g & 2) ? Bm[mt] : Bo; Am[mt] = A1 * A2; Bm[mt] = A2 * B1 + B2; }
        float at = Am[0], ht = Bm[0];
#pragma unroll
        for (int mt = 1; mt < 4; ++mt) { ht = Am[mt] * ht + Bm[mt]; at *= Am[mt]; }
        if (g == 0) ((f32x2*)(P.ws + WS_LSUM))[((size_t)seq * 64 + chunk) * LW + ch] = (f32x2){at, ht};
        f32x4* ab = (f32x4*)(P.ws + WS_AB) + ((size_t)unit * 8 + wave) * 512 + lane;
#pragma unroll
        for (int mt = 0; mt < 4; ++mt) { ab[mt * 64] = (f32x4){av[mt][0], av[mt][1], av[mt][2], av[mt][3]}; ab[(4 + mt) * 64] = (f32x4){bv[mt][0], bv[mt][1], bv[mt][2], bv[mt][3]}; }
        __syncthreads();
        return;
    }
    float atot = 1.f;
    const int lastmt = rows / 16 - 1;
#pragma unroll
    for (int mt = 0; mt < 4; ++mt) {
        float A = av[mt][0] * av[mt][1] * av[mt][2] * av[mt][3];
        float B = ((bv[mt][0] * av[mt][1] + bv[mt][1]) * av[mt][2] + bv[mt][2]) * av[mt][3] + bv[mt][3];
        { const float Ap = __shfl_up(A, 16), Bp = __shfl_up(B, 16); if (g >= 1) { B = A * Bp + B; A = A * Ap; } }
        { const float Ap = __shfl_up(A, 32), Bp = __shfl_up(B, 32); if (g >= 2) { B = A * Bp + B; A = A * Ap; } }
        const float hend = A * hin + B;
        const float hprev = __shfl_up(hend, 16);
        if (PASS == 2) {
            float h = g == 0 ? hin : hprev;
#pragma unroll
            for (int e = 0; e < 4; ++e) { h = av[mt][e] * h + bv[mt][e]; XF[(16 * mt + 4 * g + e) * 132 + cw] = h; }
            if (mt == lastmt && g == 3 && (!prompt || chunk == 63)) { if (prompt) P.out[O_HP + (size_t)seq * LW + ch] = h; else P.out[O_HS + (size_t)(seq - NB) * LW + ch] = h; }
        }
        hin = __shfl(hend, c + 48); atot *= __shfl(A, c + 48);
    }
    if (PASS == 1) {
        if (g == 0) ((f32x2*)(P.ws + WS_LSUM))[((size_t)seq * 64 + chunk) * LW + ch] = (f32x2){atot, hin};
        f32x4* ab = (f32x4*)(P.ws + WS_AB) + ((size_t)unit * 8 + wave) * 512 + lane;
#pragma unroll
        for (int mt = 0; mt < 4; ++mt) { ab[mt * 64] = (f32x4){av[mt][0], av[mt][1], av[mt][2], av[mt][3]}; ab[(4 + mt) * 64] = (f32x4){bv[mt][0], bv[mt][1], bv[mt][2], bv[mt][3]}; }
    }
    if (PASS == 2) {
        __syncthreads();
        const int t = tid >> 3, cg = (tid & 7) * 16;
        if (t < rows) {
            const bf16* gp = (const bf16*)(P.ws + WS_GG) + (size_t)(m0 + t) * LW + n * 128 + cg; bf16* op = (bf16*)(P.ws + WS_MIX) + (size_t)(m0 + t) * D + AW + n * 128 + cg;
#pragma unroll
            for (int q = 0; q < 2; ++q) { const u32x4 gw4 = *(const u32x4*)(gp + 8 * q); const f32x4 h0 = *(const LAS f32x4*)(XF + t * 132 + cg + 8 * q), h1 = *(const LAS f32x4*)(XF + t * 132 + cg + 8 * q + 4);
                u32x4 w;
                w.x = cvt_pk_bf16(h0[0] * gelu_tanh(__uint_as_float(gw4.x << 16)), h0[1] * gelu_tanh(__uint_as_float(gw4.x & 0xffff0000u))); w.y = cvt_pk_bf16(h0[2] * gelu_tanh(__uint_as_float(gw4.y << 16)), h0[3] * gelu_tanh(__uint_as_float(gw4.y & 0xffff0000u)));
                w.z = cvt_pk_bf16(h1[0] * gelu_tanh(__uint_as_float(gw4.z << 16)), h1[1] * gelu_tanh(__uint_as_float(gw4.z & 0xffff0000u))); w.w = cvt_pk_bf16(h1[2] * gelu_tanh(__uint_as_float(gw4.w << 16)), h1[3] * gelu_tanh(__uint_as_float(gw4.w & 0xffff0000u)));
                *(u32x4*)(op + 8 * q) = w; }
        }
    }
    __syncthreads();
}

__device__ __forceinline__ void lru_final_wave(const Params& P, int wu, int lane) {
    asm volatile("" : "+v"(lane));
    const int unit = wu >> 3, w = wu & 7, n = unit & 15, chunk = (unit >> 4) & 63, seq = unit >> 10;
    const int c = lane & 15, g = lane >> 4, cw = w * 16 + c, ch = n * 128 + cw, m0 = seq * T + chunk * 64;
    const f32x4* ab = (const f32x4*)(P.ws + WS_AB) + (size_t)wu * 512 + lane;
    f32x4 a4[4], b4[4];
#pragma unroll
    for (int mt = 0; mt < 4; ++mt) { a4[mt] = ab[mt * 64]; b4[mt] = ab[(4 + mt) * 64]; }
    const bf16* gp = (const bf16*)(P.ws + WS_GG) + (size_t)m0 * LW + ch;
    bf16 gg[4][4];
#pragma unroll
    for (int mt = 0; mt < 4; ++mt)
#pragma unroll
        for (int e = 0; e < 4; ++e) gg[mt][e] = gp[(size_t)(16 * mt + 4 * g + e) * LW];
    float hin = 0.f;
    {
        const f32x2* ls = (const f32x2*)(P.ws + WS_LSUM) + (size_t)seq * 64 * LW + ch;
        f32x2 sm[16];
#pragma unroll
        for (int i = 0; i < 16; ++i) { const int ci = 16 * g + i; sm[i] = ci < chunk ? ls[(size_t)ci * LW] : (f32x2){1.f, 0.f}; }
        float Ag = 1.f, Hg = 0.f;
#pragma unroll
        for (int i = 0; i < 16; ++i) { Hg = sm[i][0] * Hg + sm[i][1]; Ag *= sm[i][0]; }
#pragma unroll
        for (int q = 0; q < 4; ++q) { const float Aq = __shfl(Ag, c + 16 * q), Hq = __shfl(Hg, c + 16 * q); hin = Aq * hin + Hq; }
    }
    bf16* op = (bf16*)(P.ws + WS_MIX) + (size_t)m0 * D + AW + ch;
#pragma unroll
    for (int mt = 0; mt < 4; ++mt) {
        float A = a4[mt][0] * a4[mt][1] * a4[mt][2] * a4[mt][3];
        float B = ((b4[mt][0] * a4[mt][1] + b4[mt][1]) * a4[mt][2] + b4[mt][2]) * a4[mt][3] + b4[mt][3];
        { const float Ap = __shfl_up(A, 16), Bp = __shfl_up(B, 16); if (g >= 1) { B = A * Bp + B; A = A * Ap; } }
        { const float Ap = __shfl_up(A, 32), Bp = __shfl_up(B, 32); if (g >= 2) { B = A * Bp + B; A = A * Ap; } }
        const float hend = A * hin + B;
        const float hprev = __shfl_up(hend, 16);
        float h = g == 0 ? hin : hprev;
#pragma unroll
        for (int e = 0; e < 4; ++e) { h = a4[mt][e] * h + b4[mt][e]; op[(size_t)(16 * mt + 4 * g + e) * D] = (bf16)f2bf(h * gelu_tanh(__uint_as_float((unsigned)gg[mt][e] << 16))); }
        if (mt == 3 && g == 3 && chunk == 63) P.out[O_HP + (size_t)seq * LW + ch] = h;
        hin = __shfl(hend, c + 48);
    }
}
#ifndef MK_N_LAUNCHES
#define MK_N_LAUNCHES 1
#endif
constexpr int N_PHASES = 8;
constexpr int LRU1_IN_P2 = 1536;
#ifndef PG8_SP2
#define PG8_SP2 true
#endif
#ifndef PG8_ALIGN
#define PG8_ALIGN true
#endif
#ifdef PROBE_SAME
struct SameOrder { int ntf; __device__ bool next(int i, pg8::Unit& u) const { if (i >= 12) return false; u.pm = PROBE_SAME ? (int)(blockIdx.x & 7) : 0; u.pn = PROBE_SAME ? (int)((blockIdx.x >> 3) & 3) + 4 * (i & 1) : 0; u.kb = 0; u.nt = ntf; u.part = -1; return true; }
    __device__ __forceinline__ void a_ready(const pg8::Unit&) const {} __device__ __forceinline__ void done(const pg8::Unit&) const {} };
#endif
__global__ void __launch_bounds__(NWAVES * 64, 2) fwd(Params P) {
    extern __shared__ __attribute__((aligned(16))) unsigned char lds_raw[];
    LAS unsigned char* lds = (LAS unsigned char*)lds_raw;
    const int tid = threadIdx.x, lane = tid & 63, wave = __builtin_amdgcn_readfirstlane(tid >> 6);
    const int G = gridDim.x, gw = blockIdx.x * NWAVES + wave, NGW = G * NWAVES;
    volatile LAS unsigned* MISC = (volatile LAS unsigned*)(lds + MISC_OFF);
    if (tid < 32) MISC[tid] = 0u;
    __syncthreads();
    unsigned* ctl = (unsigned*)(P.ws + WS_CTL);
    XcdBarrier bar; bar.bar = ctl + CW_BAR; bar.x = 0; bar.st = nullptr;
    if (MK_N_LAUNCHES == 1) bar = xcd_barrier_post(ctl + CW_BAR, MISC + 8);
    const int lo = P.ph_lo, hi = P.ph_hi;
#ifndef PHASE_MASK
#define PHASE_MASK 0xff
#endif
#define IN(k) (((PHASE_MASK >> (k)) & 1) && lo <= (k) && (k) < hi)
#define SEAM(k) do { if (IN(k) && IN((k) + 1)) xcd_barrier(bar); } while (0)
    unsigned char* ws = P.ws;
    float* mod = (float*)(ws + WS_MOD);
    bf16* U = (bf16*)(ws + WS_U);

#ifdef PROBE_NT
    if (lo == 9) {
        pg8::Gemm g{U, (const bf16*)(ws + WS_WGU), NTOK, 2 * DFF, D};
#ifdef PROBE_SAME
        SameOrder S; S.ntf = PROBE_NT;
        EpiGlu<0> E{(bf16*)(ws + WS_END), 1.0f, nullptr, nullptr};
#ifndef PROBE_VAR
#define PROBE_VAR 0
#endif
        pg8::gemm_phase<EpiGlu<0>, SameOrder, PG8_ALIGN, PG8_SP2, PROBE_VAR>(lds, g, S, E);
#else
        pg8::StaticOrder S; S.init(NTOK, 2 * DFF, D, G, (int)blockIdx.x); S.ntf = PROBE_NT;
        EpiGlu<0> E{(bf16*)(ws + WS_END), 1.0f, nullptr, nullptr};
        pg8::gemm_phase<EpiGlu<0>, pg8::StaticOrder, PG8_ALIGN, PG8_SP2>(lds, g, S, E);
#endif
    }
#endif
    if (IN(0)) {
        p0_amax(P, gw, NGW, lane);
        VM_WAIT(); __syncthreads();
        if (tid == 0) { __builtin_amdgcn_fence(__ATOMIC_RELEASE, "agent"); VM_WAIT(); __hip_atomic_fetch_add(ctl + CW_ARRIVE + 896, 1u, __ATOMIC_RELAXED, __HIP_MEMORY_SCOPE_AGENT); }
        if (P.sub & 16) p0_mod(P, lds, tid, wave, lane);
        VM_WAIT(); __syncthreads();
        if (tid == 0) { __builtin_amdgcn_fence(__ATOMIC_RELEASE, "agent"); VM_WAIT(); __hip_atomic_fetch_add(ctl + CW_ARRIVE + 512, 1u, __ATOMIC_RELAXED, __HIP_MEMORY_SCOPE_AGENT); }
        if (P.sub & 32) p0_convert(P, lds, gw, NGW, wave, lane);
    }
    if (IN(1)) {
        if (tid == 0) {
            unsigned sp = 0;
            while (__hip_atomic_load(ctl + CW_ARRIVE + 512, __ATOMIC_RELAXED, __HIP_MEMORY_SCOPE_AGENT) < (unsigned)G) { __builtin_amdgcn_s_sleep(2);
                if ((++sp & 255u) == 0u) { if (__hip_atomic_load(ctl + CW_TMO2, __ATOMIC_RELAXED, __HIP_MEMORY_SCOPE_AGENT)) break; if (sp > (1u << 20)) { __hip_atomic_store(ctl + CW_TMO2, 1u, __ATOMIC_RELAXED, __HIP_MEMORY_SCOPE_AGENT); break; } } }
            __builtin_amdgcn_fence(__ATOMIC_ACQUIRE, "agent"); VM_WAIT();
        }
        __syncthreads();
        norm_sample_split<false>(P, lds, P.in[I_XS], P.in[I_G1], mod, 0 * D, 1 * D, U, nullptr, nullptr, wave, lane);
        norm_rows<false>(P.in[I_XP], P.in[I_XS], P.in[I_G1], mod, 0 * D, 1 * D, U, nullptr, nullptr, NPR, gw, NGW, lane);
    }
    SEAM(1);
    if (IN(2)) {
        pg8::Gemm g{U, (const bf16*)(ws + WS_WIN), NTOK, INC, D}; InOrder S; S.init(G, (int)blockIdx.x);
        EpiIn E{(bf16*)(ws + WS_Q), (bf16*)(ws + WS_K), (bf16*)(ws + WS_VTP), (bf16*)(ws + WS_VTS), (float*)(ws + WS_XR), (bf16*)(ws + WS_GG), P.out, P.in[I_QG], P.in[I_KG], (LAS float*)(lds + XCH_OFF)};
        pg8::gemm_phase<EpiIn, InOrder, PG8_ALIGN, PG8_SP2>(lds, g, S, E);
        VM_WAIT(); __syncthreads();
        if (tid == 0) { __builtin_amdgcn_fence(__ATOMIC_RELEASE, "agent"); VM_WAIT(); __hip_atomic_fetch_add(ctl + CW_ARRIVE, 1u, __ATOMIC_RELAXED, __HIP_MEMORY_SCOPE_AGENT); }
        S.mode = 1;
        pg8::gemm_phase<EpiIn, InOrder, PG8_ALIGN, PG8_SP2>(lds, g, S, E);
        if (tid == 0) {
            unsigned sp = 0;
            while (__hip_atomic_load(ctl + CW_ARRIVE, __ATOMIC_RELAXED, __HIP_MEMORY_SCOPE_AGENT) < (unsigned)G) { __builtin_amdgcn_s_sleep(2);
                if ((++sp & 255u) == 0u) { if (__hip_atomic_load(ctl + CW_TMO2, __ATOMIC_RELAXED, __HIP_MEMORY_SCOPE_AGENT)) break; if (sp > (1u << 20)) { __hip_atomic_store(ctl + CW_TMO2, 1u, __ATOMIC_RELAXED, __HIP_MEMORY_SCOPE_AGENT); break; } } }
            __builtin_amdgcn_fence(__ATOMIC_ACQUIRE, "agent"); VM_WAIT();
        }
        __syncthreads();
        if (P.sub & 1) {
            unsigned nextu = 0; if (tid == 0) nextu = __hip_atomic_fetch_add(ctl + CW_LQ, 1u, __ATOMIC_RELAXED, __HIP_MEMORY_SCOPE_AGENT);
            for (;;) {
                if (tid == 0) MISC[16] = nextu;
                __syncthreads();
                const int u = (int)MISC[16];
                if (u >= LRU1_IN_P2) break;
                if (tid == 0) nextu = __hip_atomic_fetch_add(ctl + CW_LQ, 1u, __ATOMIC_RELAXED, __HIP_MEMORY_SCOPE_AGENT);
                lru_unit<1>(P, lds, u, tid, wave, lane);
            }
        }
    }
    SEAM(2);
    if (IN(3)) {
        if (P.sub & 1) for (int u = LRU1_IN_P2 + (int)blockIdx.x; u < NB * 64 * 16; u += G) lru_unit<1>(P, lds, u, tid, wave, lane);
        VM_WAIT(); __syncthreads();
        if (tid == 0) { __builtin_amdgcn_fence(__ATOMIC_RELEASE, "agent"); VM_WAIT(); __hip_atomic_fetch_add(ctl + CW_ARRIVE + 768, 1u, __ATOMIC_RELAXED, __HIP_MEMORY_SCOPE_AGENT); }
        attn_phase(P, lds, tid, wave, lane);
        if (P.sub & 8) {
            constexpr int NWU = NB * 64 * 16 * 8; const int per = (NWU + G - 1) / G, w0 = (int)blockIdx.x * per, w1 = w0 + per < NWU ? w0 + per : NWU;
            for (;;) {
                int idx = 0; if (lane == 0) idx = (int)__hip_atomic_fetch_add((LAS unsigned*)(lds + MISC_OFF) + 17, 1u, __ATOMIC_RELAXED, __HIP_MEMORY_SCOPE_WORKGROUP);
                idx = __builtin_amdgcn_readfirstlane(idx);
                if (w0 + idx >= w1) break;
                lru_final_wave(P, w0 + idx, lane);
            }
        }
        __syncthreads();
        if (P.sub & 8) for (int u = NB * 64 * 16 + blockIdx.x; u < NB * 64 * 16 + SB * 16; u += G) lru_unit<2>(P, lds, u, tid, wave, lane);
    }
    SEAM(3);
    if (IN(4)) {
        pg8::Gemm g{(const bf16*)(ws + WS_MIX), (const bf16*)(ws + WS_WOUT), NTOK, D, D}; SplitOrder S; S.init(D, G, (int)blockIdx.x);
        EpiRes<false, true> E{P.in[I_XP], ws + WS_X1, mod + 2 * D, (float*)(ws + WS_SLAB), (P.sub >> 6) & 1, 1.0f};
        pg8::gemm_phase<EpiRes<false, true>, SplitOrder, PG8_ALIGN, PG8_SP2>(lds, g, S, E);
    }
    SEAM(4);
    if (IN(5)) {
        norm_sample_split<true, 2>(P, lds, P.in[I_XS], P.in[I_G2], mod, 3 * D, 4 * D, U, (const float*)(ws + WS_SLAB), (float*)(ws + WS_X1) + (size_t)NPR * D, wave, lane, (float*)(ws + WS_CTL + WS_SU));
        norm_rows<true, 2>((const float*)(ws + WS_X1), P.in[I_XS], P.in[I_G2], mod, 3 * D, 4 * D, U, nullptr, nullptr, NPR, gw, NGW, lane, (float*)(ws + WS_CTL + WS_SU));
    }
    SEAM(5);
    if (IN(6)) {
        pg8::Gemm g{U, (const bf16*)(ws + WS_WGU), NTOK, 2 * DFF, D / 2}; GluOrder S; S.init(D / 2, G, (int)blockIdx.x); S.mode = 1;
        EpiGlu<2> E{(bf16*)(ws + WS_H), 1.0f, (const float*)(ws + WS_CTL + WS_SU), (const float*)(ws + WS_CTL + WS_AMAX)};
        pg8::gemm_phase<EpiGlu<2>, GluOrder, PG8_ALIGN, PG8_SP2, 0, 2>(lds, g, S, E);
        VM_WAIT(); __syncthreads();
        if (tid == 0) { __builtin_amdgcn_fence(__ATOMIC_RELEASE, "agent"); VM_WAIT(); __hip_atomic_fetch_add(ctl + CW_ARRIVE + 256, 1u, __ATOMIC_RELAXED, __HIP_MEMORY_SCOPE_AGENT); }
        S.mode = 0;
        pg8::gemm_phase<EpiGlu<2>, GluOrder, PG8_ALIGN, PG8_SP2, 0, 2>(lds, g, S, E);
        if (tid == 0) {
            unsigned sp = 0;
            while (__hip_atomic_load(ctl + CW_ARRIVE + 256, __ATOMIC_RELAXED, __HIP_MEMORY_SCOPE_AGENT) < (unsigned)G) { __builtin_amdgcn_s_sleep(2);
                if ((++sp & 255u) == 0u) { if (__hip_atomic_load(ctl + CW_TMO2, __ATOMIC_RELAXED, __HIP_MEMORY_SCOPE_AGENT)) break; if (sp > (1u << 20)) { __hip_atomic_store(ctl + CW_TMO2, 1u, __ATOMIC_RELAXED, __HIP_MEMORY_SCOPE_AGENT); break; } } }
            __builtin_amdgcn_fence(__ATOMIC_ACQUIRE, "agent"); VM_WAIT();
        }
        __syncthreads();
        constexpr int KD = F8_DOWN ? DFF / 2 : DFF;
        pg8::Gemm g2{(const bf16*)(ws + WS_H), (const bf16*)(ws + WS_WD), NTOK, D, KD}; TailSplit S2; S2.init(KD, G, (int)blockIdx.x);
        EpiRes<true, false> E2{ws + WS_X1, P.out + O_Y, mod + 5 * D, (float*)(ws + WS_SLAB), 0, F8_DOWN ? W8_INV : 1.0f};
        pg8::gemm_phase<EpiRes<true, false>, TailSplit, PG8_ALIGN, PG8_SP2, 0, F8_DOWN ? 1 : 0>(lds, g2, S2, E2);
    }
    SEAM(6);
    if (IN(7)) {
        {
            const float* slab = (const float*)(ws + WS_SLAB); const float* x1s = (const float*)(ws + WS_X1) + (size_t)NPR * D; float* ys = P.out + O_Y + (size_t)NPR * D;
            for (int t = gw; t < NSA * 4; t += NGW) {
                const int r = t >> 2, col0 = 1024 * (t & 3);
                f32x4 v[4];
#pragma unroll
                for (int j = 0; j < 4; ++j) v[j] = *(const f32x4*)(x1s + (size_t)r * D + col0 + 4 * (lane + 64 * j));
#pragma unroll
                for (int q = 0; q < 8; ++q)
#pragma unroll
                    for (int j = 0; j < 4; ++j) v[j] += *(const f32x4*)(slab + ((size_t)q * NSA + r) * D + col0 + 4 * (lane + 64 * j));
#pragma unroll
                for (int j = 0; j < 4; ++j) *(f32x4*)(ys + (size_t)r * D + col0 + 4 * (lane + 64 * j)) = v[j];
            }
        }
        constexpr int KD = F8_DOWN ? DFF / 2 : DFF;
        pg8::Gemm g{(const bf16*)(ws + WS_H), (const bf16*)(ws + WS_WD), NTOK, D, KD}; pg8::StaticOrder S; S.init(NPR, D, KD, G, (int)blockIdx.x);
        EpiRes<true, false> E{ws + WS_X1, P.out + O_Y, mod + 5 * D, (float*)(ws + WS_SLAB), (P.sub >> 6) & 1, F8_DOWN ? W8_INV : 1.0f};
        pg8::gemm_phase<EpiRes<true, false>, pg8::StaticOrder, PG8_ALIGN, PG8_SP2, 0, F8_DOWN ? 1 : 0>(lds, g, S, E);
    }
#undef IN
#undef SEAM
}

extern "C" void kernel_launch(void* const* d_in, const int* in_sizes, int n_in, void* d_out, int out_size, void* d_ws, size_t ws_size, hipStream_t stream) {
    static int grid = 0;
    if (grid == 0) {
        if (n_in != 27 || in_sizes[0] != NPR * D || out_size != (int)O_END || ws_size < WS_END2) {
            fprintf(stderr, "kernel_launch: built for 27 inputs, x_prompt of %d floats, %zu outputs, >= %zu bytes of workspace; got n_in %d, in0 %d, out %d, ws %zu; nothing launched\n", NPR * D, (size_t)O_END, (size_t)WS_END2, n_in, n_in > 0 ? in_sizes[0] : -1, out_size, ws_size);
            grid = -1; return; }
        int dev = 0, cus = 0, per_cu = 0;
        if (hipGetDevice(&dev) != hipSuccess || hipDeviceGetAttribute(&cus, hipDeviceAttributeMultiprocessorCount, dev) != hipSuccess) { fprintf(stderr, "kernel_launch: device query failed\n"); grid = -1; return; }
        if (hipFuncSetAttribute((const void*)fwd, hipFuncAttributeMaxDynamicSharedMemorySize, LDS_BYTES) != hipSuccess) { fprintf(stderr, "kernel_launch: hipFuncSetAttribute failed\n"); grid = -1; return; }
        if (hipOccupancyMaxActiveBlocksPerMultiprocessor(&per_cu, (const void*)fwd, NWAVES * 64, LDS_BYTES) != hipSuccess || per_cu < 1)
            fprintf(stderr, "kernel_launch: note: occupancy query reports %d workgroups per CU\n", per_cu);
        (void)hipGetLastError();
        grid = cus;
    }
    if (grid < 0) return;
    if (hipMemsetAsync((char*)d_ws + WS_CTL, 0, CTL_ZERO_BYTES, stream) != hipSuccess) { fprintf(stderr, "kernel_launch: hipMemsetAsync failed\n"); return; }
    Params p{};
    for (int i = 0; i < 27; ++i) p.in[i] = (const float*)d_in[i];
    p.out = (float*)d_out; p.ws = (unsigned char*)d_ws; p.sub = 63;
#ifdef PROBE_PREFIX
    p.ph_lo = 0; p.ph_hi = PROBE_PREFIX;
#ifdef PROBE_SUB
    p.sub = PROBE_SUB;
#endif
    hipLaunchKernelGGL(fwd, dim3(grid), dim3(NWAVES * 64), LDS_BYTES, stream, p);
    (void)hipMemsetAsync((char*)d_ws + WS_CTL, 0, CTL_ZERO_BYTES, stream);
    p.sub = 63;
#endif
    for (int li = 0; li < MK_N_LAUNCHES; ++li) {
        p.ph_lo = (MK_N_LAUNCHES == 1) ? 0 : li; p.ph_hi = (MK_N_LAUNCHES == 1) ? N_PHASES : li + 1;
        hipLaunchKernelGGL(fwd, dim3(grid), dim3(NWAVES * 64), LDS_BYTES, stream, p);
        const hipError_t le = hipPeekAtLastError();
        if (le != hipSuccess) { fprintf(stderr, "kernel_launch: launch %d failed: %s\n", li, hipGetErrorName(le)); break; }
    }
#ifdef PROBE_PHASE
    p.ph_lo = PROBE_PHASE; p.ph_hi = PROBE_PHASE + 1;
#ifdef PROBE_SUB
    p.sub = PROBE_SUB;
#endif
    hipLaunchKernelGGL(fwd, dim3(grid), dim3(NWAVES * 64), LDS_BYTES, stream, p);
#endif
}
```

```cpp
#include <hip/hip_runtime.h>
#include <cstdio>
#include <cstdint>
namespace pg8 {
#define PG8_LAS __attribute__((address_space(3)))
typedef unsigned short bf16_t;
typedef short bf16x8 __attribute__((ext_vector_type(8)));
typedef float f32x4 __attribute__((ext_vector_type(4)));
typedef unsigned u32x4 __attribute__((ext_vector_type(4)));
typedef int i32x4 __attribute__((ext_vector_type(4)));
typedef int i32x8 __attribute__((ext_vector_type(8)));
constexpr int BM = 256, BK = 64, HALF = 128, HTB = HALF * BK * 2  , STAGE_BYTES = 8 * HTB, NXCD = 8, WGM = 8;

__host__ __device__ __forceinline__ int lds_byte(int r, int c) { const int st = (r >> 4) * 2 + (c >> 5), rr = r & 15, cc = c & 31, ob = rr * 64 + cc * 2; return st * 1024 + (ob ^ (((ob >> 9) & 1) << 5)); }
__host__ __device__ __forceinline__ void stage_rc(int b, int& R, int& C) { const int st = b / 1024, sb = b % 1024, swz = sb ^ (((sb >> 9) & 1) << 5); R = (st >> 1) * 16 + swz / 64; C = (st & 1) * 32 + (swz % 64) / 2; }
__host__ __device__ __forceinline__ int perm32(int rho) { const int n = rho >> 4, i = rho & 15; return 8 * (i >> 2) + 4 * n + (i & 3); }

struct Unit { int pm, pn, kb, nt, part; };
struct Gemm { const bf16_t* A; const bf16_t* Bt; int M, N, K; };

struct StaticOrder {
    int nM, nN, nwg, G, c, ntf;
    __host__ __device__ void init(int M, int N, int K, int G_, int c_) { nM = M / BM; nN = N / BM; nwg = nM * nN; G = G_; c = c_; ntf = K / BK; }
    __host__ __device__ bool next(int i, Unit& u) const {
        const long L = (long)i * G + c; if (L >= nwg) return false;
        int wgid = (int)L; { const int q = nwg / NXCD, r = nwg % NXCD, xcd = wgid % NXCD, off = wgid / NXCD; wgid = (xcd < r ? xcd * (q + 1) : r * (q + 1) + (xcd - r) * q) + off; }
        const int nig = WGM * nN, gid = wgid / nig, fm = gid * WGM, gsz = (nM - fm) < WGM ? (nM - fm) : WGM;
        u.pm = fm + ((wgid % nig) % gsz); u.pn = (wgid % nig) / gsz; u.kb = 0; u.nt = ntf; u.part = -1; return true;
    }
    __device__ __forceinline__ void a_ready(const Unit&) const {}
    __device__ __forceinline__ void done(const Unit&) const {}
};
__device__ __forceinline__ unsigned cvt_pk_bf16(float lo, float hi) { unsigned r; asm volatile("v_cvt_pk_bf16_f32 %0, %1, %2" : "=v"(r) : "v"(lo), "v"(hi)); return r; }
typedef float f32x2 __attribute__((ext_vector_type(2)));
#ifndef F8_OUT
#define F8_OUT true
#endif
#ifndef F8_DOWN
#define F8_DOWN true
#endif
constexpr float W8_SCALE = 512.f, W8_INV = 1.f / 512.f;
__device__ __forceinline__ unsigned pk4_fp8(float a, float b, float c, float d) {
    a = __builtin_amdgcn_fmed3f(a, -448.f, 448.f); b = __builtin_amdgcn_fmed3f(b, -448.f, 448.f); c = __builtin_amdgcn_fmed3f(c, -448.f, 448.f); d = __builtin_amdgcn_fmed3f(d, -448.f, 448.f);
    int w = __builtin_amdgcn_cvt_pk_fp8_f32(a, b, 0, false); w = __builtin_amdgcn_cvt_pk_fp8_f32(c, d, w, true); return (unsigned)w; }
__device__ __forceinline__ unsigned pk4_i8(float a, float b, float c, float d, float inv) {
    const unsigned ua = __builtin_bit_cast(unsigned, __builtin_fmaf(a, inv, 12582912.f)), ub = __builtin_bit_cast(unsigned, __builtin_fmaf(b, inv, 12582912.f)),
                   uc = __builtin_bit_cast(unsigned, __builtin_fmaf(c, inv, 12582912.f)), ud = __builtin_bit_cast(unsigned, __builtin_fmaf(d, inv, 12582912.f));
    return (ua & 0xffu) | ((ub & 0xffu) << 8) | ((uc & 0xffu) << 16) | (ud << 24); }
#ifndef PG8_KOUTER
#define PG8_KOUTER 1
#endif
template <class Epi, class Sched, bool ALIGN_EPI = false, bool SP2 = false, int VAR = 0, int QM = 0>
__device__ __forceinline__ void gemm_phase(PG8_LAS unsigned char* lds, const Gemm g, const Sched& S, const Epi& E) {
    const int tid = threadIdx.x, wid = __builtin_amdgcn_readfirstlane(tid >> 6), lane = tid & 63, wr = wid >> 2, wc = wid & 3, fr = lane & 15, fq = lane >> 4;
    const int K = g.K; int nt;
    unsigned voffA[2], voffB[2];
#pragma unroll
    for (int i = 0; i < 2; ++i) { int R, C; stage_rc(tid * 16 + i * 8192, R, C); const int Rb = Epi::PERM ? ((R & ~31) + perm32(R & 31)) : R;
        voffA[i] = (unsigned)(R * K + C) * 2u; voffB[i] = (unsigned)(Rb * K + C) * 2u; }
    const size_t kstep = (size_t)(BK * 2);
    const size_t hstep = (size_t)HALF * K * 2;
    const size_t tstep = 2 * hstep;
    const unsigned ldsw = (unsigned)wid * 1024u;
    const int aoff = lds_byte(wr * 64 + fr, fq * 8), boff = lds_byte(wc * 32 + fr, fq * 8);
#define PG8_SA(b, h) (((b) * 2 + (h)) * HTB)
#define PG8_SB(b, h) ((4 + (b) * 2 + (h)) * HTB)
#define PG8_STAGE(bufoff, gbase, voff) do { if constexpr (VAR != 3) { _Pragma("unroll") for (int _i = 0; _i < 2; ++_i) \
        __builtin_amdgcn_global_load_lds((const unsigned*)((const char*)(gbase) + (voff)[_i]), (PG8_LAS unsigned*)(lds + (bufoff) + ldsw + _i * 8192), 16, 0, 0); } } while (0)
#define PG8_LDA(dst, b, h) do { if constexpr (VAR != 2) _Pragma("unroll") for (int m = 0; m < 4; ++m) _Pragma("unroll") for (int k = 0; k < 2; ++k) dst[m][k] = *(const PG8_LAS bf16x8*)(lds + PG8_SA(b, h) + aoff + m * 2048 + k * 1024); } while (0)
#define PG8_LDB(dst, b, h) do { if constexpr (VAR != 2) _Pragma("unroll") for (int n = 0; n < 2; ++n) _Pragma("unroll") for (int k = 0; k < 2; ++k) dst[n][k] = *(const PG8_LAS bf16x8*)(lds + PG8_SB(b, h) + boff + n * 2048 + k * 1024); } while (0)
#define PG8_MMA(ai, bj, At, Bt) do { if constexpr (VAR != 5) __builtin_amdgcn_s_setprio(1); \
        if constexpr (QM == 2) { _Pragma("unroll") for (int k = 0; k < 2; ++k) _Pragma("unroll") for (int m = 0; m < 4; ++m) _Pragma("unroll") for (int n = 0; n < 2; ++n) \
            acc[ai][bj][m][n] = __builtin_bit_cast(f32x4, __builtin_amdgcn_mfma_i32_16x16x64_i8(__builtin_bit_cast(i32x4, Bt[n][k]), __builtin_bit_cast(i32x4, At[m][k]), __builtin_bit_cast(i32x4, acc[ai][bj][m][n]), 0, 0, 0)); } \
        else if constexpr (QM == 1) { _Pragma("unroll") for (int m = 0; m < 4; ++m) _Pragma("unroll") for (int n = 0; n < 2; ++n) \
            asm volatile("v_mfma_f32_16x16x128_f8f6f4 %0, %1, %2, %0" : "+v"(acc[ai][bj][m][n]) : "v"(__builtin_shufflevector(__builtin_bit_cast(i32x4, Bt[n][0]), __builtin_bit_cast(i32x4, Bt[n][1]), 0, 1, 2, 3, 4, 5, 6, 7)), \
                "v"(__builtin_shufflevector(__builtin_bit_cast(i32x4, At[m][0]), __builtin_bit_cast(i32x4, At[m][1]), 0, 1, 2, 3, 4, 5, 6, 7))); } \
        else if constexpr (VAR == 4 || (VAR == 0 && PG8_KOUTER)) { _Pragma("unroll") for (int k = 0; k < 2; ++k) _Pragma("unroll") for (int m = 0; m < 4; ++m) _Pragma("unroll") for (int n = 0; n < 2; ++n) \
            acc[ai][bj][m][n] = __builtin_amdgcn_mfma_f32_16x16x32_bf16(Bt[n][k], At[m][k], acc[ai][bj][m][n], 0, 0, 0); } \
        else { _Pragma("unroll") for (int m = 0; m < 4; ++m) _Pragma("unroll") for (int n = 0; n < 2; ++n) _Pragma("unroll") for (int k = 0; k < (VAR == 1 ? 1 : 2); ++k) \
            acc[ai][bj][m][n] = __builtin_amdgcn_mfma_f32_16x16x32_bf16(Bt[n][k], At[m][k], acc[ai][bj][m][n], 0, 0, 0); } \
        if constexpr (VAR != 5) __builtin_amdgcn_s_setprio(0); } while (0)
#define PG8_WAIT_V(n) asm volatile("s_waitcnt vmcnt(" #n ")" ::: "memory")
#define PG8_WAIT_L(n) asm volatile("s_waitcnt lgkmcnt(" #n ")" ::: "memory")
#define PG8_BAR __builtin_amdgcn_s_barrier()
#define PG8_SCHED __builtin_amdgcn_sched_barrier(0)
    Unit cur, nxt; int ui = 0;
    if (!S.next(0, cur)) return;
    nt = cur.nt;
    f32x4 acc[2][2][4][2];
#pragma unroll
    for (int a = 0; a < 2; ++a)
#pragma unroll
        for (int b = 0; b < 2; ++b)
#pragma unroll
            for (int m = 0; m < 4; ++m)
#pragma unroll
                for (int n = 0; n < 2; ++n) acc[a][b][m][n] = (f32x4){0.f, 0.f, 0.f, 0.f};
    bf16x8 At[4][2], B0[2][2], B1[2][2];
    const char* cA = (const char*)g.A + (size_t)cur.pm * tstep + (size_t)cur.kb * kstep; const char* cB = (const char*)g.Bt + (size_t)cur.pn * tstep + (size_t)cur.kb * kstep;
    S.a_ready(cur);
    if constexpr (SP2) {
        PG8_STAGE(PG8_SB(0, 0), cB, voffB); PG8_STAGE(PG8_SB(0, 1), cB + hstep, voffB); PG8_STAGE(PG8_SA(0, 0), cA, voffA); PG8_STAGE(PG8_SA(0, 1), cA + hstep, voffA);
        if (wr == 1) PG8_BAR;
        PG8_WAIT_V(2); PG8_BAR;
        PG8_STAGE(PG8_SB(1, 0), cB + kstep, voffB); PG8_STAGE(PG8_SA(1, 0), cA + kstep, voffA); PG8_STAGE(PG8_SB(1, 1), cB + hstep + kstep, voffB);
        PG8_WAIT_V(6); PG8_BAR;
    } else {
        PG8_STAGE(PG8_SB(0, 0), cB, voffB); PG8_STAGE(PG8_SA(0, 0), cA, voffA); PG8_STAGE(PG8_SB(0, 1), cB + hstep, voffB); PG8_STAGE(PG8_SA(0, 1), cA + hstep, voffA);
        if (wr == 1) PG8_BAR;
        PG8_WAIT_V(4); PG8_BAR;
        PG8_STAGE(PG8_SB(1, 0), cB + kstep, voffB); PG8_STAGE(PG8_SA(1, 0), cA + kstep, voffA); PG8_STAGE(PG8_SB(1, 1), cB + hstep + kstep, voffB);
        PG8_WAIT_V(6); PG8_BAR;
    }
    for (;;) {
        const bool has_next = S.next(ui + 1, nxt);
        const char* nA = has_next ? (const char*)g.A + (size_t)nxt.pm * tstep + (size_t)nxt.kb * kstep : cA; const char* nB = has_next ? (const char*)g.Bt + (size_t)nxt.pn * tstep + (size_t)nxt.kb * kstep : cB;
        for (int t = 0; t < nt; t += 2) {
            const bool last = (t == nt - 2);
            const char* a1 = cA + (size_t)(t + 1) * kstep;
            const char* a2 = last ? nA : cA + (size_t)(t + 2) * kstep; const char* b2 = last ? nB : cB + (size_t)(t + 2) * kstep;
            const char* a3 = a2 + kstep; const char* b3 = b2 + kstep;
            if (last && has_next) S.a_ready(nxt);
            if constexpr (SP2) {
            PG8_LDB(B0, 0, 0); PG8_LDB(B1, 0, 1); PG8_SCHED; PG8_LDA(At, 0, 0); PG8_STAGE(PG8_SA(1, 1), a1 + hstep, voffA);
            PG8_WAIT_V(8); PG8_WAIT_L(0); PG8_BAR; PG8_MMA(0, 0, At, B0); PG8_MMA(0, 1, At, B1); PG8_BAR; PG8_SCHED;
            PG8_LDA(At, 0, 1); PG8_STAGE(PG8_SB(0, 0), b2, voffB); PG8_STAGE(PG8_SB(0, 1), b2 + hstep, voffB); PG8_STAGE(PG8_SA(0, 0), a2, voffA);
            PG8_WAIT_V(8); PG8_WAIT_L(0); PG8_BAR; PG8_MMA(1, 0, At, B0); PG8_MMA(1, 1, At, B1); PG8_BAR; PG8_SCHED;
            PG8_LDB(B0, 1, 0); PG8_LDB(B1, 1, 1); PG8_SCHED; PG8_LDA(At, 1, 0); PG8_STAGE(PG8_SA(0, 1), a2 + hstep, voffA);
            PG8_WAIT_V(8); PG8_WAIT_L(0); PG8_BAR; PG8_MMA(0, 0, At, B0); PG8_MMA(0, 1, At, B1); PG8_BAR; PG8_SCHED;
            PG8_LDA(At, 1, 1); PG8_STAGE(PG8_SB(1, 0), b3, voffB); PG8_STAGE(PG8_SB(1, 1), b3 + hstep, voffB); PG8_STAGE(PG8_SA(1, 0), a3, voffA);
            PG8_WAIT_V(8); PG8_WAIT_L(0); PG8_BAR; PG8_MMA(1, 0, At, B0); PG8_MMA(1, 1, At, B1); PG8_BAR; PG8_SCHED;
            } else {
            PG8_LDB(B0, 0, 0); PG8_SCHED; PG8_LDA(At, 0, 0); PG8_STAGE(PG8_SA(1, 1), a1 + hstep, voffA);
            PG8_WAIT_L(8); PG8_BAR; PG8_WAIT_L(0); PG8_MMA(0, 0, At, B0); PG8_BAR; PG8_SCHED;
            PG8_LDB(B1, 0, 1); PG8_STAGE(PG8_SB(0, 0), b2, voffB);
            PG8_BAR; PG8_WAIT_L(0); PG8_MMA(0, 1, At, B1); PG8_BAR;
            PG8_LDA(At, 0, 1); PG8_STAGE(PG8_SA(0, 0), a2, voffA);
            PG8_BAR; PG8_WAIT_L(0); PG8_MMA(1, 0, At, B0); PG8_BAR; PG8_SCHED;
            PG8_STAGE(PG8_SB(0, 1), b2 + hstep, voffB);
            PG8_WAIT_V(6); PG8_BAR; PG8_MMA(1, 1, At, B1); PG8_BAR;
            PG8_LDB(B0, 1, 0); PG8_SCHED; PG8_LDA(At, 1, 0); PG8_STAGE(PG8_SA(0, 1), a2 + hstep, voffA);
            PG8_WAIT_L(8); PG8_BAR; PG8_WAIT_L(0); PG8_MMA(0, 0, At, B0); PG8_BAR; PG8_SCHED;
            PG8_LDB(B1, 1, 1); PG8_STAGE(PG8_SB(1, 0), b3, voffB);
            PG8_BAR; PG8_WAIT_L(0); PG8_MMA(0, 1, At, B1); PG8_BAR;
            PG8_LDA(At, 1, 1); PG8_STAGE(PG8_SA(1, 0), a3, voffA);
            PG8_BAR; PG8_WAIT_L(0); PG8_MMA(1, 0, At, B0); PG8_BAR; PG8_SCHED;
            PG8_STAGE(PG8_SB(1, 1), b3 + hstep, voffB);
            PG8_WAIT_V(6); PG8_BAR; PG8_MMA(1, 1, At, B1); PG8_BAR;
            }
        }
        if constexpr (ALIGN_EPI) { if (wr == 0) PG8_BAR; }
        if constexpr (QM == 1) { PG8_SCHED; asm volatile("s_nop 15\n\ts_nop 7" ::: "memory"); PG8_SCHED; }
        if constexpr (!Epi::AFTER_DRAIN) { E(acc, cur, wr, wc, fr, fq); S.done(cur); }
        if (!has_next) break;
#pragma unroll
        for (int a = 0; a < 2; ++a)
#pragma unroll
            for (int b = 0; b < 2; ++b)
#pragma unroll
                for (int m = 0; m < 4; ++m)
#pragma unroll
                    for (int n = 0; n < 2; ++n) acc[a][b][m][n] = (f32x4){0.f, 0.f, 0.f, 0.f};
        cur = nxt; cA = nA; cB = nB; ++ui; nt = cur.nt;
        if constexpr (ALIGN_EPI) { if (wr == 1) PG8_BAR; }
    }
    PG8_WAIT_V(0);
    if constexpr (!ALIGN_EPI) { if (wr == 0) PG8_BAR; }
    PG8_BAR;
    if constexpr (Epi::AFTER_DRAIN) { E.fused(acc, cur, wr, wc, fr, fq, lds, wid, lane); S.done(cur); }
#undef PG8_SA
#undef PG8_SB
#undef PG8_STAGE
#undef PG8_LDA
#undef PG8_LDB
#undef PG8_MMA
#undef PG8_WAIT_V
#undef PG8_WAIT_L
#undef PG8_BAR
#undef PG8_SCHED
}
}
constexpr int D = 4096, T = 4096, NB = 2, NPR = NB * T, SB = 16, ST = 32, NSA = SB * ST, NTOK = NPR + NSA;
constexpr int NSEQ = NB + SB, AW = 2048, LW = 2048, HD = 128, NH = 16, DFF = 11008, INC = 10240, NMOD = 6 * D;
constexpr int CROWS = 512, KS_LD = 544;
constexpr float RMS_EPS = 1e-6f;
constexpr float QSCALE = 0.08838834764831845f * 1.4426950408889634f;
constexpr float LOG2E = 1.4426950408889634f;
constexpr size_t O_Y = 0, O_KP = (size_t)NTOK * D, O_VP = O_KP + (size_t)NB * 512 * AW, O_CP = O_VP + (size_t)NB * 512 * AW, O_HP = O_CP + (size_t)NB * 3 * LW,
                 O_KS = O_HP + (size_t)NB * LW, O_VS = O_KS + (size_t)NSA * AW, O_CS = O_VS + (size_t)NSA * AW, O_HS = O_CS + (size_t)SB * 3 * LW, O_END = O_HS + (size_t)SB * LW;
static_assert(O_END == 42090496, "output size");
constexpr size_t MiB = 1u << 20;
constexpr size_t WS_CTL = 0, CTL_ZERO_BYTES = 32768 + 90112, WS_AMAX = 32768  , WS_SU = 131072  ;
constexpr size_t WS_MOD = 1 * MiB, WS_LSUM = 3 * MiB, WS_WRG = 5 * MiB, WS_WIN = 6 * MiB, WS_WOUT = 86 * MiB, WS_WGU = 118 * MiB, WS_WD = 290 * MiB, WS_U = 376 * MiB,
                 WS_Q = 444 * MiB, WS_K = 478 * MiB, WS_KC = 512 * MiB, WS_VTP = 544 * MiB, WS_VTS = 576 * MiB, WS_XR = 610 * MiB, WS_GG = 678 * MiB, WS_MIX = 712 * MiB,
                 WS_X1 = 780 * MiB, WS_H = 916 * MiB, WS_END = 1099 * MiB;
static_assert(WS_H + (size_t)NTOK * DFF * 2 <= WS_END && WS_X1 + (size_t)NTOK * D * 4 <= WS_H && WS_WGU + (size_t)2 * DFF * D * 2 <= WS_WD && WS_WD + (size_t)D * DFF * 2 <= WS_U, "d_ws map");
constexpr size_t WS_AB = WS_END;
constexpr size_t WS_END2 = WS_END + 128 * MiB;
constexpr size_t WS_SLAB = WS_Q;
static_assert(WS_SLAB + (size_t)8 * NSA * D * 4 <= WS_KC, "slab overlay");
static_assert((4096 + 3456) * 4 <= 32768, "control words inside the zeroed region");
constexpr int CW_BAR = 4096, CW_ARRIVE = 64, CW_LQ = 128, CW_TMO2 = 192;
constexpr int RING_BYTES = 131072;
constexpr int XCH_OFF = RING_BYTES;
constexpr int MISC_OFF = XCH_OFF + 8192;
constexpr int LDS_BYTES = 147456;

#define LAS __attribute__((address_space(3)))
typedef unsigned short bf16;
typedef float f32x4 __attribute__((ext_vector_type(4)));
typedef float f32x2 __attribute__((ext_vector_type(2)));
typedef short bf16x8 __attribute__((ext_vector_type(8)));
typedef unsigned u32x4 __attribute__((ext_vector_type(4)));
typedef unsigned u32x2 __attribute__((ext_vector_type(2)));
using pg8::cvt_pk_bf16; using pg8::pk4_fp8; using pg8::pk4_i8; using pg8::W8_SCALE; using pg8::W8_INV;
#define LDS_WAIT() asm volatile("s_waitcnt lgkmcnt(0)" ::: "memory")
#define VM_WAIT() asm volatile("s_waitcnt vmcnt(0)" ::: "memory")

__device__ __forceinline__ float fast_sigmoid(float x) { return __builtin_amdgcn_rcpf(1.0f + __builtin_amdgcn_exp2f(-LOG2E * x)); }
__device__ __forceinline__ float gelu_tanh(float x) { return x * __builtin_amdgcn_rcpf(1.0f + __builtin_amdgcn_exp2f(-2.302208198f * (x + 0.044715f * x * x * x))); }

__device__ __forceinline__ float xrow16_max(float x) {
    auto s = __builtin_amdgcn_permlane16_swap(__float_as_uint(x), __float_as_uint(x), false, false); x = fmaxf(__uint_as_float(s[0]), __uint_as_float(s[1]));
    auto t = __builtin_amdgcn_permlane32_swap(__float_as_uint(x), __float_as_uint(x), false, false); return fmaxf(__uint_as_float(t[0]), __uint_as_float(t[1]));
}
__device__ __forceinline__ float xrow16_sum(float x) {
    auto s = __builtin_amdgcn_permlane16_swap(__float_as_uint(x), __float_as_uint(x), false, false); x = __uint_as_float(s[0]) + __uint_as_float(s[1]);
    auto t = __builtin_amdgcn_permlane32_swap(__float_as_uint(x), __float_as_uint(x), false, false); return __uint_as_float(t[0]) + __uint_as_float(t[1]);
}
struct EpiIn {
    static constexpr bool PERM = true, AFTER_DRAIN = false;
    bf16* Q; bf16* K; bf16* VtP; bf16* VtS; float* XR; bf16* GG; float* out; const float* qg; const float* kg; LAS float* xch;
    __device__ __forceinline__ void operator()(const f32x4 (&acc)[2][2][4][2], const pg8::Unit& u, int wr, int wc, int fr, int fq) const {
        asm volatile("" : "+v"(fr), "+v"(fq));
        const int region = u.pn >> 3, pl = u.pn & 7;
        const int rl0 = wr * 64 + fr, cl0 = wc * 32 + 8 * fq;
        const bool prompt = u.pm < 32;
        const int pb = u.pm >> 4, pt0 = (u.pm & 15) * 256, s0 = (u.pm - 32) * 256;
#ifndef RMASK
#define RMASK 31
#endif
        if ((RMASK & 3) && region < 2) {
#pragma unroll
            for (int ai = 0; ai < 2; ++ai)
#pragma unroll
                for (int m = 0; m < 4; ++m)
#pragma unroll
                    for (int bj = 0; bj < 2; ++bj) {
                        const f32x4 a = acc[ai][bj][m][0], b = acc[ai][bj][m][1];
                        float s = (a[0] * a[0] + a[1] * a[1]) + (a[2] * a[2] + a[3] * a[3]) + (b[0] * b[0] + b[1] * b[1]) + (b[2] * b[2] + b[3] * b[3]);
                        s = xrow16_sum(s);
                        if (fq == 0) xch[((ai * 128 + m * 16 + rl0) * 2 + bj) * 4 + wc] = s;
                    }
            asm volatile("s_waitcnt lgkmcnt(0)" ::: "memory"); __builtin_amdgcn_s_barrier(); asm volatile("" ::: "memory");
            const float* gp = (region == 0 ? qg : kg) + cl0;
            const float osc = region == 0 ? QSCALE : 1.0f;
            const f32x4 g0 = *(const f32x4*)gp * osc, g1 = *(const f32x4*)(gp + 4) * osc;
            bf16* dst = region == 0 ? Q : K;
            const bool newk = (region == 1) && (!prompt || (u.pm & 15) >= 14);
            float* ok = prompt ? out + O_KP + (size_t)(pb * 512 + pt0 - 3584) * AW : out + O_KS + (size_t)s0 * AW;
#pragma unroll
            for (int ai = 0; ai < 2; ++ai)
#pragma unroll
                for (int m = 0; m < 4; ++m) {
                    const int rl = ai * 128 + m * 16 + rl0; const size_t mrow = (size_t)u.pm * 256 + rl;
#pragma unroll
                    for (int bj = 0; bj < 2; ++bj) {
                        const f32x4 p = *(const LAS f32x4*)&xch[(rl * 2 + bj) * 4];
                        const float rs = __builtin_amdgcn_rsqf(((p[0] + p[1]) + (p[2] + p[3])) * (1.0f / 128.0f) + RMS_EPS);
                        const f32x4 v0 = acc[ai][bj][m][0] * rs * g0, v1 = acc[ai][bj][m][1] * rs * g1;
                        const int col = (pl * 2 + bj) * 128 + cl0;
                        u32x4 w; w.x = cvt_pk_bf16(v0[0], v0[1]); w.y = cvt_pk_bf16(v0[2], v0[3]); w.z = cvt_pk_bf16(v1[0], v1[1]); w.w = cvt_pk_bf16(v1[2], v1[3]);
                        const size_t hidx = prompt ? ((size_t)(pb * NH + pl * 2 + bj) * T + pt0 + rl) * HD + cl0 : (size_t)NPR * AW + ((size_t)(((s0 + rl) >> 5) * NH + pl * 2 + bj) * ST + ((s0 + rl) & 31)) * HD + cl0;
                        *(u32x4*)(dst + hidx) = w;
                        if (newk) { float* o = ok + (size_t)rl * AW + col; *(f32x4*)o = v0; *(f32x4*)(o + 4) = v1; }
                    }
                    asm volatile("" ::: "memory");
                }
        } else if ((RMASK & 4) && region == 2) {
            const bool newv = !prompt || (u.pm & 15) >= 14;
            float* ov = prompt ? out + O_VP + (size_t)(pb * 512 + pt0 - 3584) * AW : out + O_VS + (size_t)s0 * AW;
#pragma unroll
            for (int bj = 0; bj < 2; ++bj) {
                const int h = pl * 2 + bj;
#pragma unroll
                for (int n = 0; n < 2; ++n)
#pragma unroll
                    for (int j = 0; j < 4; j += 2) {
                        const int d = cl0 + 4 * n + j;
                        if (prompt) {
                            bf16* p0 = VtP + (((size_t)(pb * NH + h) * (T / 32) + (pt0 >> 5)) * HD + d) * 32 + (rl0 & 31) + (size_t)(rl0 >> 5) * (HD * 32);
#pragma unroll
                            for (int ai = 0; ai < 2; ++ai)
#pragma unroll
                                for (int m = 0; m < 4; ++m) { const unsigned w = cvt_pk_bf16(acc[ai][bj][m][n][j], acc[ai][bj][m][n][j + 1]); bf16* q0 = p0 + (ai * 4 + (m >> 1)) * (HD * 32) + (m & 1) * 16; q0[0] = (bf16)(w & 0xffffu); q0[32] = (bf16)(w >> 16); }
                        } else {
#pragma unroll
                            for (int ai = 0; ai < 2; ++ai)
#pragma unroll
                                for (int m = 0; m < 4; ++m) { const int s = s0 + ai * 128 + m * 16 + rl0; bf16* q0 = VtS + (((size_t)((s >> 5) * NH + h) * (KS_LD / 32) + CROWS / 32) * HD + d) * 32 + (s & 31);
                                    const unsigned w = cvt_pk_bf16(acc[ai][bj][m][n][j], acc[ai][bj][m][n][j + 1]); q0[0] = (bf16)(w & 0xffffu); q0[32] = (bf16)(w >> 16); }
                        }
                    }
            }
            if (newv) {
#pragma unroll
                for (int ai = 0; ai < 2; ++ai)
#pragma unroll
                    for (int m = 0; m < 4; ++m) { const int rl = ai * 128 + m * 16 + rl0;
#pragma unroll
                        for (int bj = 0; bj < 2; ++bj) { float* o = ov + (size_t)rl * AW + (pl * 2 + bj) * 128 + cl0; *(f32x4*)o = acc[ai][bj][m][0]; *(f32x4*)(o + 4) = acc[ai][bj][m][1]; } }
            }
        } else if ((RMASK & 8) && region == 3) {
#pragma unroll
            for (int ai = 0; ai < 2; ++ai)
#pragma unroll
                for (int m = 0; m < 4; ++m) { const int rl = ai * 128 + m * 16 + rl0; const size_t mrow = (size_t)u.pm * 256 + rl;
                    int ci = -1; float* oc = out;
                    if (prompt) { if ((u.pm & 15) == 15 && rl >= 253) { ci = rl - 253; oc = out + O_CP + (size_t)(pb * 3 + ci) * LW; } }
                    else { const int s = s0 + rl; if ((s & 31) >= 29) { ci = (s & 31) - 29; oc = out + O_CS + (size_t)((s >> 5) * 3 + ci) * LW; } }
#pragma unroll
                    for (int bj = 0; bj < 2; ++bj) { const int col = pl * 256 + bj * 128 + cl0; float* o = XR + mrow * LW + col; *(f32x4*)o = acc[ai][bj][m][0]; *(f32x4*)(o + 4) = acc[ai][bj][m][1];
                        if (ci >= 0) { *(f32x4*)(oc + col) = acc[ai][bj][m][0]; *(f32x4*)(oc + col + 4) = acc[ai][bj][m][1]; } } }
        } else if (RMASK & 16) {
#pragma unroll
            for (int ai = 0; ai < 2; ++ai)
#pragma unroll
                for (int m = 0; m < 4; ++m) { const size_t mrow = (size_t)u.pm * 256 + ai * 128 + m * 16 + rl0;
#pragma unroll
                    for (int bj = 0; bj < 2; ++bj) { const f32x4 a = acc[ai][bj][m][0], b = acc[ai][bj][m][1];
                        u32x4 w; w.x = cvt_pk_bf16(a[0], a[1]); w.y = cvt_pk_bf16(a[2], a[3]); w.z = cvt_pk_bf16(b[0], b[1]); w.w = cvt_pk_bf16(b[2], b[3]);
                        *(u32x4*)(GG + mrow * LW + pl * 256 + bj * 128 + cl0) = w; } }
        }
    }
};
struct SplitOrder {
    pg8::StaticOrder full; int G, c, np;
    __device__ __forceinline__ void init(int K, int G_, int c_) { full.init(NPR, D, K, G_, c_); G = G_; c = c_; np = K / 128; }
    __device__ __forceinline__ bool next(int i, pg8::Unit& u) const {
        const int L = i * G + c;
        if (L < full.nwg) return full.next(i, u);
        const int j = L - full.nwg; if (j >= 256) return false;
        const int tile = j >> 3, part = j & 7, base = np >> 3, rem = np & 7;
        u.pm = 32 + (tile >> 4); u.pn = tile & 15; u.kb = 2 * (part * base + (part < rem ? part : rem)); u.nt = 2 * (base + (part < rem ? 1 : 0)); u.part = part; return true;
    }
    __device__ __forceinline__ void a_ready(const pg8::Unit&) const {}
    __device__ __forceinline__ void done(const pg8::Unit&) const {}
};
struct InOrder {
    pg8::StaticOrder full; int G, c, mode;
    __device__ __forceinline__ void init(int G_, int c_) { full.init(NPR, INC, D, G_, c_); G = G_; c = c_; mode = 0; }
    __device__ __forceinline__ bool next(int i, pg8::Unit& u) const {
        if (mode == 0) return full.next(i, u);
        const int L = i * G + c; if (L >= 2 * (INC / 256)) return false;
        u.pm = 32 + L / (INC / 256); u.pn = L % (INC / 256); u.kb = 0; u.nt = D / 64; u.part = -1; return true;
    }
    __device__ __forceinline__ void a_ready(const pg8::Unit&) const {}
    __device__ __forceinline__ void done(const pg8::Unit&) const {}
};
struct GluOrder {
    pg8::StaticOrder full; int G, c, mode;
    __device__ __forceinline__ void init(int K, int G_, int c_) { full.init(NPR, 2 * DFF, K, G_, c_); G = G_; c = c_; mode = 0; }
    __device__ __forceinline__ bool next(int i, pg8::Unit& u) const {
        if (mode == 0) return full.next(i, u);
        const int cc = (G == 256) ? ((c + 256 - 84) & 255) : c, L = i * G + cc; if (L >= 2 * (2 * DFF / 256)) return false;
        u.pm = 32 + L / (2 * DFF / 256); u.pn = L % (2 * DFF / 256); u.kb = 0; u.nt = full.ntf; u.part = -1; return true;
    }
    __device__ __forceinline__ void a_ready(const pg8::Unit&) const {}
    __device__ __forceinline__ void done(const pg8::Unit&) const {}
};
struct TailSplit {
    int rank, nrank, np;
    __device__ __forceinline__ void init(int K, int G, int c) { np = K / 128; if (G == 256) { rank = c < 84 ? c : (c >= 192 ? 84 + (c - 192) : -1); nrank = 148; } else { rank = c; nrank = G; } }
    __device__ __forceinline__ bool next(int i, pg8::Unit& u) const {
        if (rank < 0) return false;
        const int j = rank + i * nrank; if (j >= 256) return false;
        const int tile = j >> 3, part = j & 7, base = np >> 3, rem = np & 7;
        u.pm = 32 + (tile >> 4); u.pn = tile & 15; u.kb = 2 * (part * base + (part < rem ? part : rem)); u.nt = 2 * (base + (part < rem ? 1 : 0)); u.part = part; return true;
    }
    __device__ __forceinline__ void a_ready(const pg8::Unit&) const {}
    __device__ __forceinline__ void done(const pg8::Unit&) const {}
};
template <bool BASE_BF16, bool OUT_BF16> struct EpiRes {
    static constexpr bool PERM = false, AFTER_DRAIN = false;
    const void* base; void* outp; const float* gate; float* slab; int probe_skip; float wsc;
    __device__ __forceinline__ void operator()(const f32x4 (&acc)[2][2][4][2], const pg8::Unit& u, int wr, int wc, int fr, int fq) const {
        asm volatile("" : "+v"(fr), "+v"(fq));
        const int col0 = u.pn * 256 + wc * 32 + 4 * fq;
        if (probe_skip) return;
        if (u.part < 0) {
            const float* gp = gate + (size_t)(u.pm >> 4) * NMOD + col0;
            f32x4 gv[2][2];
#pragma unroll
            for (int bj = 0; bj < 2; ++bj)
#pragma unroll
                for (int n = 0; n < 2; ++n) gv[bj][n] = *(const f32x4*)(gp + bj * 128 + n * 16) * wsc;
#pragma unroll
            for (int ai = 0; ai < 2; ++ai) {
                const size_t row0 = (size_t)u.pm * 256 + ai * 128 + wr * 64 + fr;
                f32x4 bs[4][2][2]; u32x2 bw[4][2][2];
#pragma unroll
                for (int m = 0; m < 4; ++m)
#pragma unroll
                    for (int bj = 0; bj < 2; ++bj)
#pragma unroll
                        for (int n = 0; n < 2; ++n) { const size_t off = (row0 + m * 16) * D + col0 + bj * 128 + n * 16;
                            if (BASE_BF16) bw[m][bj][n] = *(const u32x2*)((const bf16*)base + off); else bs[m][bj][n] = *(const f32x4*)((const float*)base + off); }
#pragma unroll
                for (int m = 0; m < 4; ++m)
#pragma unroll
                    for (int bj = 0; bj < 2; ++bj)
#pragma unroll
                        for (int n = 0; n < 2; ++n) { const size_t off = (row0 + m * 16) * D + col0 + bj * 128 + n * 16;
                            f32x4 bsv;
                            if (BASE_BF16) { const u32x2 w = bw[m][bj][n]; bsv = (f32x4){__uint_as_float(w.x << 16), __uint_as_float(w.x & 0xffff0000u), __uint_as_float(w.y << 16), __uint_as_float(w.y & 0xffff0000u)}; }
                            else bsv = bs[m][bj][n];
                            const f32x4 o = bsv + gv[bj][n] * acc[ai][bj][m][n];
                            if (OUT_BF16) { u32x2 w; w.x = cvt_pk_bf16(o[0], o[1]); w.y = cvt_pk_bf16(o[2], o[3]); *(u32x2*)((bf16*)outp + off) = w; }
                            else __builtin_nontemporal_store(o, (f32x4*)((float*)outp + off)); }
                asm volatile("" ::: "memory");
            }
        } else {
#pragma unroll
            for (int ai = 0; ai < 2; ++ai)
#pragma unroll
                for (int m = 0; m < 4; ++m) {
                    const int rl = ai * 128 + wr * 64 + m * 16 + fr; const size_t mrow = (size_t)u.pm * 256 + rl;
                    const int seq = NB + (((u.pm - 32) * 256 + rl) >> 5);
                    const float* gp = gate + (size_t)seq * NMOD;
#pragma unroll
                    for (int bj = 0; bj < 2; ++bj)
#pragma unroll
                        for (int n = 0; n < 2; ++n) { const int c = col0 + bj * 128 + n * 16; *(f32x4*)(slab + ((size_t)u.part * NSA + (mrow - NPR)) * D + c) = *(const f32x4*)(gp + c) * wsc * acc[ai][bj][m][n]; }
                    if (m & 1) asm volatile("" ::: "memory");
                }
        }
    }
};
template <int QM> struct EpiGlu {
    static constexpr bool PERM = true, AFTER_DRAIN = false;
    bf16* H; float wsc; const float* su; const float* sw;
    __device__ __forceinline__ void operator()(const f32x4 (&acc)[2][2][4][2], const pg8::Unit& u, int wr, int wc, int fr, int fq) const {
        asm volatile("" : "+v"(fr), "+v"(fq));
        const int col = u.pn * 128 + wc * 32 + 8 * fq;
        f32x4 sg[2], sp[2]; float rs[2][4];
        if (QM == 2) { const float* p = sw + u.pn * 256 + wc * 32 + 8 * fq; sg[0] = *(const f32x4*)p * (1.f / 127.f); sg[1] = *(const f32x4*)(p + 4) * (1.f / 127.f); sp[0] = *(const f32x4*)(p + 128) * (1.f / 127.f); sp[1] = *(const f32x4*)(p + 132) * (1.f / 127.f);
#pragma unroll
            for (int ai = 0; ai < 2; ++ai)
#pragma unroll
                for (int m = 0; m < 4; ++m) rs[ai][m] = su[(size_t)u.pm * 256 + ai * 128 + wr * 64 + m * 16 + fr]; }
#pragma unroll
        for (int ai = 0; ai < 2; ++ai)
#pragma unroll
            for (int m = 0; m < 4; ++m) { const size_t mrow = (size_t)u.pm * 256 + ai * 128 + wr * 64 + m * 16 + fr;
                f32x4 v[2];
#pragma unroll
                for (int n = 0; n < 2; ++n) { f32x4 g, up;
                    if (QM == 2) {
#pragma unroll
                        for (int j = 0; j < 4; ++j) { const float ga = acc[ai][0][m][n][j], ua = acc[ai][1][m][n][j];
                            g[j] = (float)__builtin_bit_cast(int, ga) * (rs[ai][m] * sg[n][j]); up[j] = (float)__builtin_bit_cast(int, ua) * (rs[ai][m] * sp[n][j]); } }
                    else { g = acc[ai][0][m][n] * wsc; up = acc[ai][1][m][n] * wsc; }
#pragma unroll
                    for (int j = 0; j < 4; ++j) v[n][j] = g[j] * fast_sigmoid(g[j]) * up[j]; }
                if (F8_DOWN) { u32x2 w; w.x = pk4_fp8(v[0][0], v[0][1], v[0][2], v[0][3]); w.y = pk4_fp8(v[1][0], v[1][1], v[1][2], v[1][3]); *(u32x2*)((unsigned char*)H + mrow * DFF + col) = w; }
                else { u32x4 w; w.x = cvt_pk_bf16(v[0][0], v[0][1]); w.y = cvt_pk_bf16(v[0][2], v[0][3]); w.z = cvt_pk_bf16(v[1][0], v[1][1]); w.w = cvt_pk_bf16(v[1][2], v[1][3]);
                    *(u32x4*)(H + mrow * DFF + col) = w; } }
    }
};
#define XB_TMO      128
#define XB_XCNT(j)  (256  + 64 * (j))
#define XB_XSUB(j)  (1280 + 64 * (j))
#define XB_XGEN(j)  (2304 + 64 * (j))
#define XB_TOP      3328
#define XB_TOPGEN   3392
#define XCD_BAR_WORDS 3456
#define XB_SPIN_CAP (1u << 18)
#define LAS __attribute__((address_space(3)))

__device__ __forceinline__ unsigned xb_ld(unsigned* p)              { return __hip_atomic_load(p, __ATOMIC_RELAXED, __HIP_MEMORY_SCOPE_AGENT); }
__device__ __forceinline__ unsigned xb_add(unsigned* p, unsigned v) { return __hip_atomic_fetch_add(p, v, __ATOMIC_RELAXED, __HIP_MEMORY_SCOPE_AGENT); }
__device__ __forceinline__ unsigned xb_xcc_id() { return (unsigned)__builtin_amdgcn_s_getreg((3 << 11) | 20) & 0xFu; }
#define XB_SPIN(cond, bar) do { unsigned _sp = 0; while (cond) { __builtin_amdgcn_s_sleep(1); \
    if ((++_sp & 255u) == 0u) { if (xb_ld(&(bar)[XB_TMO])) break; if (_sp > XB_SPIN_CAP) { atomicAdd(&(bar)[XB_TMO], 1u); break; } } } } while (0)

struct XcdBarrier {
    unsigned* bar; unsigned x;
    volatile LAS unsigned* st;
};

__device__ __forceinline__ XcdBarrier xcd_barrier_post(unsigned* bar, volatile LAS unsigned* st) {
    XcdBarrier b; b.bar = bar; b.x = xb_xcc_id(); b.st = st;
    if (threadIdx.x == 0) (void)xb_add(&bar[XB_XCNT(b.x)], 1u);
    return b;
}
__device__ __forceinline__ void xcd_barrier_complete(unsigned* bar, unsigned x, unsigned& nloc, unsigned& nx) {
    const unsigned G = gridDim.x * gridDim.y * gridDim.z;
    unsigned sum, cnt, mine, sp = 0u;
    for (;;) {
        sum = 0u; cnt = 0u; mine = 0u;
#pragma unroll
        for (unsigned j = 0; j < 16; ++j) { const unsigned c = xb_ld(&bar[XB_XCNT(j)]); sum += c; cnt += (c > 0u) ? 1u : 0u; mine = (j == x) ? c : mine; }
        if (sum == G) break;
        __builtin_amdgcn_s_sleep(1);
        if ((++sp & 255u) == 0u) { if (xb_ld(&bar[XB_TMO])) break; if (sp > XB_SPIN_CAP) { atomicAdd(&bar[XB_TMO], 1u); break; } }
    }
    nloc = mine > 0u ? mine : 1u; nx = cnt > 0u ? cnt : 1u;
}

__device__ __forceinline__ void xcd_barrier(const XcdBarrier& b) {
    asm volatile("s_waitcnt vmcnt(0)" ::: "memory");
    __syncthreads();
    if (threadIdx.x == 0) {
        unsigned* bar = b.bar;
        __builtin_amdgcn_s_waitcnt(0);
        unsigned nloc = b.st[0], nx = b.st[1];
        if (nloc == 0u) { xcd_barrier_complete(bar, b.x, nloc, nx); b.st[0] = nloc; b.st[1] = nx; }
        const unsigned old = xb_add(&bar[XB_XSUB(b.x)], 1u);
        const unsigned gen = old / nloc;
        if (old + 1u == (gen + 1u) * nloc) {
            __builtin_amdgcn_fence(__ATOMIC_RELEASE, "agent");
            asm volatile("s_waitcnt vmcnt(0)" ::: "memory");
            const unsigned og = xb_add(&bar[XB_TOP], 1u);
            const unsigned tg = og / nx;
            if (og + 1u == (tg + 1u) * nx) xb_add(&bar[XB_TOPGEN], 1u);
            else XB_SPIN(xb_ld(&bar[XB_TOPGEN]) == tg, bar);
            __builtin_amdgcn_fence(__ATOMIC_ACQUIRE, "agent");
            xb_add(&bar[XB_XGEN(b.x)], 1u);
            asm volatile("s_waitcnt vmcnt(0)" ::: "memory");
        } else {
            XB_SPIN(xb_ld(&bar[XB_XGEN(b.x)]) == gen, bar);
            __builtin_amdgcn_fence(__ATOMIC_ACQUIRE, "agent");
            asm volatile("s_waitcnt vmcnt(0)" ::: "memory");
        }
    }
    __syncthreads();
}
constexpr int NWAVES = 8;
struct Params {
    const float* in[27];
    float* out; unsigned char* ws;
    int ph_lo, ph_hi;
    int sub, pad;
};
enum { I_XP = 0, I_XS, I_CK, I_CV, I_SCONV, I_SH, I_CP, I_CS, I_G1, I_G2, I_WMOD, I_BMOD, I_WIN, I_QG, I_KG, I_RELB, I_CONVW, I_CONVB, I_WRA, I_BRA, I_WRX, I_BRX, I_LAM, I_WOUT, I_WG, I_WU, I_WD };

__device__ __forceinline__ float wave_sum(float v) {
#pragma unroll
    for (int o = 1; o < 64; o <<= 1) v += __shfl_xor(v, o);
    return v;
}
__device__ __forceinline__ unsigned f2bf(float f) { unsigned u = __builtin_bit_cast(unsigned, f); return (u + 0x7fffu + ((u >> 16) & 1u)) >> 16; }
__device__ __forceinline__ unsigned pk2(float lo, float hi) { return f2bf(lo) | (f2bf(hi) << 16); }

#ifndef NT_WEIGHTS
#define NT_WEIGHTS 0
#endif
#if NT_WEIGHTS
#define NT_LOAD(p) __builtin_nontemporal_load(p)
#else
#define NT_LOAD(p) (*(p))
#endif
__device__ __forceinline__ void transpose_item(const float* src, size_t sld, bf16* dst, size_t dld, LAS float* scr, int lane, size_t blk = 32) {
    { f32x4 v[8]; const int r8 = lane >> 3, c4 = lane & 7;
#pragma unroll
      for (int i = 0; i < 8; ++i) v[i] = NT_LOAD((const f32x4*)(src + (size_t)(8 * i + r8) * sld + 4 * c4));
#pragma unroll
      for (int i = 0; i < 8; ++i) { LAS float* d = scr + (8 * i + r8) * 33 + 4 * c4; d[0] = v[i][0]; d[1] = v[i][1]; d[2] = v[i][2]; d[3] = v[i][3]; } }
    LDS_WAIT(); asm volatile("" ::: "memory");
    const int c = lane & 7;
#pragma unroll
    for (int j = 0; j < 4; ++j) { const int n = (lane >> 3) + 8 * j; const LAS float* s = scr + (8 * c) * 33 + n;
        u32x4 o; o.x = pk2(s[0 * 33], s[1 * 33]); o.y = pk2(s[2 * 33], s[3 * 33]); o.z = pk2(s[4 * 33], s[5 * 33]); o.w = pk2(s[6 * 33], s[7 * 33]);
        *(u32x4*)(dst + (size_t)n * dld + (size_t)(c >> 2) * blk + 8 * (c & 3)) = o; }
    LDS_WAIT(); asm volatile("" ::: "memory");
}
__device__ __forceinline__ void transpose_item_f8(const float* src, size_t sld, unsigned char* dst, size_t dld, LAS float* scr, int lane) {
    { f32x4 v[8]; const int r8 = lane >> 3, c4 = lane & 7;
#pragma unroll
      for (int i = 0; i < 8; ++i) v[i] = NT_LOAD((const f32x4*)(src + (size_t)(8 * i + r8) * sld + 4 * c4));
#pragma unroll
      for (int i = 0; i < 8; ++i) { LAS float* d = scr + (8 * i + r8) * 33 + 4 * c4; d[0] = v[i][0]; d[1] = v[i][1]; d[2] = v[i][2]; d[3] = v[i][3]; } }
    LDS_WAIT(); asm volatile("" ::: "memory");
#pragma unroll
    for (int j = 0; j < 2; ++j) { const int p = lane + 64 * j, n = p >> 2, c = p & 3; const LAS float* s = scr + (16 * c) * 33 + n;
        u32x4 o; o.x = pk4_fp8(s[0 * 33] * W8_SCALE, s[1 * 33] * W8_SCALE, s[2 * 33] * W8_SCALE, s[3 * 33] * W8_SCALE); o.y = pk4_fp8(s[4 * 33] * W8_SCALE, s[5 * 33] * W8_SCALE, s[6 * 33] * W8_SCALE, s[7 * 33] * W8_SCALE);
        o.z = pk4_fp8(s[8 * 33] * W8_SCALE, s[9 * 33] * W8_SCALE, s[10 * 33] * W8_SCALE, s[11 * 33] * W8_SCALE); o.w = pk4_fp8(s[12 * 33] * W8_SCALE, s[13 * 33] * W8_SCALE, s[14 * 33] * W8_SCALE, s[15 * 33] * W8_SCALE);
        *(u32x4*)(dst + (size_t)n * dld + 16 * c) = o; }
    LDS_WAIT(); asm volatile("" ::: "memory");
}
__device__ __forceinline__ void transpose_item_i8(const float* src, size_t sld, unsigned char* dst, size_t dld, LAS float* scr, int lane, const float* amax) {
    { f32x4 v[8]; const int r8 = lane >> 3, c4 = lane & 7;
#pragma unroll
      for (int i = 0; i < 8; ++i) v[i] = NT_LOAD((const f32x4*)(src + (size_t)(8 * i + r8) * sld + 4 * c4));
#pragma unroll
      for (int i = 0; i < 8; ++i) { LAS float* d = scr + (8 * i + r8) * 33 + 4 * c4; d[0] = v[i][0]; d[1] = v[i][1]; d[2] = v[i][2]; d[3] = v[i][3]; } }
    LDS_WAIT(); asm volatile("" ::: "memory");
#pragma unroll
    for (int j = 0; j < 2; ++j) { const int p = lane + 64 * j, n = p >> 2, c = p & 3; const LAS float* s = scr + (16 * c) * 33 + n;
        const float a = amax[n], inv = a > 0.f ? 127.f / a : 0.f;
        u32x4 o; o.x = pk4_i8(s[0 * 33], s[1 * 33], s[2 * 33], s[3 * 33], inv); o.y = pk4_i8(s[4 * 33], s[5 * 33], s[6 * 33], s[7 * 33], inv);
        o.z = pk4_i8(s[8 * 33], s[9 * 33], s[10 * 33], s[11 * 33], inv); o.w = pk4_i8(s[12 * 33], s[13 * 33], s[14 * 33], s[15 * 33], inv);
        *(u32x4*)(dst + (size_t)n * dld + 16 * c) = o; }
    LDS_WAIT(); asm volatile("" ::: "memory");
}
__device__ __forceinline__ void p0_amax(const Params& P, int gw, int NGW, int lane) {
    unsigned* amax = (unsigned*)(P.ws + WS_CTL + WS_AMAX);
    constexpr int CC = DFF / 256, KC = D / 32, NIT = 2 * KC * CC;
    for (int it = gw; it < NIT; it += NGW) {
        const int up = it >= KC * CC, r = up ? it - KC * CC : it, kc = r / CC, cc = r % CC;
        const float* src = P.in[up ? I_WU : I_WG] + (size_t)kc * 32 * DFF + cc * 256 + 4 * lane;
        f32x4 m = (f32x4){0.f, 0.f, 0.f, 0.f};
#pragma unroll
        for (int h = 0; h < 2; ++h) { f32x4 v[16];
#pragma unroll
            for (int i = 0; i < 16; ++i) v[i] = NT_LOAD((const f32x4*)(src + (size_t)(h * 16 + i) * DFF));
#pragma unroll
            for (int i = 0; i < 16; ++i) { m[0] = fmaxf(m[0], fabsf(v[i][0])); m[1] = fmaxf(m[1], fabsf(v[i][1])); m[2] = fmaxf(m[2], fabsf(v[i][2])); m[3] = fmaxf(m[3], fabsf(v[i][3])); } }
        const int n = cc * 256 + 4 * lane, ni = 256 * (n >> 7) + (n & 127) + (up ? 128 : 0);
#pragma unroll
        for (int j = 0; j < 4; ++j) { const float mj = m[j]; __hip_atomic_fetch_max(amax + ni + j, __builtin_bit_cast(unsigned, mj), __ATOMIC_RELAXED, __HIP_MEMORY_SCOPE_AGENT); }
    }
}
__device__ __forceinline__ void cvt_item(const float* src, bf16* dst, int lane) {
#pragma unroll
    for (int j = 0; j < 4; ++j) { const f32x4 a = *(const f32x4*)(src + j * 512 + lane * 8), b = *(const f32x4*)(src + j * 512 + lane * 8 + 4);
        u32x4 o; o.x = pk2(a[0], a[1]); o.y = pk2(a[2], a[3]); o.z = pk2(b[0], b[1]); o.w = pk2(b[2], b[3]); *(u32x4*)(dst + j * 512 + lane * 8) = o; }
}
__device__ __forceinline__ void p0_convert(const Params& P, LAS unsigned char* lds, int gw, int NGW, int wave, int lane) {
    LAS float* scr = (LAS float*)(lds + wave * 8704);
    unsigned char* ws = P.ws;
    bf16* WinT = (bf16*)(ws + WS_WIN); bf16* WoutT = (bf16*)(ws + WS_WOUT); bf16* WguT = (bf16*)(ws + WS_WGU); bf16* WdT = (bf16*)(ws + WS_WD); bf16* WrgT = (bf16*)(ws + WS_WRG);
    bf16* VtS = (bf16*)(ws + WS_VTS); bf16* Kc = (bf16*)(ws + WS_KC);
    constexpr int I_IN = (D / 64) * (INC / 32), I_OUT = (D / 64) * (D / 32), I_GA = (D / 64) * (DFF / 32), I_DN = (DFF / 64) * (D / 32), I_CVT = SB * NH * (CROWS / 64) * (HD / 32), I_RG = 16 * (128 / 64) * (128 / 32),
                  I_KC = SB * NH * (CROWS / 16);
    constexpr int NITEMS = I_IN + I_OUT + I_DN + I_CVT + 2 * I_RG + I_KC;
    for (int it = gw; it < NITEMS; it += NGW) {
        int r = it;
        if (r < I_IN) { const int nb = r % (INC / 32), kb = r / (INC / 32); transpose_item(P.in[I_WIN] + (size_t)kb * 64 * INC + nb * 32, INC, WinT + (size_t)nb * 32 * D + kb * 64, D, scr, lane); continue; } r -= I_IN;
        if (r < I_OUT) { const int nb = r % (D / 32), kb = r / (D / 32); if (F8_OUT) transpose_item_f8(P.in[I_WOUT] + (size_t)kb * 64 * D + nb * 32, D, (unsigned char*)WoutT + (size_t)nb * 32 * D + kb * 64, D, scr, lane);
            else transpose_item(P.in[I_WOUT] + (size_t)kb * 64 * D + nb * 32, D, WoutT + (size_t)nb * 32 * D + kb * 64, D, scr, lane); continue; } r -= I_OUT;
        if (r < I_DN) { const int nb = r % (D / 32), kb = r / (D / 32);
            if (F8_DOWN) transpose_item_f8(P.in[I_WD] + (size_t)kb * 64 * D + nb * 32, D, (unsigned char*)WdT + (size_t)nb * 32 * DFF + kb * 64, DFF, scr, lane);
            else transpose_item(P.in[I_WD] + (size_t)kb * 64 * D + nb * 32, D, WdT + (size_t)nb * 32 * DFF + kb * 64, DFF, scr, lane); continue; } r -= I_DN;
        if (r < I_CVT) { const int sub = r & 31, bh = r >> 5, b = bh >> 4, h = bh & 15, kb = sub >> 2, nb = sub & 3;
            transpose_item(P.in[I_CV] + ((size_t)(b * CROWS + kb * 64) * NH + h) * HD + nb * 32, (size_t)NH * HD, VtS + (((size_t)(b * NH + h) * (KS_LD / 32) + kb * 2) * HD + nb * 32) * 32, 32, scr, lane, HD * 32); continue; } r -= I_CVT;
        if (r < 2 * I_RG) { const int x = r >= I_RG; if (x) r -= I_RG; const int sub = r & 7, n = r >> 3, kb = sub >> 2, nb = sub & 3;
            transpose_item(P.in[x ? I_WRX : I_WRA] + (size_t)n * 16384 + kb * 64 * 128 + nb * 32, 128, WrgT + ((size_t)n * 256 + x * 128 + nb * 32) * 128 + kb * 64, 128, scr, lane); continue; } r -= 2 * I_RG;
        { const int kc = r & 31, bh = r >> 5, b = bh >> 4, h = bh & 15;
#pragma unroll
          for (int j = 0; j < 4; ++j) { const int key = kc * 16 + 4 * j + (lane >> 4), d8 = (lane & 15) * 8; const float* sp = P.in[I_CK] + ((size_t)(b * CROWS + key) * NH + h) * HD + d8;
              const f32x4 a = *(const f32x4*)sp, c4 = *(const f32x4*)(sp + 4); u32x4 o; o.x = pk2(a[0], a[1]); o.y = pk2(a[2], a[3]); o.z = pk2(c4[0], c4[1]); o.w = pk2(c4[2], c4[3]);
              *(u32x4*)(Kc + ((size_t)bh * CROWS + key) * HD + d8) = o; } }
    }
    { unsigned* ctl = (unsigned*)(ws + WS_CTL);
      if (threadIdx.x == 0) {
          unsigned sp = 0;
          while (__hip_atomic_load(ctl + CW_ARRIVE + 896, __ATOMIC_RELAXED, __HIP_MEMORY_SCOPE_AGENT) < gridDim.x) { __builtin_amdgcn_s_sleep(2);
              if ((++sp & 255u) == 0u) { if (__hip_atomic_load(ctl + CW_TMO2, __ATOMIC_RELAXED, __HIP_MEMORY_SCOPE_AGENT)) break; if (sp > (1u << 20)) { __hip_atomic_store(ctl + CW_TMO2, 1u, __ATOMIC_RELAXED, __HIP_MEMORY_SCOPE_AGENT); break; } } }
          __builtin_amdgcn_fence(__ATOMIC_ACQUIRE, "agent"); VM_WAIT();
      }
      __syncthreads(); }
    const float* amax = (const float*)(ws + WS_CTL + WS_AMAX);
    for (int it = gw; it < 2 * I_GA; it += NGW) {
        int r = it; const int up = r >= I_GA; if (up) r -= I_GA; const int nb = r % (DFF / 32), kb = r / (DFF / 32); const int n0 = nb * 32, row0 = 256 * (n0 >> 7) + (n0 & 127) + (up ? 128 : 0);
        transpose_item_i8(P.in[up ? I_WU : I_WG] + (size_t)kb * 64 * DFF + n0, DFF, (unsigned char*)WguT + (size_t)row0 * D + kb * 64, D, scr, lane, amax + row0);
    }
}
__device__ __forceinline__ void p0_mod(const Params& P, LAS unsigned char* lds, int tid, int wave, int lane) {
    LAS float* Sw = (LAS float*)lds + wave * 640;
    LAS float* Rb = (LAS float*)(lds + 20480);
    const float* Wm = P.in[I_WMOD]; float* mod = (float*)(P.ws + WS_MOD);
    for (int cb = blockIdx.x; cb < NMOD / 96; cb += gridDim.x) {
        const int n0 = cb * 96, rs = lane / 24, c4 = lane % 24;
        f32x4 acc[NSEQ];
#pragma unroll
        for (int s = 0; s < NSEQ; ++s) acc[s] = (f32x4){0.f, 0.f, 0.f, 0.f};
        __syncthreads();
        for (int idx = lane; idx < NSEQ * 16; idx += 64) { const int sq = idx >> 4, r = idx & 15; const float v = sq < NB ? P.in[I_CP][sq * D + wave * 16 + r] : P.in[I_CS][(sq - NB) * D + wave * 16 + r]; Sw[r * 20 + sq] = v * fast_sigmoid(v); }
        f32x4 w[8];
        if (lane < 48) {
#pragma unroll
            for (int p = 0; p < 8; ++p) w[p] = NT_LOAD((const f32x4*)(Wm + (size_t)(wave * 16 + 2 * p + rs) * NMOD + n0 + 4 * c4)); }
        for (int ch = 0; ch < D / 128; ++ch) {
            const int k0 = ch * 128; LAS float* Sc = Sw + (ch & 1) * 320; LAS float* Sn = Sw + ((ch + 1) & 1) * 320;
            const int kn = (ch + 1 < D / 128) ? k0 + 128 : k0;
            for (int idx = lane; idx < NSEQ * 16; idx += 64) { const int sq = idx >> 4, r = idx & 15; const float v = sq < NB ? P.in[I_CP][sq * D + kn + wave * 16 + r] : P.in[I_CS][(sq - NB) * D + kn + wave * 16 + r]; Sn[r * 20 + sq] = v * fast_sigmoid(v); }
            LDS_WAIT(); asm volatile("" ::: "memory");
            if (lane < 48) {
                f32x4 wn[8];
#pragma unroll
                for (int p = 0; p < 8; ++p) wn[p] = NT_LOAD((const f32x4*)(Wm + (size_t)(kn + wave * 16 + 2 * p + rs) * NMOD + n0 + 4 * c4));
#pragma unroll
                for (int p = 0; p < 8; ++p) { const LAS float* sp = Sc + (2 * p + rs) * 20;
                    const f32x4 s0 = *(const LAS f32x4*)sp, s1 = *(const LAS f32x4*)(sp + 4), s2 = *(const LAS f32x4*)(sp + 8), s3 = *(const LAS f32x4*)(sp + 12); const f32x2 s4 = *(const LAS f32x2*)(sp + 16);
#pragma unroll
                    for (int j = 0; j < 4; ++j) { acc[j] += w[p] * s0[j]; acc[4 + j] += w[p] * s1[j]; acc[8 + j] += w[p] * s2[j]; acc[12 + j] += w[p] * s3[j]; }
                    acc[16] += w[p] * s4[0]; acc[17] += w[p] * s4[1]; }
#pragma unroll
                for (int p = 0; p < 8; ++p) w[p] = wn[p];
            }
            LDS_WAIT(); asm volatile("" ::: "memory");
        }
        if (lane < 48) {
#pragma unroll
            for (int s = 0; s < NSEQ; ++s) *(LAS f32x4*)(Rb + ((wave * 2 + rs) * NSEQ + s) * 96 + 4 * c4) = acc[s];
        }
        __syncthreads();
        for (int idx = tid; idx < NSEQ * 96; idx += NWAVES * 64) { const int s = idx / 96, c = idx % 96; float v = P.in[I_BMOD][n0 + c];
#pragma unroll
            for (int q = 0; q < 16; ++q) v += Rb[(q * NSEQ + s) * 96 + c];
            mod[(size_t)s * NMOD + n0 + c] = v; }
    }
    __syncthreads();
}
template <bool X0_BF16, int UQ = 0> __device__ __forceinline__ void norm_rows(const float* __restrict__ x0, const float* __restrict__ x1, const float* __restrict__ gain, const float* __restrict__ mod, int sh_off, int sc_off, bf16* __restrict__ U, const float* __restrict__ slab, float* __restrict__ x1out, int nrows, int gw, int NGW, int lane, float* __restrict__ su = nullptr) {
    for (int m = gw; m < nrows; m += NGW) {
        const float* xr = m < NPR ? x0 + (X0_BF16 ? 0 : (size_t)m * D) : x1 + (size_t)(m - NPR) * D;
        const int seq = m < NPR ? m / T : NB + (m - NPR) / ST;
        const float* mp = mod + (size_t)seq * NMOD;
        f32x4 v[16]; float ss = 0.f;
#pragma unroll
        for (int j = 0; j < 16; ++j) {
            if (X0_BF16 && m < NPR) { const u32x2 w = *(const u32x2*)((const bf16*)x0 + (size_t)m * D + 4 * (lane + 64 * j)); v[j] = (f32x4){__uint_as_float(w.x << 16), __uint_as_float(w.x & 0xffff0000u), __uint_as_float(w.y << 16), __uint_as_float(w.y & 0xffff0000u)}; }
            else v[j] = *(const f32x4*)(xr + 4 * (lane + 64 * j)); }
        if (slab && m >= NPR) {
            for (int q = 0; q < 8; ++q) {
#pragma unroll
                for (int j = 0; j < 16; ++j) v[j] += *(const f32x4*)(slab + ((size_t)q * NSA + (m - NPR)) * D + 4 * (lane + 64 * j)); }
#pragma unroll
            for (int j = 0; j < 16; ++j) *(f32x4*)(x1out + (size_t)(m - NPR) * D + 4 * (lane + 64 * j)) = v[j];
        }
#pragma unroll
        for (int j = 0; j < 16; ++j) ss += (v[j][0] * v[j][0] + v[j][1] * v[j][1]) + (v[j][2] * v[j][2] + v[j][3] * v[j][3]);
        const float rstd = __builtin_amdgcn_rsqf(wave_sum(ss) * (1.0f / D) + RMS_EPS);
        bf16* up = U + (size_t)m * D; unsigned char* up8 = (unsigned char*)U + (size_t)m * D;
        constexpr int JB = UQ ? 4 : 8;
        float amx = 0.f;
#pragma unroll
        for (int jb = 0; jb < 16; jb += JB) {
            f32x4 g[JB], sc[JB], sh[JB];
#pragma unroll
            for (int j = 0; j < JB; ++j) { const int c = 4 * (lane + 64 * (jb + j)); g[j] = *(const f32x4*)(gain + c); sc[j] = *(const f32x4*)(mp + sc_off + c); sh[j] = *(const f32x4*)(mp + sh_off + c); }
#pragma unroll
            for (int j = 0; j < JB; ++j) { const int c = 4 * (lane + 64 * (jb + j));
                const f32x4 o = v[jb + j] * rstd * g[j] * (sc[j] + 1.0f) + sh[j];
                if (UQ == 2) { v[jb + j] = o; amx = fmaxf(fmaxf(amx, fmaxf(fabsf(o[0]), fabsf(o[1]))), fmaxf(fabsf(o[2]), fabsf(o[3]))); }
                else { u32x2 w; w.x = cvt_pk_bf16(o[0], o[1]); w.y = cvt_pk_bf16(o[2], o[3]); *(u32x2*)(up + c) = w; } }
            if (UQ) asm volatile("" ::: "memory");
        }
        if (UQ == 2) {
#pragma unroll
            for (int o = 1; o < 64; o <<= 1) amx = fmaxf(amx, __shfl_xor(amx, o));
            const float inv = amx > 0.f ? 127.f / amx : 0.f;
            if (lane == 0) su[m] = amx * (1.f / 127.f);
#pragma unroll
            for (int j = 0; j < 16; ++j) *(unsigned*)(up8 + 4 * (lane + 64 * j)) = pk4_i8(v[j][0], v[j][1], v[j][2], v[j][3], inv);
        }
    }
}

template <bool SLAB, int UQ = 0> __device__ __forceinline__ void norm_sample_split(const Params& P, LAS unsigned char* lds, const float* __restrict__ xs, const float* __restrict__ gain, const float* __restrict__ mod, int sh_off, int sc_off,
                                                  bf16* __restrict__ U, const float* __restrict__ slab, float* __restrict__ x1out, int wave, int lane, float* __restrict__ su = nullptr) {
    LAS float* part = (LAS float*)lds;
    for (int rb = blockIdx.x; rb < NSA / 2; rb += gridDim.x) {
        const int r = 2 * rb + (wave >> 2), col0 = 1024 * (wave & 3), seq = NB + r / ST;
        const float* mp = mod + (size_t)seq * NMOD;
        f32x4 v[4];
#pragma unroll
        for (int j = 0; j < 4; ++j) v[j] = *(const f32x4*)(xs + (size_t)r * D + col0 + 4 * (lane + 64 * j));
        if (SLAB) {
#pragma unroll
            for (int q = 0; q < 8; ++q)
#pragma unroll
                for (int j = 0; j < 4; ++j) v[j] += *(const f32x4*)(slab + ((size_t)q * NSA + r) * D + col0 + 4 * (lane + 64 * j)); }
        float ss = 0.f;
#pragma unroll
        for (int j = 0; j < 4; ++j) { if (SLAB) *(f32x4*)(x1out + (size_t)r * D + col0 + 4 * (lane + 64 * j)) = v[j]; ss += (v[j][0] * v[j][0] + v[j][1] * v[j][1]) + (v[j][2] * v[j][2] + v[j][3] * v[j][3]); }
        ss = wave_sum(ss);
        __syncthreads();
        if (lane == 0) part[wave] = ss;
        __syncthreads();
        const int w0 = wave & 4; const float tot = (part[w0] + part[w0 + 1]) + (part[w0 + 2] + part[w0 + 3]);
        const float rstd = __builtin_amdgcn_rsqf(tot * (1.0f / D) + RMS_EPS);
        bf16* up = U + (size_t)(NPR + r) * D; unsigned char* up8 = (unsigned char*)U + (size_t)(NPR + r) * D;
        float amx = 0.f;
#pragma unroll
        for (int j = 0; j < 4; ++j) { const int c = col0 + 4 * (lane + 64 * j);
            const f32x4 o = v[j] * rstd * *(const f32x4*)(gain + c) * (*(const f32x4*)(mp + sc_off + c) + 1.0f) + *(const f32x4*)(mp + sh_off + c);
            if (UQ == 2) { v[j] = o; amx = fmaxf(fmaxf(amx, fmaxf(fabsf(o[0]), fabsf(o[1]))), fmaxf(fabsf(o[2]), fabsf(o[3]))); }
            else { u32x2 w; w.x = cvt_pk_bf16(o[0], o[1]); w.y = cvt_pk_bf16(o[2], o[3]); *(u32x2*)(up + c) = w; } }
        if (UQ == 2) {
#pragma unroll
            for (int o = 1; o < 64; o <<= 1) amx = fmaxf(amx, __shfl_xor(amx, o));
            if (lane == 0) part[8 + wave] = amx;
            __syncthreads();
            const float rmx = fmaxf(fmaxf(part[8 + w0], part[8 + w0 + 1]), fmaxf(part[8 + w0 + 2], part[8 + w0 + 3]));
            const float inv = rmx > 0.f ? 127.f / rmx : 0.f;
            if (lane == 0 && (wave & 3) == 0) su[NPR + r] = rmx * (1.f / 127.f);
#pragma unroll
            for (int j = 0; j < 4; ++j) *(unsigned*)(up8 + col0 + 4 * (lane + 64 * j)) = pk4_i8(v[j][0], v[j][1], v[j][2], v[j][3], inv);
        }
    }
}
__device__ __forceinline__ void attn_unit(const bf16* Qp, const bf16* Kp0, const bf16* Kp1, int nks, int ks_split, const bf16* Vt, int dq0, const LAS float* tab, bf16* Op, int lane) {
    const int c = lane & 15, g = lane >> 4;
    bf16x8 qf[2][4];
#pragma unroll
    for (int qt = 0; qt < 2; ++qt)
#pragma unroll
        for (int ds = 0; ds < 4; ++ds) qf[qt][ds] = *(const bf16x8*)(Qp + (unsigned)((16 * qt + c) * HD + 32 * ds + 8 * g));
    f32x4 o[8][2];
#pragma unroll
    for (int dt = 0; dt < 8; ++dt) { o[dt][0] = (f32x4){0.f, 0.f, 0.f, 0.f}; o[dt][1] = (f32x4){0.f, 0.f, 0.f, 0.f}; }
    float mrun[2] = {-1e30f, -1e30f}, lrun[2] = {0.f, 0.f};
    const int kr0 = 8 * (c >> 2) + (c & 3);
    const float bfar = tab[256];
    const unsigned koff = (unsigned)(kr0 * HD + 8 * g), voff = (unsigned)(c * 32 + 8 * g);
    bf16x8 kf[2][4], vf[8];
    {
        const bf16* kb = 0 < ks_split ? Kp0 : Kp1;
#pragma unroll
        for (int tau = 0; tau < 2; ++tau)
#pragma unroll
            for (int ds = 0; ds < 4; ++ds) kf[tau][ds] = *(const bf16x8*)(kb + tau * 4 * HD + 32 * ds + koff);
#pragma unroll
        for (int dt = 0; dt < 8; ++dt) vf[dt] = *(const bf16x8*)(Vt + dt * 512 + voff);
    }
    for (int ks = 0; ks < nks; ++ks) {
        f32x4 s[2][2];
#pragma unroll
        for (int qt = 0; qt < 2; ++qt)
#pragma unroll
            for (int tau = 0; tau < 2; ++tau) { f32x4 a = (f32x4){0.f, 0.f, 0.f, 0.f};
#pragma unroll
                for (int ds = 0; ds < 4; ++ds) a = __builtin_amdgcn_mfma_f32_16x16x32_bf16(kf[tau][ds], qf[qt][ds], a, 0, 0, 0);
                s[qt][tau] = a; }
        __builtin_amdgcn_sched_barrier(0);
        if (ks + 1 < nks) {
            const int kn = ks + 1; const bf16* kb = kn < ks_split ? Kp0 + (size_t)(32 * kn) * HD : Kp1 + (size_t)(32 * (kn - ks_split)) * HD;
#pragma unroll
            for (int tau = 0; tau < 2; ++tau)
#pragma unroll
                for (int ds = 0; ds < 4; ++ds) kf[tau][ds] = *(const bf16x8*)(kb + tau * 4 * HD + 32 * ds + koff);
        }
        __builtin_amdgcn_sched_barrier(0);
        const int dstep = dq0 - 32 * ks;
        if (dstep - 31 >= 128) {
#pragma unroll
            for (int qt = 0; qt < 2; ++qt)
#pragma unroll
                for (int tau = 0; tau < 2; ++tau) s[qt][tau] += bfar;
        } else {
#pragma unroll
            for (int qt = 0; qt < 2; ++qt)
#pragma unroll
                for (int tau = 0; tau < 2; ++tau)
#pragma unroll
                    for (int e = 0; e < 4; ++e) { int rel = dstep + 16 * qt + c - (8 * g + 4 * tau + e); rel = rel < -128 ? -128 : (rel > 128 ? 128 : rel); s[qt][tau][e] += tab[rel + 128]; }
        }
        bf16x8 pf[2];
#pragma unroll
        for (int qt = 0; qt < 2; ++qt) {
            float mx = fmaxf(fmaxf(fmaxf(s[qt][0][0], s[qt][0][1]), fmaxf(s[qt][0][2], s[qt][0][3])), fmaxf(fmaxf(s[qt][1][0], s[qt][1][1]), fmaxf(s[qt][1][2], s[qt][1][3])));
            mx = xrow16_max(mx);
            const float mn = fmaxf(mrun[qt], mx), alpha = __builtin_amdgcn_exp2f(mrun[qt] - mn);
            const bool grew = __any(mn > mrun[qt]); mrun[qt] = mn;
            f32x4 p0, p1;
#pragma unroll
            for (int e = 0; e < 4; ++e) { p0[e] = __builtin_amdgcn_exp2f(s[qt][0][e] - mn); p1[e] = __builtin_amdgcn_exp2f(s[qt][1][e] - mn); }
            lrun[qt] = lrun[qt] * alpha + ((p0[0] + p0[1]) + (p0[2] + p0[3])) + ((p1[0] + p1[1]) + (p1[2] + p1[3]));
            if (grew) {
#pragma unroll
                for (int dt = 0; dt < 8; ++dt) o[dt][qt] *= alpha; }
            u32x4 w; w.x = cvt_pk_bf16(p0[0], p0[1]); w.y = cvt_pk_bf16(p0[2], p0[3]); w.z = cvt_pk_bf16(p1[0], p1[1]); w.w = cvt_pk_bf16(p1[2], p1[3]);
            pf[qt] = __builtin_bit_cast(bf16x8, w);
        }
#pragma unroll
        for (int dt = 0; dt < 8; ++dt)
#pragma unroll
            for (int qt = 0; qt < 2; ++qt) o[dt][qt] = __builtin_amdgcn_mfma_f32_16x16x32_bf16(vf[dt], pf[qt], o[dt][qt], 0, 0, 0);
        __builtin_amdgcn_sched_barrier(0);
        if (ks + 1 < nks) {
            const bf16* vb = Vt + (size_t)(ks + 1) * (HD * 32);
#pragma unroll
            for (int dt = 0; dt < 8; ++dt) vf[dt] = *(const bf16x8*)(vb + dt * 512 + voff);
        }
        __builtin_amdgcn_sched_barrier(0);
    }
#pragma unroll
    for (int qt = 0; qt < 2; ++qt) {
        const float l = xrow16_sum(lrun[qt]);
        const float inv = 1.0f / l;
        bf16* op = Op + (unsigned)((16 * qt + c) * D + 4 * g); unsigned char* op8 = (unsigned char*)Op + (unsigned)((16 * qt + c) * D + 4 * g);
#pragma unroll
        for (int dt = 0; dt < 8; ++dt) { const f32x4 v = o[dt][qt] * inv;
            if (F8_OUT) *(unsigned*)(op8 + 16 * dt) = pk4_fp8(v[0], v[1], v[2], v[3]);
            else { u32x2 w; w.x = cvt_pk_bf16(v[0], v[1]); w.y = cvt_pk_bf16(v[2], v[3]); *(u32x2*)(op + 16 * dt) = w; } }
    }
}
__device__ __forceinline__ void attn_block_unit(const bf16* Qh, const bf16* Kh, const bf16* VtP, bf16* MIX, int bh, int qb, const LAS float* tabh, LAS unsigned char* ring, int wave, int lane) {
    const int c = lane & 15, g = lane >> 4, b = bh >> 4, h = bh & 15;
    const int ci0 = 4 * qb, ci = ci0 + (wave >> 1), q0 = 64 * ci + 32 * (wave & 1);
    const int kt0 = ci0 > 8 ? ci0 - 8 : 0, nt = ci0 + 3 - kt0 + 1;
    const bf16* Qp = Qh + ((size_t)bh * T + q0) * HD;
    bf16x8 qf[2][4];
#pragma unroll
    for (int qt = 0; qt < 2; ++qt)
#pragma unroll
        for (int ds = 0; ds < 4; ++ds) qf[qt][ds] = *(const bf16x8*)(Qp + (unsigned)((16 * qt + c) * HD + 32 * ds + 8 * g));
    f32x4 o[8][2];
#pragma unroll
    for (int dt = 0; dt < 8; ++dt) { o[dt][0] = (f32x4){0.f, 0.f, 0.f, 0.f}; o[dt][1] = (f32x4){0.f, 0.f, 0.f, 0.f}; }
    float mrun[2] = {-1e30f, -1e30f};
    f32x4 ol[2] = {(f32x4){0.f, 0.f, 0.f, 0.f}, (f32x4){0.f, 0.f, 0.f, 0.f}};
    const bf16x8 ones = (bf16x8){0x3F80, 0x3F80, 0x3F80, 0x3F80, 0x3F80, 0x3F80, 0x3F80, 0x3F80};
    const float bfar = tabh[256];
    unsigned ksrc[2];
#pragma unroll
    for (int j = 0; j < 2; ++j) { const int r = 4 * (2 * wave + j) + (lane >> 4), pos = lane & 15, sw = (((r >> 3) & 3) << 2) | (r & 3); ksrc[j] = (unsigned)(r * HD + ((pos ^ sw) << 3)); }
    const unsigned vsrc = (unsigned)(wave * 1024 + lane * 8);
    const bf16* Kbase = Kh + (size_t)bh * T * HD; const bf16* Vbase = VtP + (size_t)bh * (T / 32) * HD * 32;
#define ATTN_DMA(kt, slot) do { const bf16* kp_ = Kbase + (size_t)(kt) * (64 * HD); const bf16* vp_ = Vbase + (size_t)(kt) * (64 * HD) + vsrc; LAS unsigned char* sl_ = ring + (slot) * 32768 + wave * 2048; \
        __builtin_amdgcn_global_load_lds((const unsigned*)(kp_ + ksrc[0]), (LAS unsigned*)(sl_), 16, 0, 0); \
        __builtin_amdgcn_global_load_lds((const unsigned*)(kp_ + ksrc[1]), (LAS unsigned*)(sl_ + 1024), 16, 0, 0); \
        __builtin_amdgcn_global_load_lds((const unsigned*)(vp_), (LAS unsigned*)(sl_ + 16384), 16, 0, 0); \
        __builtin_amdgcn_global_load_lds((const unsigned*)(vp_ + 512), (LAS unsigned*)(sl_ + 16384 + 1024), 16, 0, 0); } while (0)
    asm volatile("s_waitcnt vmcnt(0)" ::: "memory");
    ATTN_DMA(kt0, 0); ATTN_DMA(kt0 + 1, 1);
    const int kr0 = 8 * (c >> 2) + (c & 3);
    int slot = 0;
    for (int i = 0; i < nt; ++i) {
        asm volatile("s_waitcnt vmcnt(4)" ::: "memory");
        __builtin_amdgcn_s_barrier();
        asm volatile("" ::: "memory");
        { const int in = i + 2 < nt ? i + 2 : nt - 1; int sn = slot + 2; sn = sn >= 3 ? sn - 3 : sn; ATTN_DMA(kt0 + in, sn); }
        const int kt = kt0 + i;
        if (kt >= ci - 8 && kt <= ci) {
            const LAS unsigned char* ks_ = ring + slot * 32768; const LAS unsigned char* vs_ = ks_ + 16384;
#pragma unroll
            for (int st = 0; st < 2; ++st) {
                bf16x8 kf[2][4];
#pragma unroll
                for (int tau = 0; tau < 2; ++tau)
#pragma unroll
                    for (int ds = 0; ds < 4; ++ds) kf[tau][ds] = *(const LAS bf16x8*)(ks_ + (32 * st + kr0 + 4 * tau) * 256 + (((4 * ds + g) ^ c) << 4));
                f32x4 s[2][2];
#pragma unroll
                for (int qt = 0; qt < 2; ++qt)
#pragma unroll
                    for (int tau = 0; tau < 2; ++tau) { f32x4 a = (f32x4){0.f, 0.f, 0.f, 0.f};
#pragma unroll
                        for (int ds = 0; ds < 4; ++ds) a = __builtin_amdgcn_mfma_f32_16x16x32_bf16(kf[tau][ds], qf[qt][ds], a, 0, 0, 0);
                        s[qt][tau] = a; }
                bf16x8 vf[8];
#pragma unroll
                for (int dt = 0; dt < 8; ++dt) vf[dt] = *(const LAS bf16x8*)(vs_ + st * 8192 + (16 * dt + c) * 64 + g * 16);
                const int dstep = q0 - (64 * kt + 32 * st);
                const bool far = dstep - 31 >= 128;
                const float badd = far ? bfar : 0.f;
                if (!far) {
#pragma unroll
                    for (int qt = 0; qt < 2; ++qt)
#pragma unroll
                        for (int tau = 0; tau < 2; ++tau)
#pragma unroll
                            for (int e = 0; e < 4; ++e) { int rel = dstep + 16 * qt + c - (8 * g + 4 * tau + e); rel = rel < -128 ? -128 : (rel > 128 ? 128 : rel); s[qt][tau][e] += tabh[rel + 128]; }
                }
                bf16x8 pf[2];
#pragma unroll
                for (int qt = 0; qt < 2; ++qt) {
                    float mx = fmaxf(fmaxf(fmaxf(s[qt][0][0], s[qt][0][1]), fmaxf(s[qt][0][2], s[qt][0][3])), fmaxf(fmaxf(s[qt][1][0], s[qt][1][1]), fmaxf(s[qt][1][2], s[qt][1][3])));
                    mx = xrow16_max(mx) + badd;
                    const float mn = fmaxf(mrun[qt], mx), alpha = __builtin_amdgcn_exp2f(mrun[qt] - mn), coff = badd - mn;
                    const bool grew = __any(mn > mrun[qt]); mrun[qt] = mn;
                    f32x4 p0, p1;
#pragma unroll
                    for (int e = 0; e < 4; ++e) { p0[e] = __builtin_amdgcn_exp2f(s[qt][0][e] + coff); p1[e] = __builtin_amdgcn_exp2f(s[qt][1][e] + coff); }
                    if (grew) {
#pragma unroll
                        for (int dt = 0; dt < 8; ++dt) o[dt][qt] *= alpha;
                        ol[qt] *= alpha; }
                    u32x4 w; w.x = cvt_pk_bf16(p0[0], p0[1]); w.y = cvt_pk_bf16(p0[2], p0[3]); w.z = cvt_pk_bf16(p1[0], p1[1]); w.w = cvt_pk_bf16(p1[2], p1[3]);
                    pf[qt] = __builtin_bit_cast(bf16x8, w);
                }
#pragma unroll
                for (int dt = 0; dt < 8; ++dt)
#pragma unroll
                    for (int qt = 0; qt < 2; ++qt) o[dt][qt] = __builtin_amdgcn_mfma_f32_16x16x32_bf16(vf[dt], pf[qt], o[dt][qt], 0, 0, 0);
#pragma unroll
                for (int qt = 0; qt < 2; ++qt) ol[qt] = __builtin_amdgcn_mfma_f32_16x16x32_bf16(ones, pf[qt], ol[qt], 0, 0, 0);
            }
            asm volatile("s_waitcnt lgkmcnt(0)" ::: "memory");
        }
        slot = slot == 2 ? 0 : slot + 1;
    }
#undef ATTN_DMA
    bf16* Op = F8_OUT ? (bf16*)((unsigned char*)MIX + (size_t)(b * T + q0) * D + h * HD) : MIX + (size_t)(b * T + q0) * D + h * HD;
#pragma unroll
    for (int qt = 0; qt < 2; ++qt) {
        const float inv = 1.0f / ol[qt][0];
        bf16* op = Op + (unsigned)((16 * qt + c) * D + 4 * g); unsigned char* op8 = (unsigned char*)Op + (unsigned)((16 * qt + c) * D + 4 * g);
#pragma unroll
        for (int dt = 0; dt < 8; ++dt) { const f32x4 v = o[dt][qt] * inv;
            if (F8_OUT) *(unsigned*)(op8 + 16 * dt) = pk4_fp8(v[0], v[1], v[2], v[3]);
            else { u32x2 w; w.x = cvt_pk_bf16(v[0], v[1]); w.y = cvt_pk_bf16(v[2], v[3]); *(u32x2*)(op + 16 * dt) = w; } }
    }
    asm volatile("s_waitcnt vmcnt(0)" ::: "memory");
    __builtin_amdgcn_s_barrier();
    asm volatile("" ::: "memory");
}
__device__ __forceinline__ void attn_phase(const Params& P, LAS unsigned char* lds, int tid, int wave, int lane) {
    LAS float* tab = (LAS float*)(lds + 98304);
    for (int i = tid; i < NH * 257; i += NWAVES * 64) { const int h = i / 257, r = i % 257; tab[h * 260 + r] = P.in[I_RELB][i] * LOG2E; }
    __syncthreads();
    const bf16* Q = (const bf16*)(P.ws + WS_Q); const bf16* K = (const bf16*)(P.ws + WS_K); const bf16* Kc = (const bf16*)(P.ws + WS_KC);
    const bf16* VtP = (const bf16*)(P.ws + WS_VTP); const bf16* VtS = (const bf16*)(P.ws + WS_VTS); bf16* MIX = (bf16*)(P.ws + WS_MIX);
    if (P.sub & 4) for (int u = blockIdx.x; u < NB * NH * 16; u += gridDim.x) {
        const int bh = u & 31, qb = u >> 5;
        attn_block_unit(Q, K, VtP, MIX, bh, qb, tab + (bh & 15) * 260, lds, wave, lane);
    }
    {
        unsigned* ctl = (unsigned*)(P.ws + WS_CTL);
        if (tid == 0) {
            unsigned sp = 0;
            while (__hip_atomic_load(ctl + CW_ARRIVE + 768, __ATOMIC_RELAXED, __HIP_MEMORY_SCOPE_AGENT) < gridDim.x) { __builtin_amdgcn_s_sleep(2);
                if ((++sp & 255u) == 0u) { if (__hip_atomic_load(ctl + CW_TMO2, __ATOMIC_RELAXED, __HIP_MEMORY_SCOPE_AGENT)) break; if (sp > (1u << 20)) { __hip_atomic_store(ctl + CW_TMO2, 1u, __ATOMIC_RELAXED, __HIP_MEMORY_SCOPE_AGENT); break; } } }
            __builtin_amdgcn_fence(__ATOMIC_ACQUIRE, "agent"); VM_WAIT();
        }
        __syncthreads();
    }
    if ((P.sub & 2) && wave == (int)(blockIdx.x & 7)) for (int su = blockIdx.x; su < SB * NH; su += gridDim.x) {
        const int b = su >> 4, h = su & 15; const size_t srow = (size_t)NPR * AW + (size_t)(b * NH + h) * ST * HD;
        attn_unit(Q + srow, Kc + (size_t)(b * NH + h) * CROWS * HD, K + srow, 17, 16, VtS + (size_t)(b * NH + h) * (KS_LD / 32) * HD * 32, 512, tab + h * 260, F8_OUT ? (bf16*)((unsigned char*)MIX + (size_t)(NPR + b * ST) * D + h * HD) : MIX + (size_t)(NPR + b * ST) * D + h * HD, lane);
    }
}
__device__ __forceinline__ float neg_expm1(float z, float ez) {
    float p = 1.0f + z * (1.0f / 7.0f); p = 1.0f + z * (1.0f / 6.0f) * p; p = 1.0f + z * 0.2f * p; p = 1.0f + z * 0.25f * p; p = 1.0f + z * (1.0f / 3.0f) * p; p = 1.0f + z * 0.5f * p;
    return z > -0.25f ? -z * p : 1.0f - ez;
}
template <int PASS> __device__ __forceinline__ void lru_unit(const Params& P, LAS unsigned char* lds, int unit, int tid, int wave, int lane) {
    int seq, chunk, n;
    if (unit < NB * 64 * 16) { n = unit & 15; chunk = (unit >> 4) & 63; seq = unit >> 10; } else { const int r = unit - NB * 64 * 16; n = r & 15; chunk = 0; seq = NB + (r >> 4); }
    const bool prompt = seq < NB; const int rows = prompt ? 64 : 32; const int m0 = prompt ? seq * T + chunk * 64 : NPR + (seq - NB) * ST;
    LAS float* XF = (LAS float*)lds;
    LAS bf16* XB = (LAS bf16*)(lds + 64 * 132 * 4);
    const float* XR = (const float*)(P.ws + WS_XR);
    const int c = lane & 15, g = lane >> 4, cw = wave * 16 + c, ch = n * 128 + cw;
    bf16x8 ba[4], bx[4];
    {
        const bf16* wp = (const bf16*)(P.ws + WS_WRG) + ((size_t)n * 256 + cw) * 128 + 8 * g;
#pragma unroll
        for (int ks = 0; ks < 4; ++ks) { ba[ks] = *(const bf16x8*)(wp + 32 * ks); bx[ks] = *(const bf16x8*)(wp + 128 * 128 + 32 * ks); }
    }
    const float bra = P.in[I_BRA][ch], brx = P.in[I_BRX][ch], lam = P.in[I_LAM][ch];
    float hin = 0.f;
    if (PASS == 2) {
        if (prompt) {
            const f32x2* ls = (const f32x2*)(P.ws + WS_LSUM) + (size_t)seq * 64 * LW + ch;
            f32x2 sm[16];
#pragma unroll
            for (int i = 0; i < 16; ++i) { const int ci = 16 * g + i; sm[i] = ci < chunk ? ls[(size_t)ci * LW] : (f32x2){1.f, 0.f}; }
            float Ag = 1.f, Hg = 0.f;
#pragma unroll
            for (int i = 0; i < 16; ++i) { Hg = sm[i][0] * Hg + sm[i][1]; Ag *= sm[i][0]; }
#pragma unroll
            for (int q = 0; q < 4; ++q) { const float Aq = __shfl(Ag, c + 16 * q), Hq = __shfl(Hg, c + 16 * q); hin = Aq * hin + Hq; }
        } else hin = P.in[I_SH][(seq - NB) * LW + ch];
    }
    {
        const int t = tid >> 3, cg = (tid & 7) * 16, col = n * 128 + cg;
        const bool live = t < rows;
        f32x4 xv[4][4], wv[4][4], xc[4];
#pragma unroll
        for (int i = 0; i < 4; ++i) { const int tt = t - 3 + i;
            const bool fromx = tt >= 0 || (prompt && chunk > 0), froms = !fromx && !prompt;
            const float* src = froms ? P.in[I_SCONV] + (size_t)((seq - NB) * 3 + 3 + tt) * LW : XR + (size_t)(m0 + ((fromx && live) ? tt : 0)) * LW;
            const float wsc = (live && (fromx || froms)) ? 1.f : 0.f;
#pragma unroll
            for (int q = 0; q < 4; ++q) { xv[i][q] = *(const f32x4*)(src + col + 4 * q); wv[i][q] = *(const f32x4*)(P.in[I_CONVW] + (size_t)i * LW + col + 4 * q) * wsc; } }
#pragma unroll
        for (int q = 0; q < 4; ++q) { xc[q] = live ? *(const f32x4*)(P.in[I_CONVB] + col + 4 * q) : (f32x4){0.f, 0.f, 0.f, 0.f};
#pragma unroll
            for (int i = 0; i < 4; ++i) xc[q] += wv[i][q] * xv[i][q]; }
#pragma unroll
        for (int q = 0; q < 4; ++q) *(LAS f32x4*)(XF + t * 132 + cg + 4 * q) = xc[q];
        u32x4 w0, w1; w0.x = cvt_pk_bf16(xc[0][0], xc[0][1]); w0.y = cvt_pk_bf16(xc[0][2], xc[0][3]); w0.z = cvt_pk_bf16(xc[1][0], xc[1][1]); w0.w = cvt_pk_bf16(xc[1][2], xc[1][3]);
        w1.x = cvt_pk_bf16(xc[2][0], xc[2][1]); w1.y = cvt_pk_bf16(xc[2][2], xc[2][3]); w1.z = cvt_pk_bf16(xc[3][0], xc[3][1]); w1.w = cvt_pk_bf16(xc[3][2], xc[3][3]);
        *(LAS u32x4*)(XB + t * 136 + cg) = w0; *(LAS u32x4*)(XB + t * 136 + cg + 8) = w1;
    }
    __syncthreads();
    f32x4 accA[4], accX[4];
#pragma unroll
    for (int mt = 0; mt < 4; ++mt) { accA[mt] = (f32x4){0.f, 0.f, 0.f, 0.f}; accX[mt] = (f32x4){0.f, 0.f, 0.f, 0.f};
#pragma unroll
        for (int ks = 0; ks < 4; ++ks) { const bf16x8 af = *(const LAS bf16x8*)(XB + (16 * mt + c) * 136 + 32 * ks + 8 * g);
            accA[mt] = __builtin_amdgcn_mfma_f32_16x16x32_bf16(af, ba[ks], accA[mt], 0, 0, 0); accX[mt] = __builtin_amdgcn_mfma_f32_16x16x32_bf16(af, bx[ks], accX[mt], 0, 0, 0); } }
    const float c8 = -8.0f * log1pf(__expf(-lam));
    float av[4][4], bv[4][4];
#pragma unroll
    for (int mt = 0; mt < 4; ++mt)
#pragma unroll
        for (int e = 0; e < 4; ++e) { const float r = fast_sigmoid(accA[mt][e] + bra), ig = fast_sigmoid(accX[mt][e] + brx), la = c8 * r;
            const float a = __builtin_amdgcn_exp2f(la * LOG2E); av[mt][e] = a; bv[mt][e] = __builtin_amdgcn_sqrtf(neg_expm1(2.0f * la, a * a)) * ig * XF[(16 * mt + 4 * g + e) * 132 + cw]; }
    if (PASS == 1) {
        float Am[4], Bm[4];
#pragma unroll
        for (int mt = 0; mt < 4; ++mt) { Am[mt] = av[mt][0] * av[mt][1] * av[mt][2] * av[mt][3]; Bm[mt] = ((bv[mt][0] * av[mt][1] + bv[mt][1]) * av[mt][2] + bv[mt][2]) * av[mt][3] + bv[mt][3]; }
#pragma unroll
        for (int mt = 0; mt < 4; ++mt) { const float Ao = __shfl_xor(Am[mt], 16), Bo = __shfl_xor(Bm[mt], 16);
            const float A1 = (g & 1) ? Ao : Am[mt], B1 = (g & 1) ? Bo : Bm[mt], A2 = (g & 1) ? Am[mt] : Ao, B2 = (g & 1) ? Bm[mt] : Bo; Am[mt] = A1 * A2; Bm[mt] = A2 * B1 + B2; }
#pragma unroll
        for (int mt = 0; mt < 4; ++mt) { const float Ao = __shfl_xor(Am[mt], 32), Bo = __shfl_xor(Bm[mt], 32);
            const float A1 = (g & 2) ? Ao : Am[mt], B1 = (g & 2) ? Bo : Bm[mt], A2 = (g & 2) ? Am[mt] : Ao, B2 = (g & 2) ? Bm[mt] : Bo; Am[mt] = A1 * A2; Bm[mt] = A2 * B1 + B2; }
        float at = Am[0], ht = Bm[0];
#pragma unroll
        for (int mt = 1; mt < 4; ++mt) { ht = Am[mt] * ht + Bm[mt]; at *= Am[mt]; }
        if (g == 0) ((f32x2*)(P.ws + WS_LSUM))[((size_t)seq * 64 + chunk) * LW + ch] = (f32x2){at, ht};
        f32x4* ab = (f32x4*)(P.ws + WS_AB) + ((size_t)unit * 8 + wave) * 512 + lane;
#pragma unroll
        for (int mt = 0; mt < 4; ++mt) { ab[mt * 64] = (f32x4){av[mt][0], av[mt][1], av[mt][2], av[mt][3]}; ab[(4 + mt) * 64] = (f32x4){bv[mt][0], bv[mt][1], bv[mt][2], bv[mt][3]}; }
        __syncthreads();
        return;
    }
    float atot = 1.f;
    const int lastmt = rows / 16 - 1;
#pragma unroll
    for (int mt = 0; mt < 4; ++mt) {
        float A = av[mt][0] * av[mt][1] * av[mt][2] * av[mt][3];
        float B = ((bv[mt][0] * av[mt][1] + bv[mt][1]) * av[mt][2] + bv[mt][2]) * av[mt][3] + bv[mt][3];
        { const float Ap = __shfl_up(A, 16), Bp = __shfl_up(B, 16); if (g >= 1) { B = A * Bp + B; A = A * Ap; } }
        { const float Ap = __shfl_up(A, 32), Bp = __shfl_up(B, 32); if (g >= 2) { B = A * Bp + B; A = A * Ap; } }
        const float hend = A * hin + B;
        const float hprev = __shfl_up(hend, 16);
        if (PASS == 2) {
            float h = g == 0 ? hin : hprev;
#pragma unroll
            for (int e = 0; e < 4; ++e) { h = av[mt][e] * h + bv[mt][e]; XF[(16 * mt + 4 * g + e) * 132 + cw] = h; }
            if (mt == lastmt && g == 3 && (!prompt || chunk == 63)) { if (prompt) P.out[O_HP + (size_t)seq * LW + ch] = h; else P.out[O_HS + (size_t)(seq - NB) * LW + ch] = h; }
        }
        hin = __shfl(hend, c + 48); atot *= __shfl(A, c + 48);
    }
    if (PASS == 1) {
        if (g == 0) ((f32x2*)(P.ws + WS_LSUM))[((size_t)seq * 64 + chunk) * LW + ch] = (f32x2){atot, hin};
        f32x4* ab = (f32x4*)(P.ws + WS_AB) + ((size_t)unit * 8 + wave) * 512 + lane;
#pragma unroll
        for (int mt = 0; mt < 4; ++mt) { ab[mt * 64] = (f32x4){av[mt][0], av[mt][1], av[mt][2], av[mt][3]}; ab[(4 + mt) * 64] = (f32x4){bv[mt][0], bv[mt][1], bv[mt][2], bv[mt][3]}; }
    }
    if (PASS == 2) {
        __syncthreads();
        const int t = tid >> 3, cg = (tid & 7) * 16;
        if (t < rows) {
            const bf16* gp = (const bf16*)(P.ws + WS_GG) + (size_t)(m0 + t) * LW + n * 128 + cg; bf16* op = (bf16*)(P.ws + WS_MIX) + (size_t)(m0 + t) * D + AW + n * 128 + cg;
#pragma unroll
            for (int q = 0; q < 2; ++q) { const u32x4 gw4 = *(const u32x4*)(gp + 8 * q); const f32x4 h0 = *(const LAS f32x4*)(XF + t * 132 + cg + 8 * q), h1 = *(const LAS f32x4*)(XF + t * 132 + cg + 8 * q + 4);
                u32x4 w;
                w.x = cvt_pk_bf16(h0[0] * gelu_tanh(__uint_as_float(gw4.x << 16)), h0[1] * gelu_tanh(__uint_as_float(gw4.x & 0xffff0000u))); w.y = cvt_pk_bf16(h0[2] * gelu_tanh(__uint_as_float(gw4.y << 16)), h0[3] * gelu_tanh(__uint_as_float(gw4.y & 0xffff0000u)));
                w.z = cvt_pk_bf16(h1[0] * gelu_tanh(__uint_as_float(gw4.z << 16)), h1[1] * gelu_tanh(__uint_as_float(gw4.z & 0xffff0000u))); w.w = cvt_pk_bf16(h1[2] * gelu_tanh(__uint_as_float(gw4.w << 16)), h1[3] * gelu_tanh(__uint_as_float(gw4.w & 0xffff0000u)));
                if (F8_OUT) { u32x2 w8;
                    w8.x = pk4_fp8(h0[0] * gelu_tanh(__uint_as_float(gw4.x << 16)), h0[1] * gelu_tanh(__uint_as_float(gw4.x & 0xffff0000u)), h0[2] * gelu_tanh(__uint_as_float(gw4.y << 16)), h0[3] * gelu_tanh(__uint_as_float(gw4.y & 0xffff0000u)));
                    w8.y = pk4_fp8(h1[0] * gelu_tanh(__uint_as_float(gw4.z << 16)), h1[1] * gelu_tanh(__uint_as_float(gw4.z & 0xffff0000u)), h1[2] * gelu_tanh(__uint_as_float(gw4.w << 16)), h1[3] * gelu_tanh(__uint_as_float(gw4.w & 0xffff0000u)));
                    *(u32x2*)(P.ws + WS_MIX + (size_t)(m0 + t) * D + AW + n * 128 + cg + 8 * q) = w8; }
                else *(u32x4*)(op + 8 * q) = w; }
        }
    }
    __syncthreads();
}

__device__ __forceinline__ void lru_final_wave(const Params& P, int wu, int lane) {
    asm volatile("" : "+v"(lane));
    const int unit = wu >> 3, w = wu & 7, n = unit & 15, chunk = (unit >> 4) & 63, seq = unit >> 10;
    const int c = lane & 15, g = lane >> 4, cw = w * 16 + c, ch = n * 128 + cw, m0 = seq * T + chunk * 64;
    const f32x4* ab = (const f32x4*)(P.ws + WS_AB) + (size_t)wu * 512 + lane;
    f32x4 a4[4], b4[4];
#pragma unroll
    for (int mt = 0; mt < 4; ++mt) { a4[mt] = ab[mt * 64]; b4[mt] = ab[(4 + mt) * 64]; }
    const bf16* gp = (const bf16*)(P.ws + WS_GG) + (size_t)m0 * LW + ch;
    bf16 gg[4][4];
#pragma unroll
    for (int mt = 0; mt < 4; ++mt)
#pragma unroll
        for (int e = 0; e < 4; ++e) gg[mt][e] = gp[(size_t)(16 * mt + 4 * g + e) * LW];
    float hin = 0.f;
    {
        const f32x2* ls = (const f32x2*)(P.ws + WS_LSUM) + (size_t)seq * 64 * LW + ch;
        f32x2 sm[16];
#pragma unroll
        for (int i = 0; i < 16; ++i) { const int ci = 16 * g + i; sm[i] = ci < chunk ? ls[(size_t)ci * LW] : (f32x2){1.f, 0.f}; }
        float Ag = 1.f, Hg = 0.f;
#pragma unroll
        for (int i = 0; i < 16; ++i) { Hg = sm[i][0] * Hg + sm[i][1]; Ag *= sm[i][0]; }
#pragma unroll
        for (int q = 0; q < 4; ++q) { const float Aq = __shfl(Ag, c + 16 * q), Hq = __shfl(Hg, c + 16 * q); hin = Aq * hin + Hq; }
    }
    bf16* op = (bf16*)(P.ws + WS_MIX) + (size_t)m0 * D + AW + ch;
#pragma unroll
    for (int mt = 0; mt < 4; ++mt) {
        float A = a4[mt][0] * a4[mt][1] * a4[mt][2] * a4[mt][3];
        float B = ((b4[mt][0] * a4[mt][1] + b4[mt][1]) * a4[mt][2] + b4[mt][2]) * a4[mt][3] + b4[mt][3];
        { const float Ap = __shfl_up(A, 16), Bp = __shfl_up(B, 16); if (g >= 1) { B = A * Bp + B; A = A * Ap; } }
        { const float Ap = __shfl_up(A, 32), Bp = __shfl_up(B, 32); if (g >= 2) { B = A * Bp + B; A = A * Ap; } }
        const float hend = A * hin + B;
        const float hprev = __shfl_up(hend, 16);
        float h = g == 0 ? hin : hprev;
#pragma unroll
        for (int e = 0; e < 4; ++e) { h = a4[mt][e] * h + b4[mt][e]; const float lo = h * gelu_tanh(__uint_as_float((unsigned)gg[mt][e] << 16));
            if (F8_OUT) (P.ws + WS_MIX + (size_t)m0 * D + AW + ch)[(size_t)(16 * mt + 4 * g + e) * D] = (unsigned char)(pk4_fp8(lo, 0.f, 0.f, 0.f) & 0xffu);
            else op[(size_t)(16 * mt + 4 * g + e) * D] = (bf16)f2bf(lo); }
        if (mt == 3 && g == 3 && chunk == 63) P.out[O_HP + (size_t)seq * LW + ch] = h;
        hin = __shfl(hend, c + 48);
    }
}
#ifndef MK_N_LAUNCHES
#define MK_N_LAUNCHES 1
#endif
constexpr int N_PHASES = 8;
constexpr int LRU1_IN_P2 = 1536;
#ifndef PG8_SP2
#define PG8_SP2 true
#endif
#ifndef PG8_ALIGN
#define PG8_ALIGN true
#endif
#ifdef PROBE_SAME
struct SameOrder { int ntf; __device__ bool next(int i, pg8::Unit& u) const { if (i >= 12) return false; u.pm = PROBE_SAME ? (int)(blockIdx.x & 7) : 0; u.pn = PROBE_SAME ? (int)((blockIdx.x >> 3) & 3) + 4 * (i & 1) : 0; u.kb = 0; u.nt = ntf; u.part = -1; return true; }
    __device__ __forceinline__ void a_ready(const pg8::Unit&) const {} __device__ __forceinline__ void done(const pg8::Unit&) const {} };
#endif
__global__ void __launch_bounds__(NWAVES * 64, 2) fwd(Params P) {
    extern __shared__ __attribute__((aligned(16))) unsigned char lds_raw[];
    LAS unsigned char* lds = (LAS unsigned char*)lds_raw;
    const int tid = threadIdx.x, lane = tid & 63, wave = __builtin_amdgcn_readfirstlane(tid >> 6);
    const int G = gridDim.x, gw = blockIdx.x * NWAVES + wave, NGW = G * NWAVES;
    volatile LAS unsigned* MISC = (volatile LAS unsigned*)(lds + MISC_OFF);
    if (tid < 32) MISC[tid] = 0u;
    __syncthreads();
    unsigned* ctl = (unsigned*)(P.ws + WS_CTL);
    XcdBarrier bar; bar.bar = ctl + CW_BAR; bar.x = 0; bar.st = nullptr;
    if (MK_N_LAUNCHES == 1) bar = xcd_barrier_post(ctl + CW_BAR, MISC + 8);
    const int lo = P.ph_lo, hi = P.ph_hi;
#ifndef PHASE_MASK
#define PHASE_MASK 0xff
#endif
#define IN(k) (((PHASE_MASK >> (k)) & 1) && lo <= (k) && (k) < hi)
#define SEAM(k) do { if (IN(k) && IN((k) + 1)) xcd_barrier(bar); } while (0)
    unsigned char* ws = P.ws;
    float* mod = (float*)(ws + WS_MOD);
    bf16* U = (bf16*)(ws + WS_U);

#ifdef PROBE_NT
    if (lo == 9) {
        pg8::Gemm g{U, (const bf16*)(ws + WS_WGU), NTOK, 2 * DFF, D};
#ifdef PROBE_SAME
        SameOrder S; S.ntf = PROBE_NT;
        EpiGlu<0> E{(bf16*)(ws + WS_END), 1.0f, nullptr, nullptr};
#ifndef PROBE_VAR
#define PROBE_VAR 0
#endif
        pg8::gemm_phase<EpiGlu<0>, SameOrder, PG8_ALIGN, PG8_SP2, PROBE_VAR>(lds, g, S, E);
#else
        pg8::StaticOrder S; S.init(NTOK, 2 * DFF, D, G, (int)blockIdx.x); S.ntf = PROBE_NT;
        EpiGlu<0> E{(bf16*)(ws + WS_END), 1.0f, nullptr, nullptr};
        pg8::gemm_phase<EpiGlu<0>, pg8::StaticOrder, PG8_ALIGN, PG8_SP2>(lds, g, S, E);
#endif
    }
#endif
    if (IN(0)) {
        p0_amax(P, gw, NGW, lane);
        VM_WAIT(); __syncthreads();
        if (tid == 0) { __builtin_amdgcn_fence(__ATOMIC_RELEASE, "agent"); VM_WAIT(); __hip_atomic_fetch_add(ctl + CW_ARRIVE + 896, 1u, __ATOMIC_RELAXED, __HIP_MEMORY_SCOPE_AGENT); }
        if (P.sub & 16) p0_mod(P, lds, tid, wave, lane);
        VM_WAIT(); __syncthreads();
        if (tid == 0) { __builtin_amdgcn_fence(__ATOMIC_RELEASE, "agent"); VM_WAIT(); __hip_atomic_fetch_add(ctl + CW_ARRIVE + 512, 1u, __ATOMIC_RELAXED, __HIP_MEMORY_SCOPE_AGENT); }
        if (P.sub & 32) p0_convert(P, lds, gw, NGW, wave, lane);
    }
    if (IN(1)) {
        if (tid == 0) {
            unsigned sp = 0;
            while (__hip_atomic_load(ctl + CW_ARRIVE + 512, __ATOMIC_RELAXED, __HIP_MEMORY_SCOPE_AGENT) < (unsigned)G) { __builtin_amdgcn_s_sleep(2);
                if ((++sp & 255u) == 0u) { if (__hip_atomic_load(ctl + CW_TMO2, __ATOMIC_RELAXED, __HIP_MEMORY_SCOPE_AGENT)) break; if (sp > (1u << 20)) { __hip_atomic_store(ctl + CW_TMO2, 1u, __ATOMIC_RELAXED, __HIP_MEMORY_SCOPE_AGENT); break; } } }
            __builtin_amdgcn_fence(__ATOMIC_ACQUIRE, "agent"); VM_WAIT();
        }
        __syncthreads();
        norm_sample_split<false>(P, lds, P.in[I_XS], P.in[I_G1], mod, 0 * D, 1 * D, U, nullptr, nullptr, wave, lane);
        norm_rows<false>(P.in[I_XP], P.in[I_XS], P.in[I_G1], mod, 0 * D, 1 * D, U, nullptr, nullptr, NPR, gw, NGW, lane);
    }
    SEAM(1);
    if (IN(2)) {
        pg8::Gemm g{U, (const bf16*)(ws + WS_WIN), NTOK, INC, D}; InOrder S; S.init(G, (int)blockIdx.x);
        EpiIn E{(bf16*)(ws + WS_Q), (bf16*)(ws + WS_K), (bf16*)(ws + WS_VTP), (bf16*)(ws + WS_VTS), (float*)(ws + WS_XR), (bf16*)(ws + WS_GG), P.out, P.in[I_QG], P.in[I_KG], (LAS float*)(lds + XCH_OFF)};
        pg8::gemm_phase<EpiIn, InOrder, PG8_ALIGN, PG8_SP2>(lds, g, S, E);
        VM_WAIT(); __syncthreads();
        if (tid == 0) { __builtin_amdgcn_fence(__ATOMIC_RELEASE, "agent"); VM_WAIT(); __hip_atomic_fetch_add(ctl + CW_ARRIVE, 1u, __ATOMIC_RELAXED, __HIP_MEMORY_SCOPE_AGENT); }
        S.mode = 1;
        pg8::gemm_phase<EpiIn, InOrder, PG8_ALIGN, PG8_SP2>(lds, g, S, E);
        if (tid == 0) {
            unsigned sp = 0;
            while (__hip_atomic_load(ctl + CW_ARRIVE, __ATOMIC_RELAXED, __HIP_MEMORY_SCOPE_AGENT) < (unsigned)G) { __builtin_amdgcn_s_sleep(2);
                if ((++sp & 255u) == 0u) { if (__hip_atomic_load(ctl + CW_TMO2, __ATOMIC_RELAXED, __HIP_MEMORY_SCOPE_AGENT)) break; if (sp > (1u << 20)) { __hip_atomic_store(ctl + CW_TMO2, 1u, __ATOMIC_RELAXED, __HIP_MEMORY_SCOPE_AGENT); break; } } }
            __builtin_amdgcn_fence(__ATOMIC_ACQUIRE, "agent"); VM_WAIT();
        }
        __syncthreads();
        if (P.sub & 1) {
            unsigned nextu = 0; if (tid == 0) nextu = __hip_atomic_fetch_add(ctl + CW_LQ, 1u, __ATOMIC_RELAXED, __HIP_MEMORY_SCOPE_AGENT);
            for (;;) {
                if (tid == 0) MISC[16] = nextu;
                __syncthreads();
                const int u = (int)MISC[16];
                if (u >= LRU1_IN_P2) break;
                if (tid == 0) nextu = __hip_atomic_fetch_add(ctl + CW_LQ, 1u, __ATOMIC_RELAXED, __HIP_MEMORY_SCOPE_AGENT);
                lru_unit<1>(P, lds, u, tid, wave, lane);
            }
        }
    }
    SEAM(2);
    if (IN(3)) {
        if (P.sub & 1) for (int u = LRU1_IN_P2 + (int)blockIdx.x; u < NB * 64 * 16; u += G) lru_unit<1>(P, lds, u, tid, wave, lane);
        VM_WAIT(); __syncthreads();
        if (tid == 0) { __builtin_amdgcn_fence(__ATOMIC_RELEASE, "agent"); VM_WAIT(); __hip_atomic_fetch_add(ctl + CW_ARRIVE + 768, 1u, __ATOMIC_RELAXED, __HIP_MEMORY_SCOPE_AGENT); }
        attn_phase(P, lds, tid, wave, lane);
        if (P.sub & 8) {
            constexpr int NWU = NB * 64 * 16 * 8; const int per = (NWU + G - 1) / G, w0 = (int)blockIdx.x * per, w1 = w0 + per < NWU ? w0 + per : NWU;
            for (;;) {
                int idx = 0; if (lane == 0) idx = (int)__hip_atomic_fetch_add((LAS unsigned*)(lds + MISC_OFF) + 17, 1u, __ATOMIC_RELAXED, __HIP_MEMORY_SCOPE_WORKGROUP);
                idx = __builtin_amdgcn_readfirstlane(idx);
                if (w0 + idx >= w1) break;
                lru_final_wave(P, w0 + idx, lane);
            }
        }
        __syncthreads();
        if (P.sub & 8) for (int u = NB * 64 * 16 + blockIdx.x; u < NB * 64 * 16 + SB * 16; u += G) lru_unit<2>(P, lds, u, tid, wave, lane);
    }
    SEAM(3);
    if (IN(4)) {
        constexpr int KO = F8_OUT ? D / 2 : D;
        pg8::Gemm g{(const bf16*)(ws + WS_MIX), (const bf16*)(ws + WS_WOUT), NTOK, D, KO}; SplitOrder S; S.init(KO, G, (int)blockIdx.x);
        EpiRes<false, true> E{P.in[I_XP], ws + WS_X1, mod + 2 * D, (float*)(ws + WS_SLAB), (P.sub >> 6) & 1, F8_OUT ? W8_INV : 1.0f};
        pg8::gemm_phase<EpiRes<false, true>, SplitOrder, PG8_ALIGN, PG8_SP2, 0, F8_OUT ? 1 : 0>(lds, g, S, E);
    }
    SEAM(4);
    if (IN(5)) {
        norm_sample_split<true, 2>(P, lds, P.in[I_XS], P.in[I_G2], mod, 3 * D, 4 * D, U, (const float*)(ws + WS_SLAB), (float*)(ws + WS_X1) + (size_t)NPR * D, wave, lane, (float*)(ws + WS_CTL + WS_SU));
        norm_rows<true, 2>((const float*)(ws + WS_X1), P.in[I_XS], P.in[I_G2], mod, 3 * D, 4 * D, U, nullptr, nullptr, NPR, gw, NGW, lane, (float*)(ws + WS_CTL + WS_SU));
    }
    SEAM(5);
    if (IN(6)) {
        pg8::Gemm g{U, (const bf16*)(ws + WS_WGU), NTOK, 2 * DFF, D / 2}; GluOrder S; S.init(D / 2, G, (int)blockIdx.x); S.mode = 1;
        EpiGlu<2> E{(bf16*)(ws + WS_H), 1.0f, (const float*)(ws + WS_CTL + WS_SU), (const float*)(ws + WS_CTL + WS_AMAX)};
        pg8::gemm_phase<EpiGlu<2>, GluOrder, PG8_ALIGN, PG8_SP2, 0, 2>(lds, g, S, E);
        VM_WAIT(); __syncthreads();
        if (tid == 0) { __builtin_amdgcn_fence(__ATOMIC_RELEASE, "agent"); VM_WAIT(); __hip_atomic_fetch_add(ctl + CW_ARRIVE + 256, 1u, __ATOMIC_RELAXED, __HIP_MEMORY_SCOPE_AGENT); }
        S.mode = 0;
        pg8::gemm_phase<EpiGlu<2>, GluOrder, PG8_ALIGN, PG8_SP2, 0, 2>(lds, g, S, E);
        if (tid == 0) {
            unsigned sp = 0;
            while (__hip_atomic_load(ctl + CW_ARRIVE + 256, __ATOMIC_RELAXED, __HIP_MEMORY_SCOPE_AGENT) < (unsigned)G) { __builtin_amdgcn_s_sleep(2);
                if ((++sp & 255u) == 0u) { if (__hip_atomic_load(ctl + CW_TMO2, __ATOMIC_RELAXED, __HIP_MEMORY_SCOPE_AGENT)) break; if (sp > (1u << 20)) { __hip_atomic_store(ctl + CW_TMO2, 1u, __ATOMIC_RELAXED, __HIP_MEMORY_SCOPE_AGENT); break; } } }
            __builtin_amdgcn_fence(__ATOMIC_ACQUIRE, "agent"); VM_WAIT();
        }
        __syncthreads();
        constexpr int KD = F8_DOWN ? DFF / 2 : DFF;
        pg8::Gemm g2{(const bf16*)(ws + WS_H), (const bf16*)(ws + WS_WD), NTOK, D, KD}; TailSplit S2; S2.init(KD, G, (int)blockIdx.x);
        EpiRes<true, false> E2{ws + WS_X1, P.out + O_Y, mod + 5 * D, (float*)(ws + WS_SLAB), 0, F8_DOWN ? W8_INV : 1.0f};
        pg8::gemm_phase<EpiRes<true, false>, TailSplit, PG8_ALIGN, PG8_SP2, 0, F8_DOWN ? 1 : 0>(lds, g2, S2, E2);
    }
    SEAM(6);
    if (IN(7)) {
        {
            const float* slab = (const float*)(ws + WS_SLAB); const float* x1s = (const float*)(ws + WS_X1) + (size_t)NPR * D; float* ys = P.out + O_Y + (size_t)NPR * D;
            for (int t = gw; t < NSA * 4; t += NGW) {
                const int r = t >> 2, col0 = 1024 * (t & 3);
                f32x4 v[4];
#pragma unroll
                for (int j = 0; j < 4; ++j) v[j] = *(const f32x4*)(x1s + (size_t)r * D + col0 + 4 * (lane + 64 * j));
#pragma unroll
                for (int q = 0; q < 8; ++q)
#pragma unroll
                    for (int j = 0; j < 4; ++j) v[j] += *(const f32x4*)(slab + ((size_t)q * NSA + r) * D + col0 + 4 * (lane + 64 * j));
#pragma unroll
                for (int j = 0; j < 4; ++j) *(f32x4*)(ys + (size_t)r * D + col0 + 4 * (lane + 64 * j)) = v[j];
            }
        }
        constexpr int KD = F8_DOWN ? DFF / 2 : DFF;
        pg8::Gemm g{(const bf16*)(ws + WS_H), (const bf16*)(ws + WS_WD), NTOK, D, KD}; pg8::StaticOrder S; S.init(NPR, D, KD, G, (int)blockIdx.x);
        EpiRes<true, false> E{ws + WS_X1, P.out + O_Y, mod + 5 * D, (float*)(ws + WS_SLAB), (P.sub >> 6) & 1, F8_DOWN ? W8_INV : 1.0f};
        pg8::gemm_phase<EpiRes<true, false>, pg8::StaticOrder, PG8_ALIGN, PG8_SP2, 0, F8_DOWN ? 1 : 0>(lds, g, S, E);
    }
#undef IN
#undef SEAM
}

extern "C" void kernel_launch(void* const* d_in, const int* in_sizes, int n_in, void* d_out, int out_size, void* d_ws, size_t ws_size, hipStream_t stream) {
    static int grid = 0;
    if (grid == 0) {
        if (n_in != 27 || in_sizes[0] != NPR * D || out_size != (int)O_END || ws_size < WS_END2) {
            fprintf(stderr, "kernel_launch: built for 27 inputs, x_prompt of %d floats, %zu outputs, >= %zu bytes of workspace; got n_in %d, in0 %d, out %d, ws %zu; nothing launched\n", NPR * D, (size_t)O_END, (size_t)WS_END2, n_in, n_in > 0 ? in_sizes[0] : -1, out_size, ws_size);
            grid = -1; return; }
        int dev = 0, cus = 0, per_cu = 0;
        if (hipGetDevice(&dev) != hipSuccess || hipDeviceGetAttribute(&cus, hipDeviceAttributeMultiprocessorCount, dev) != hipSuccess) { fprintf(stderr, "kernel_launch: device query failed\n"); grid = -1; return; }
        if (hipFuncSetAttribute((const void*)fwd, hipFuncAttributeMaxDynamicSharedMemorySize, LDS_BYTES) != hipSuccess) { fprintf(stderr, "kernel_launch: hipFuncSetAttribute failed\n"); grid = -1; return; }
        if (hipOccupancyMaxActiveBlocksPerMultiprocessor(&per_cu, (const void*)fwd, NWAVES * 64, LDS_BYTES) != hipSuccess || per_cu < 1)
            fprintf(stderr, "kernel_launch: note: occupancy query reports %d workgroups per CU\n", per_cu);
        (void)hipGetLastError();
        grid = cus;
    }
    if (grid < 0) return;
    if (hipMemsetAsync((char*)d_ws + WS_CTL, 0, CTL_ZERO_BYTES, stream) != hipSuccess) { fprintf(stderr, "kernel_launch: hipMemsetAsync failed\n"); return; }
    Params p{};
    for (int i = 0; i < 27; ++i) p.in[i] = (const float*)d_in[i];
    p.out = (float*)d_out; p.ws = (unsigned char*)d_ws; p.sub = 63;
#ifdef PROBE_PREFIX
    p.ph_lo = 0; p.ph_hi = PROBE_PREFIX;
#ifdef PROBE_SUB
    p.sub = PROBE_SUB;
#endif
    hipLaunchKernelGGL(fwd, dim3(grid), dim3(NWAVES * 64), LDS_BYTES, stream, p);
    (void)hipMemsetAsync((char*)d_ws + WS_CTL, 0, CTL_ZERO_BYTES, stream);
    p.sub = 63;
#endif
    for (int li = 0; li < MK_N_LAUNCHES; ++li) {
        p.ph_lo = (MK_N_LAUNCHES == 1) ? 0 : li; p.ph_hi = (MK_N_LAUNCHES == 1) ? N_PHASES : li + 1;
        hipLaunchKernelGGL(fwd, dim3(grid), dim3(NWAVES * 64), LDS_BYTES, stream, p);
        const hipError_t le = hipPeekAtLastError();
        if (le != hipSuccess) { fprintf(stderr, "kernel_launch: launch %d failed: %s\n", li, hipGetErrorName(le)); break; }
    }
#ifdef PROBE_PHASE
    p.ph_lo = PROBE_PHASE; p.ph_hi = PROBE_PHASE + 1;
#ifdef PROBE_SUB
    p.sub = PROBE_SUB;
#endif
    hipLaunchKernelGGL(fwd, dim3(grid), dim3(NWAVES * 64), LDS_BYTES, stream, p);
#endif
}
```

```cpp
#include <hip/hip_runtime.h>
#include <cstdio>
#include <cstdint>
namespace pg8 {
#define PG8_LAS __attribute__((address_space(3)))
typedef unsigned short bf16_t;
typedef short bf16x8 __attribute__((ext_vector_type(8)));
typedef float f32x4 __attribute__((ext_vector_type(4)));
typedef unsigned u32x4 __attribute__((ext_vector_type(4)));
typedef int i32x4 __attribute__((ext_vector_type(4)));
typedef int i32x8 __attribute__((ext_vector_type(8)));
constexpr int BM = 256, BK = 64, HALF = 128, HTB = HALF * BK * 2  , STAGE_BYTES = 8 * HTB, NXCD = 8, WGM = 8;

__host__ __device__ __forceinline__ int lds_byte(int r, int c) { const int st = (r >> 4) * 2 + (c >> 5), rr = r & 15, cc = c & 31, ob = rr * 64 + cc * 2; return st * 1024 + (ob ^ (((ob >> 9) & 1) << 5)); }
__host__ __device__ __forceinline__ void stage_rc(int b, int& R, int& C) { const int st = b / 1024, sb = b % 1024, swz = sb ^ (((sb >> 9) & 1) << 5); R = (st >> 1) * 16 + swz / 64; C = (st & 1) * 32 + (swz % 64) / 2; }
__host__ __device__ __forceinline__ int perm32(int rho) { const int n = rho >> 4, i = rho & 15; return 8 * (i >> 2) + 4 * n + (i & 3); }

struct Unit { int pm, pn, kb, nt, part; };
struct Gemm { const bf16_t* A; const bf16_t* Bt; int M, N, K; };

struct StaticOrder {
    int nM, nN, nwg, G, c, ntf;
    __host__ __device__ void init(int M, int N, int K, int G_, int c_) { nM = M / BM; nN = N / BM; nwg = nM * nN; G = G_; c = c_; ntf = K / BK; }
    __host__ __device__ bool next(int i, Unit& u) const {
        const long L = (long)i * G + c; if (L >= nwg) return false;
        int wgid = (int)L; { const int q = nwg / NXCD, r = nwg % NXCD, xcd = wgid % NXCD, off = wgid / NXCD; wgid = (xcd < r ? xcd * (q + 1) : r * (q + 1) + (xcd - r) * q) + off; }
        const int nig = WGM * nN, gid = wgid / nig, fm = gid * WGM, gsz = (nM - fm) < WGM ? (nM - fm) : WGM;
        u.pm = fm + ((wgid % nig) % gsz); u.pn = (wgid % nig) / gsz; u.kb = 0; u.nt = ntf; u.part = -1; return true;
    }
    __device__ __forceinline__ void a_ready(const Unit&) const {}
    __device__ __forceinline__ void done(const Unit&) const {}
};
__device__ __forceinline__ unsigned cvt_pk_bf16(float lo, float hi) { unsigned r; asm volatile("v_cvt_pk_bf16_f32 %0, %1, %2" : "=v"(r) : "v"(lo), "v"(hi)); return r; }
typedef float f32x2 __attribute__((ext_vector_type(2)));
#ifndef F8_DOWN
#define F8_DOWN true
#endif
constexpr float W8_SCALE = 512.f, W8_INV = 1.f / 512.f;
__device__ __forceinline__ unsigned pk4_fp8(float a, float b, float c, float d) {
    a = __builtin_amdgcn_fmed3f(a, -448.f, 448.f); b = __builtin_amdgcn_fmed3f(b, -448.f, 448.f); c = __builtin_amdgcn_fmed3f(c, -448.f, 448.f); d = __builtin_amdgcn_fmed3f(d, -448.f, 448.f);
    int w = __builtin_amdgcn_cvt_pk_fp8_f32(a, b, 0, false); w = __builtin_amdgcn_cvt_pk_fp8_f32(c, d, w, true); return (unsigned)w; }
__device__ __forceinline__ unsigned pk4_i8(float a, float b, float c, float d, float inv) {
    const unsigned ua = __builtin_bit_cast(unsigned, __builtin_fmaf(a, inv, 12582912.f)), ub = __builtin_bit_cast(unsigned, __builtin_fmaf(b, inv, 12582912.f)),
                   uc = __builtin_bit_cast(unsigned, __builtin_fmaf(c, inv, 12582912.f)), ud = __builtin_bit_cast(unsigned, __builtin_fmaf(d, inv, 12582912.f));
    return (ua & 0xffu) | ((ub & 0xffu) << 8) | ((uc & 0xffu) << 16) | (ud << 24); }
#ifndef PG8_KOUTER
#define PG8_KOUTER 1
#endif
template <class Epi, class Sched, bool ALIGN_EPI = false, bool SP2 = false, int VAR = 0, int QM = 0>
__device__ __forceinline__ void gemm_phase(PG8_LAS unsigned char* lds, const Gemm g, const Sched& S, const Epi& E) {
    const int tid = threadIdx.x, wid = __builtin_amdgcn_readfirstlane(tid >> 6), lane = tid & 63, wr = wid >> 2, wc = wid & 3, fr = lane & 15, fq = lane >> 4;
    const int K = g.K; int nt;
    unsigned voffA[2], voffB[2];
#pragma unroll
    for (int i = 0; i < 2; ++i) { int R, C; stage_rc(tid * 16 + i * 8192, R, C); const int Rb = Epi::PERM ? ((R & ~31) + perm32(R & 31)) : R;
        voffA[i] = (unsigned)(R * K + C) * 2u; voffB[i] = (unsigned)(Rb * K + C) * 2u; }
    const size_t kstep = (size_t)(BK * 2);
    const size_t hstep = (size_t)HALF * K * 2;
    const size_t tstep = 2 * hstep;
    const unsigned ldsw = (unsigned)wid * 1024u;
    const int aoff = lds_byte(wr * 64 + fr, fq * 8), boff = lds_byte(wc * 32 + fr, fq * 8);
#define PG8_SA(b, h) (((b) * 2 + (h)) * HTB)
#define PG8_SB(b, h) ((4 + (b) * 2 + (h)) * HTB)
#define PG8_STAGE(bufoff, gbase, voff) do { if constexpr (VAR != 3) { _Pragma("unroll") for (int _i = 0; _i < 2; ++_i) \
        __builtin_amdgcn_global_load_lds((const unsigned*)((const char*)(gbase) + (voff)[_i]), (PG8_LAS unsigned*)(lds + (bufoff) + ldsw + _i * 8192), 16, 0, 0); } } while (0)
#define PG8_LDA(dst, b, h) do { if constexpr (VAR != 2) _Pragma("unroll") for (int m = 0; m < 4; ++m) _Pragma("unroll") for (int k = 0; k < 2; ++k) dst[m][k] = *(const PG8_LAS bf16x8*)(lds + PG8_SA(b, h) + aoff + m * 2048 + k * 1024); } while (0)
#define PG8_LDB(dst, b, h) do { if constexpr (VAR != 2) _Pragma("unroll") for (int n = 0; n < 2; ++n) _Pragma("unroll") for (int k = 0; k < 2; ++k) dst[n][k] = *(const PG8_LAS bf16x8*)(lds + PG8_SB(b, h) + boff + n * 2048 + k * 1024); } while (0)
#define PG8_MMA(ai, bj, At, Bt) do { if constexpr (VAR != 5) __builtin_amdgcn_s_setprio(1); \
        if constexpr (QM == 2) { _Pragma("unroll") for (int k = 0; k < 2; ++k) _Pragma("unroll") for (int m = 0; m < 4; ++m) _Pragma("unroll") for (int n = 0; n < 2; ++n) \
            acc[ai][bj][m][n] = __builtin_bit_cast(f32x4, __builtin_amdgcn_mfma_i32_16x16x64_i8(__builtin_bit_cast(i32x4, Bt[n][k]), __builtin_bit_cast(i32x4, At[m][k]), __builtin_bit_cast(i32x4, acc[ai][bj][m][n]), 0, 0, 0)); } \
        else if constexpr (QM == 1) { _Pragma("unroll") for (int m = 0; m < 4; ++m) _Pragma("unroll") for (int n = 0; n < 2; ++n) \
            asm volatile("v_mfma_f32_16x16x128_f8f6f4 %0, %1, %2, %0" : "+v"(acc[ai][bj][m][n]) : "v"(__builtin_shufflevector(__builtin_bit_cast(i32x4, Bt[n][0]), __builtin_bit_cast(i32x4, Bt[n][1]), 0, 1, 2, 3, 4, 5, 6, 7)), \
                "v"(__builtin_shufflevector(__builtin_bit_cast(i32x4, At[m][0]), __builtin_bit_cast(i32x4, At[m][1]), 0, 1, 2, 3, 4, 5, 6, 7))); } \
        else if constexpr (VAR == 4 || (VAR == 0 && PG8_KOUTER)) { _Pragma("unroll") for (int k = 0; k < 2; ++k) _Pragma("unroll") for (int m = 0; m < 4; ++m) _Pragma("unroll") for (int n = 0; n < 2; ++n) \
            acc[ai][bj][m][n] = __builtin_amdgcn_mfma_f32_16x16x32_bf16(Bt[n][k], At[m][k], acc[ai][bj][m][n], 0, 0, 0); } \
        else { _Pragma("unroll") for (int m = 0; m < 4; ++m) _Pragma("unroll") for (int n = 0; n < 2; ++n) _Pragma("unroll") for (int k = 0; k < (VAR == 1 ? 1 : 2); ++k) \
            acc[ai][bj][m][n] = __builtin_amdgcn_mfma_f32_16x16x32_bf16(Bt[n][k], At[m][k], acc[ai][bj][m][n], 0, 0, 0); } \
        if constexpr (VAR != 5) __builtin_amdgcn_s_setprio(0); } while (0)
#define PG8_WAIT_V(n) asm volatile("s_waitcnt vmcnt(" #n ")" ::: "memory")
#define PG8_WAIT_L(n) asm volatile("s_waitcnt lgkmcnt(" #n ")" ::: "memory")
#define PG8_BAR __builtin_amdgcn_s_barrier()
#define PG8_SCHED __builtin_amdgcn_sched_barrier(0)
    Unit cur, nxt; int ui = 0;
    if (!S.next(0, cur)) return;
    nt = cur.nt;
    f32x4 acc[2][2][4][2];
#pragma unroll
    for (int a = 0; a < 2; ++a)
#pragma unroll
        for (int b = 0; b < 2; ++b)
#pragma unroll
            for (int m = 0; m < 4; ++m)
#pragma unroll
                for (int n = 0; n < 2; ++n) acc[a][b][m][n] = (f32x4){0.f, 0.f, 0.f, 0.f};
    bf16x8 At[4][2], B0[2][2], B1[2][2];
    const char* cA = (const char*)g.A + (size_t)cur.pm * tstep + (size_t)cur.kb * kstep; const char* cB = (const char*)g.Bt + (size_t)cur.pn * tstep + (size_t)cur.kb * kstep;
    S.a_ready(cur);
    if constexpr (SP2) {
        PG8_STAGE(PG8_SB(0, 0), cB, voffB); PG8_STAGE(PG8_SB(0, 1), cB + hstep, voffB); PG8_STAGE(PG8_SA(0, 0), cA, voffA); PG8_STAGE(PG8_SA(0, 1), cA + hstep, voffA);
        if (wr == 1) PG8_BAR;
        PG8_WAIT_V(2); PG8_BAR;
        PG8_STAGE(PG8_SB(1, 0), cB + kstep, voffB); PG8_STAGE(PG8_SA(1, 0), cA + kstep, voffA); PG8_STAGE(PG8_SB(1, 1), cB + hstep + kstep, voffB);
        PG8_WAIT_V(6); PG8_BAR;
    } else {
        PG8_STAGE(PG8_SB(0, 0), cB, voffB); PG8_STAGE(PG8_SA(0, 0), cA, voffA); PG8_STAGE(PG8_SB(0, 1), cB + hstep, voffB); PG8_STAGE(PG8_SA(0, 1), cA + hstep, voffA);
        if (wr == 1) PG8_BAR;
        PG8_WAIT_V(4); PG8_BAR;
        PG8_STAGE(PG8_SB(1, 0), cB + kstep, voffB); PG8_STAGE(PG8_SA(1, 0), cA + kstep, voffA); PG8_STAGE(PG8_SB(1, 1), cB + hstep + kstep, voffB);
        PG8_WAIT_V(6); PG8_BAR;
    }
    for (;;) {
        const bool has_next = S.next(ui + 1, nxt);
        const char* nA = has_next ? (const char*)g.A + (size_t)nxt.pm * tstep + (size_t)nxt.kb * kstep : cA; const char* nB = has_next ? (const char*)g.Bt + (size_t)nxt.pn * tstep + (size_t)nxt.kb * kstep : cB;
        for (int t = 0; t < nt; t += 2) {
            const bool last = (t == nt - 2);
            const char* a1 = cA + (size_t)(t + 1) * kstep;
            const char* a2 = last ? nA : cA + (size_t)(t + 2) * kstep; const char* b2 = last ? nB : cB + (size_t)(t + 2) * kstep;
            const char* a3 = a2 + kstep; const char* b3 = b2 + kstep;
            if (last && has_next) S.a_ready(nxt);
            if constexpr (SP2) {
            PG8_LDB(B0, 0, 0); PG8_LDB(B1, 0, 1); PG8_SCHED; PG8_LDA(At, 0, 0); PG8_STAGE(PG8_SA(1, 1), a1 + hstep, voffA);
            PG8_WAIT_V(8); PG8_WAIT_L(0); PG8_BAR; PG8_MMA(0, 0, At, B0); PG8_MMA(0, 1, At, B1); PG8_BAR; PG8_SCHED;
            PG8_LDA(At, 0, 1); PG8_STAGE(PG8_SB(0, 0), b2, voffB); PG8_STAGE(PG8_SB(0, 1), b2 + hstep, voffB); PG8_STAGE(PG8_SA(0, 0), a2, voffA);
            PG8_WAIT_V(8); PG8_WAIT_L(0); PG8_BAR; PG8_MMA(1, 0, At, B0); PG8_MMA(1, 1, At, B1); PG8_BAR; PG8_SCHED;
            PG8_LDB(B0, 1, 0); PG8_LDB(B1, 1, 1); PG8_SCHED; PG8_LDA(At, 1, 0); PG8_STAGE(PG8_SA(0, 1), a2 + hstep, voffA);
            PG8_WAIT_V(8); PG8_WAIT_L(0); PG8_BAR; PG8_MMA(0, 0, At, B0); PG8_MMA(0, 1, At, B1); PG8_BAR; PG8_SCHED;
            PG8_LDA(At, 1, 1); PG8_STAGE(PG8_SB(1, 0), b3, voffB); PG8_STAGE(PG8_SB(1, 1), b3 + hstep, voffB); PG8_STAGE(PG8_SA(1, 0), a3, voffA);
            PG8_WAIT_V(8); PG8_WAIT_L(0); PG8_BAR; PG8_MMA(1, 0, At, B0); PG8_MMA(1, 1, At, B1); PG8_BAR; PG8_SCHED;
            } else {
            PG8_LDB(B0, 0, 0); PG8_SCHED; PG8_LDA(At, 0, 0); PG8_STAGE(PG8_SA(1, 1), a1 + hstep, voffA);
            PG8_WAIT_L(8); PG8_BAR; PG8_WAIT_L(0); PG8_MMA(0, 0, At, B0); PG8_BAR; PG8_SCHED;
            PG8_LDB(B1, 0, 1); PG8_STAGE(PG8_SB(0, 0), b2, voffB);
            PG8_BAR; PG8_WAIT_L(0); PG8_MMA(0, 1, At, B1); PG8_BAR;
            PG8_LDA(At, 0, 1); PG8_STAGE(PG8_SA(0, 0), a2, voffA);
            PG8_BAR; PG8_WAIT_L(0); PG8_MMA(1, 0, At, B0); PG8_BAR; PG8_SCHED;
            PG8_STAGE(PG8_SB(0, 1), b2 + hstep, voffB);
            PG8_WAIT_V(6); PG8_BAR; PG8_MMA(1, 1, At, B1); PG8_BAR;
            PG8_LDB(B0, 1, 0); PG8_SCHED; PG8_LDA(At, 1, 0); PG8_STAGE(PG8_SA(0, 1), a2 + hstep, voffA);
            PG8_WAIT_L(8); PG8_BAR; PG8_WAIT_L(0); PG8_MMA(0, 0, At, B0); PG8_BAR; PG8_SCHED;
            PG8_LDB(B1, 1, 1); PG8_STAGE(PG8_SB(1, 0), b3, voffB);
            PG8_BAR; PG8_WAIT_L(0); PG8_MMA(0, 1, At, B1); PG8_BAR;
            PG8_LDA(At, 1, 1); PG8_STAGE(PG8_SA(1, 0), a3, voffA);
            PG8_BAR; PG8_WAIT_L(0); PG8_MMA(1, 0, At, B0); PG8_BAR; PG8_SCHED;
            PG8_STAGE(PG8_SB(1, 1), b3 + hstep, voffB);
            PG8_WAIT_V(6); PG8_BAR; PG8_MMA(1, 1, At, B1); PG8_BAR;
            }
        }
        if constexpr (ALIGN_EPI) { if (wr == 0) PG8_BAR; }
        if constexpr (QM == 1) { PG8_SCHED; asm volatile("s_nop 15\n\ts_nop 7" ::: "memory"); PG8_SCHED; }
        if constexpr (!Epi::AFTER_DRAIN) { E(acc, cur, wr, wc, fr, fq); S.done(cur); }
        if (!has_next) break;
#pragma unroll
        for (int a = 0; a < 2; ++a)
#pragma unroll
            for (int b = 0; b < 2; ++b)
#pragma unroll
                for (int m = 0; m < 4; ++m)
#pragma unroll
                    for (int n = 0; n < 2; ++n) acc[a][b][m][n] = (f32x4){0.f, 0.f, 0.f, 0.f};
        cur = nxt; cA = nA; cB = nB; ++ui; nt = cur.nt;
        if constexpr (ALIGN_EPI) { if (wr == 1) PG8_BAR; }
    }
    PG8_WAIT_V(0);
    if constexpr (!ALIGN_EPI) { if (wr == 0) PG8_BAR; }
    PG8_BAR;
    if constexpr (Epi::AFTER_DRAIN) { E.fused(acc, cur, wr, wc, fr, fq, lds, wid, lane); S.done(cur); }
#undef PG8_SA
#undef PG8_SB
#undef PG8_STAGE
#undef PG8_LDA
#undef PG8_LDB
#undef PG8_MMA
#undef PG8_WAIT_V
#undef PG8_WAIT_L
#undef PG8_BAR
#undef PG8_SCHED
}
}
constexpr int D = 4096, T = 4096, NB = 2, NPR = NB * T, SB = 16, ST = 32, NSA = SB * ST, NTOK = NPR + NSA;
constexpr int NSEQ = NB + SB, AW = 2048, LW = 2048, HD = 128, NH = 16, DFF = 11008, INC = 10240, NMOD = 6 * D;
constexpr int CROWS = 512, KS_LD = 544;
constexpr float RMS_EPS = 1e-6f;
constexpr float QSCALE = 0.08838834764831845f * 1.4426950408889634f;
constexpr float LOG2E = 1.4426950408889634f;
constexpr size_t O_Y = 0, O_KP = (size_t)NTOK * D, O_VP = O_KP + (size_t)NB * 512 * AW, O_CP = O_VP + (size_t)NB * 512 * AW, O_HP = O_CP + (size_t)NB * 3 * LW,
                 O_KS = O_HP + (size_t)NB * LW, O_VS = O_KS + (size_t)NSA * AW, O_CS = O_VS + (size_t)NSA * AW, O_HS = O_CS + (size_t)SB * 3 * LW, O_END = O_HS + (size_t)SB * LW;
static_assert(O_END == 42090496, "output size");
constexpr size_t MiB = 1u << 20;
constexpr size_t WS_CTL = 0, CTL_ZERO_BYTES = 163840, WS_AMAX = 32768  ,
                 WS_AMAX1 = 122880  , WS_SU = 163840  , WS_SU1 = 262144  ;
constexpr size_t WS_MOD = 1 * MiB, WS_LSUM = 3 * MiB, WS_WRG = 5 * MiB, WS_WIN = 6 * MiB, WS_WOUT = 86 * MiB, WS_WGU = 118 * MiB, WS_WD = 290 * MiB, WS_U = 376 * MiB,
                 WS_Q = 444 * MiB, WS_K = 478 * MiB, WS_KC = 512 * MiB, WS_VTP = 544 * MiB, WS_VTS = 576 * MiB, WS_XR = 610 * MiB, WS_GG = 678 * MiB, WS_MIX = 712 * MiB,
                 WS_X1 = 780 * MiB, WS_H = 916 * MiB, WS_END = 1099 * MiB;
static_assert(WS_H + (size_t)NTOK * DFF * 2 <= WS_END && WS_X1 + (size_t)NTOK * D * 4 <= WS_H && WS_WGU + (size_t)2 * DFF * D * 2 <= WS_WD && WS_WD + (size_t)D * DFF * 2 <= WS_U, "d_ws map");
constexpr size_t WS_AB = WS_END;
constexpr size_t WS_END2 = WS_END + 128 * MiB;
constexpr size_t WS_WIN8 = WS_H + 96 * MiB, WS_U8 = WS_H + 140 * MiB;
static_assert(WS_H + (size_t)NTOK * DFF <= WS_WIN8 && WS_WIN8 + (size_t)INC * D <= WS_U8 && WS_U8 + (size_t)NTOK * D <= WS_END, "int8 images");
constexpr size_t WS_SLAB = WS_Q;
static_assert(WS_SLAB + (size_t)8 * NSA * D * 4 <= WS_KC, "slab overlay");
static_assert((4096 + 3456) * 4 <= 32768, "control words inside the zeroed region");
constexpr int CW_BAR = 4096, CW_ARRIVE = 64, CW_LQ = 128, CW_TMO2 = 192;
constexpr int RING_BYTES = 131072;
constexpr int XCH_OFF = RING_BYTES;
constexpr int MISC_OFF = XCH_OFF + 8192;
constexpr int LDS_BYTES = 147456;

#define LAS __attribute__((address_space(3)))
typedef unsigned short bf16;
typedef float f32x4 __attribute__((ext_vector_type(4)));
typedef float f32x2 __attribute__((ext_vector_type(2)));
typedef short bf16x8 __attribute__((ext_vector_type(8)));
typedef unsigned u32x4 __attribute__((ext_vector_type(4)));
typedef unsigned u32x2 __attribute__((ext_vector_type(2)));
using pg8::cvt_pk_bf16; using pg8::pk4_fp8; using pg8::pk4_i8; using pg8::W8_SCALE; using pg8::W8_INV;
#define LDS_WAIT() asm volatile("s_waitcnt lgkmcnt(0)" ::: "memory")
#define VM_WAIT() asm volatile("s_waitcnt vmcnt(0)" ::: "memory")

__device__ __forceinline__ float fast_sigmoid(float x) { return __builtin_amdgcn_rcpf(1.0f + __builtin_amdgcn_exp2f(-LOG2E * x)); }
__device__ __forceinline__ float gelu_tanh(float x) { return x * __builtin_amdgcn_rcpf(1.0f + __builtin_amdgcn_exp2f(-2.302208198f * (x + 0.044715f * x * x * x))); }

__device__ __forceinline__ float xrow16_max(float x) {
    auto s = __builtin_amdgcn_permlane16_swap(__float_as_uint(x), __float_as_uint(x), false, false); x = fmaxf(__uint_as_float(s[0]), __uint_as_float(s[1]));
    auto t = __builtin_amdgcn_permlane32_swap(__float_as_uint(x), __float_as_uint(x), false, false); return fmaxf(__uint_as_float(t[0]), __uint_as_float(t[1]));
}
__device__ __forceinline__ float xrow16_sum(float x) {
    auto s = __builtin_amdgcn_permlane16_swap(__float_as_uint(x), __float_as_uint(x), false, false); x = __uint_as_float(s[0]) + __uint_as_float(s[1]);
    auto t = __builtin_amdgcn_permlane32_swap(__float_as_uint(x), __float_as_uint(x), false, false); return __uint_as_float(t[0]) + __uint_as_float(t[1]);
}
template <int QM> struct EpiIn {
    static constexpr bool PERM = true, AFTER_DRAIN = false;
    bf16* Q; bf16* K; bf16* VtP; bf16* VtS; float* XR; bf16* GG; float* out; const float* qg; const float* kg; LAS float* xch; const float* su; const float* sw;
    __device__ __forceinline__ void operator()(const f32x4 (&acc)[2][2][4][2], const pg8::Unit& u, int wr, int wc, int fr, int fq) const {
        asm volatile("" : "+v"(fr), "+v"(fq));
        if (QM == 2) {
            f32x4 (&A)[2][2][4][2] = const_cast<f32x4 (&)[2][2][4][2]>(acc);
            const float* p = sw + u.pn * 256 + wc * 32 + 8 * fq; f32x4 cs[2][2];
#pragma unroll
            for (int bj = 0; bj < 2; ++bj)
#pragma unroll
                for (int n = 0; n < 2; ++n) cs[bj][n] = *(const f32x4*)(p + 128 * bj + 4 * n) * (1.f / 127.f);
#pragma unroll
            for (int ai = 0; ai < 2; ++ai)
#pragma unroll
                for (int m = 0; m < 4; ++m) { const float r = su[(size_t)u.pm * 256 + ai * 128 + wr * 64 + m * 16 + fr];
#pragma unroll
                    for (int bj = 0; bj < 2; ++bj)
#pragma unroll
                        for (int n = 0; n < 2; ++n)
#pragma unroll
                            for (int j = 0; j < 4; ++j) { const float x = A[ai][bj][m][n][j]; A[ai][bj][m][n][j] = (float)__builtin_bit_cast(int, x) * (r * cs[bj][n][j]); } }
        }
        const int region = u.pn >> 3, pl = u.pn & 7;
        const int rl0 = wr * 64 + fr, cl0 = wc * 32 + 8 * fq;
        const bool prompt = u.pm < 32;
        const int pb = u.pm >> 4, pt0 = (u.pm & 15) * 256, s0 = (u.pm - 32) * 256;
#ifndef RMASK
#define RMASK 31
#endif
        if ((RMASK & 3) && region < 2) {
#pragma unroll
            for (int ai = 0; ai < 2; ++ai)
#pragma unroll
                for (int m = 0; m < 4; ++m)
#pragma unroll
                    for (int bj = 0; bj < 2; ++bj) {
                        const f32x4 a = acc[ai][bj][m][0], b = acc[ai][bj][m][1];
                        float s = (a[0] * a[0] + a[1] * a[1]) + (a[2] * a[2] + a[3] * a[3]) + (b[0] * b[0] + b[1] * b[1]) + (b[2] * b[2] + b[3] * b[3]);
                        s = xrow16_sum(s);
                        if (fq == 0) xch[((ai * 128 + m * 16 + rl0) * 2 + bj) * 4 + wc] = s;
                    }
            asm volatile("s_waitcnt lgkmcnt(0)" ::: "memory"); __builtin_amdgcn_s_barrier(); asm volatile("" ::: "memory");
            const float* gp = (region == 0 ? qg : kg) + cl0;
            const float osc = region == 0 ? QSCALE : 1.0f;
            const f32x4 g0 = *(const f32x4*)gp * osc, g1 = *(const f32x4*)(gp + 4) * osc;
            bf16* dst = region == 0 ? Q : K;
            const bool newk = (region == 1) && (!prompt || (u.pm & 15) >= 14);
            float* ok = prompt ? out + O_KP + (size_t)(pb * 512 + pt0 - 3584) * AW : out + O_KS + (size_t)s0 * AW;
#pragma unroll
            for (int ai = 0; ai < 2; ++ai)
#pragma unroll
                for (int m = 0; m < 4; ++m) {
                    const int rl = ai * 128 + m * 16 + rl0; const size_t mrow = (size_t)u.pm * 256 + rl;
#pragma unroll
                    for (int bj = 0; bj < 2; ++bj) {
                        const f32x4 p = *(const LAS f32x4*)&xch[(rl * 2 + bj) * 4];
                        const float rs = __builtin_amdgcn_rsqf(((p[0] + p[1]) + (p[2] + p[3])) * (1.0f / 128.0f) + RMS_EPS);
                        const f32x4 v0 = acc[ai][bj][m][0] * rs * g0, v1 = acc[ai][bj][m][1] * rs * g1;
                        const int col = (pl * 2 + bj) * 128 + cl0;
                        u32x4 w; w.x = cvt_pk_bf16(v0[0], v0[1]); w.y = cvt_pk_bf16(v0[2], v0[3]); w.z = cvt_pk_bf16(v1[0], v1[1]); w.w = cvt_pk_bf16(v1[2], v1[3]);
                        const size_t hidx = prompt ? ((size_t)(pb * NH + pl * 2 + bj) * T + pt0 + rl) * HD + cl0 : (size_t)NPR * AW + ((size_t)(((s0 + rl) >> 5) * NH + pl * 2 + bj) * ST + ((s0 + rl) & 31)) * HD + cl0;
                        *(u32x4*)(dst + hidx) = w;
                        if (newk) { float* o = ok + (size_t)rl * AW + col; *(f32x4*)o = v0; *(f32x4*)(o + 4) = v1; }
                    }
                    asm volatile("" ::: "memory");
                }
        } else if ((RMASK & 4) && region == 2) {
            const bool newv = !prompt || (u.pm & 15) >= 14;
            float* ov = prompt ? out + O_VP + (size_t)(pb * 512 + pt0 - 3584) * AW : out + O_VS + (size_t)s0 * AW;
#pragma unroll
            for (int bj = 0; bj < 2; ++bj) {
                const int h = pl * 2 + bj;
#pragma unroll
                for (int n = 0; n < 2; ++n)
#pragma unroll
                    for (int j = 0; j < 4; j += 2) {
                        const int d = cl0 + 4 * n + j;
                        if (prompt) {
                            bf16* p0 = VtP + (((size_t)(pb * NH + h) * (T / 32) + (pt0 >> 5)) * HD + d) * 32 + (rl0 & 31) + (size_t)(rl0 >> 5) * (HD * 32);
#pragma unroll
                            for (int ai = 0; ai < 2; ++ai)
#pragma unroll
                                for (int m = 0; m < 4; ++m) { const unsigned w = cvt_pk_bf16(acc[ai][bj][m][n][j], acc[ai][bj][m][n][j + 1]); bf16* q0 = p0 + (ai * 4 + (m >> 1)) * (HD * 32) + (m & 1) * 16; q0[0] = (bf16)(w & 0xffffu); q0[32] = (bf16)(w >> 16); }
                        } else {
#pragma unroll
                            for (int ai = 0; ai < 2; ++ai)
#pragma unroll
                                for (int m = 0; m < 4; ++m) { const int s = s0 + ai * 128 + m * 16 + rl0; bf16* q0 = VtS + (((size_t)((s >> 5) * NH + h) * (KS_LD / 32) + CROWS / 32) * HD + d) * 32 + (s & 31);
                                    const unsigned w = cvt_pk_bf16(acc[ai][bj][m][n][j], acc[ai][bj][m][n][j + 1]); q0[0] = (bf16)(w & 0xffffu); q0[32] = (bf16)(w >> 16); }
                        }
                    }
            }
            if (newv) {
#pragma unroll
                for (int ai = 0; ai < 2; ++ai)
#pragma unroll
                    for (int m = 0; m < 4; ++m) { const int rl = ai * 128 + m * 16 + rl0;
#pragma unroll
                        for (int bj = 0; bj < 2; ++bj) { float* o = ov + (size_t)rl * AW + (pl * 2 + bj) * 128 + cl0; *(f32x4*)o = acc[ai][bj][m][0]; *(f32x4*)(o + 4) = acc[ai][bj][m][1]; } }
            }
        } else if ((RMASK & 8) && region == 3) {
#pragma unroll
            for (int ai = 0; ai < 2; ++ai)
#pragma unroll
                for (int m = 0; m < 4; ++m) { const int rl = ai * 128 + m * 16 + rl0; const size_t mrow = (size_t)u.pm * 256 + rl;
                    int ci = -1; float* oc = out;
                    if (prompt) { if ((u.pm & 15) == 15 && rl >= 253) { ci = rl - 253; oc = out + O_CP + (size_t)(pb * 3 + ci) * LW; } }
                    else { const int s = s0 + rl; if ((s & 31) >= 29) { ci = (s & 31) - 29; oc = out + O_CS + (size_t)((s >> 5) * 3 + ci) * LW; } }
#pragma unroll
                    for (int bj = 0; bj < 2; ++bj) { const int col = pl * 256 + bj * 128 + cl0; float* o = XR + mrow * LW + col; *(f32x4*)o = acc[ai][bj][m][0]; *(f32x4*)(o + 4) = acc[ai][bj][m][1];
                        if (ci >= 0) { *(f32x4*)(oc + col) = acc[ai][bj][m][0]; *(f32x4*)(oc + col + 4) = acc[ai][bj][m][1]; } } }
        } else if (RMASK & 16) {
#pragma unroll
            for (int ai = 0; ai < 2; ++ai)
#pragma unroll
                for (int m = 0; m < 4; ++m) { const size_t mrow = (size_t)u.pm * 256 + ai * 128 + m * 16 + rl0;
#pragma unroll
                    for (int bj = 0; bj < 2; ++bj) { const f32x4 a = acc[ai][bj][m][0], b = acc[ai][bj][m][1];
                        u32x4 w; w.x = cvt_pk_bf16(a[0], a[1]); w.y = cvt_pk_bf16(a[2], a[3]); w.z = cvt_pk_bf16(b[0], b[1]); w.w = cvt_pk_bf16(b[2], b[3]);
                        *(u32x4*)(GG + mrow * LW + pl * 256 + bj * 128 + cl0) = w; } }
        }
    }
};
struct SplitOrder {
    pg8::StaticOrder full; int G, c, np;
    __device__ __forceinline__ void init(int K, int G_, int c_) { full.init(NPR, D, K, G_, c_); G = G_; c = c_; np = K / 128; }
    __device__ __forceinline__ bool next(int i, pg8::Unit& u) const {
        const int L = i * G + c;
        if (L < full.nwg) return full.next(i, u);
        const int j = L - full.nwg; if (j >= 256) return false;
        const int tile = j >> 3, part = j & 7, base = np >> 3, rem = np & 7;
        u.pm = 32 + (tile >> 4); u.pn = tile & 15; u.kb = 2 * (part * base + (part < rem ? part : rem)); u.nt = 2 * (base + (part < rem ? 1 : 0)); u.part = part; return true;
    }
    __device__ __forceinline__ void a_ready(const pg8::Unit&) const {}
    __device__ __forceinline__ void done(const pg8::Unit&) const {}
};
struct XrOrder {
    int G, c;
    __device__ __forceinline__ void init(int G_, int c_) { G = G_; c = c_; }
    __device__ __forceinline__ bool next(int i, pg8::Unit& u) const {
        const int L = i * G + c; if (L >= 256) return false;
        const int wg = (L & 7) * 32 + (L >> 3); u.pm = wg >> 3; u.pn = 24 + (wg & 7); u.kb = 0; u.nt = D / 64; u.part = -1; return true;
    }
    __device__ __forceinline__ void a_ready(const pg8::Unit&) const {}
    __device__ __forceinline__ void done(const pg8::Unit&) const {}
};
struct B2Order {
    int G, c;
    __device__ __forceinline__ void init(int G_, int c_) { G = G_; c = c_; }
    __device__ __forceinline__ bool next(int i, pg8::Unit& u) const {
        const int L = i * G + c; if (L >= 112) return false;
        const int idx = (L & 7) * 14 + (L >> 3);
        if (idx < 64) { u.pm = 14 + ((idx >> 4) & 1) + 16 * (idx >> 5); u.pn = 8 + (idx & 15); }
        else { const int j = idx - 64; u.pm = 32 + j / 24; u.pn = 8 + j % 24; }
        u.kb = 0; u.nt = D / 64; u.part = -1; return true;
    }
    __device__ __forceinline__ void a_ready(const pg8::Unit&) const {}
    __device__ __forceinline__ void done(const pg8::Unit&) const {}
};
struct I8Order {
    int G, c;
    __device__ __forceinline__ void init(int G_, int c_) { G = G_; c = c_; }
    __device__ __forceinline__ bool next(int i, pg8::Unit& u) const {
        const int L = i * G + c; if (L >= 992) return false;
        const int t = (L & 7) * 124 + (L >> 3);
        if (t < 896) { const int pi = t >> 5, ct = t & 31; u.pm = pi < 14 ? pi : pi + 2; u.pn = ct < 24 ? ct : ct + 8; }
        else { const int s = t - 896, pi = s >> 4, ct = s & 15; u.pm = pi < 2 ? 14 + pi : 28 + pi; u.pn = ct < 8 ? ct : ct + 24; }
        u.kb = 0; u.nt = D / 128; u.part = -1; return true;
    }
    __device__ __forceinline__ void a_ready(const pg8::Unit&) const {}
    __device__ __forceinline__ void done(const pg8::Unit&) const {}
};
struct GluOrder {
    pg8::StaticOrder full; int G, c, mode;
    __device__ __forceinline__ void init(int K, int G_, int c_) { full.init(NPR, 2 * DFF, K, G_, c_); G = G_; c = c_; mode = 0; }
    __device__ __forceinline__ bool next(int i, pg8::Unit& u) const {
        if (mode == 0) return full.next(i, u);
        const int cc = (G == 256) ? ((c + 256 - 84) & 255) : c, L = i * G + cc; if (L >= 2 * (2 * DFF / 256)) return false;
        u.pm = 32 + L / (2 * DFF / 256); u.pn = L % (2 * DFF / 256); u.kb = 0; u.nt = full.ntf; u.part = -1; return true;
    }
    __device__ __forceinline__ void a_ready(const pg8::Unit&) const {}
    __device__ __forceinline__ void done(const pg8::Unit&) const {}
};
struct TailSplit {
    int rank, nrank, np;
    __device__ __forceinline__ void init(int K, int G, int c) { np = K / 128; if (G == 256) { rank = c < 84 ? c : (c >= 192 ? 84 + (c - 192) : -1); nrank = 148; } else { rank = c; nrank = G; } }
    __device__ __forceinline__ bool next(int i, pg8::Unit& u) const {
        if (rank < 0) return false;
        const int j = rank + i * nrank; if (j >= 256) return false;
        const int tile = j >> 3, part = j & 7, base = np >> 3, rem = np & 7;
        u.pm = 32 + (tile >> 4); u.pn = tile & 15; u.kb = 2 * (part * base + (part < rem ? part : rem)); u.nt = 2 * (base + (part < rem ? 1 : 0)); u.part = part; return true;
    }
    __device__ __forceinline__ void a_ready(const pg8::Unit&) const {}
    __device__ __forceinline__ void done(const pg8::Unit&) const {}
};
template <bool BASE_BF16, bool OUT_BF16> struct EpiRes {
    static constexpr bool PERM = false, AFTER_DRAIN = false;
    const void* base; void* outp; const float* gate; float* slab; int probe_skip; float wsc;
    __device__ __forceinline__ void operator()(const f32x4 (&acc)[2][2][4][2], const pg8::Unit& u, int wr, int wc, int fr, int fq) const {
        asm volatile("" : "+v"(fr), "+v"(fq));
        const int col0 = u.pn * 256 + wc * 32 + 4 * fq;
        if (probe_skip) return;
        if (u.part < 0) {
            const float* gp = gate + (size_t)(u.pm >> 4) * NMOD + col0;
            f32x4 gv[2][2];
#pragma unroll
            for (int bj = 0; bj < 2; ++bj)
#pragma unroll
                for (int n = 0; n < 2; ++n) gv[bj][n] = *(const f32x4*)(gp + bj * 128 + n * 16) * wsc;
#pragma unroll
            for (int ai = 0; ai < 2; ++ai) {
                const size_t row0 = (size_t)u.pm * 256 + ai * 128 + wr * 64 + fr;
                f32x4 bs[4][2][2]; u32x2 bw[4][2][2];
#pragma unroll
                for (int m = 0; m < 4; ++m)
#pragma unroll
                    for (int bj = 0; bj < 2; ++bj)
#pragma unroll
                        for (int n = 0; n < 2; ++n) { const size_t off = (row0 + m * 16) * D + col0 + bj * 128 + n * 16;
                            if (BASE_BF16) bw[m][bj][n] = *(const u32x2*)((const bf16*)base + off); else bs[m][bj][n] = *(const f32x4*)((const float*)base + off); }
#pragma unroll
                for (int m = 0; m < 4; ++m)
#pragma unroll
                    for (int bj = 0; bj < 2; ++bj)
#pragma unroll
                        for (int n = 0; n < 2; ++n) { const size_t off = (row0 + m * 16) * D + col0 + bj * 128 + n * 16;
                            f32x4 bsv;
                            if (BASE_BF16) { const u32x2 w = bw[m][bj][n]; bsv = (f32x4){__uint_as_float(w.x << 16), __uint_as_float(w.x & 0xffff0000u), __uint_as_float(w.y << 16), __uint_as_float(w.y & 0xffff0000u)}; }
                            else bsv = bs[m][bj][n];
                            const f32x4 o = bsv + gv[bj][n] * acc[ai][bj][m][n];
                            if (OUT_BF16) { u32x2 w; w.x = cvt_pk_bf16(o[0], o[1]); w.y = cvt_pk_bf16(o[2], o[3]); *(u32x2*)((bf16*)outp + off) = w; }
                            else __builtin_nontemporal_store(o, (f32x4*)((float*)outp + off)); }
                asm volatile("" ::: "memory");
            }
        } else {
#pragma unroll
            for (int ai = 0; ai < 2; ++ai)
#pragma unroll
                for (int m = 0; m < 4; ++m) {
                    const int rl = ai * 128 + wr * 64 + m * 16 + fr; const size_t mrow = (size_t)u.pm * 256 + rl;
                    const int seq = NB + (((u.pm - 32) * 256 + rl) >> 5);
                    const float* gp = gate + (size_t)seq * NMOD;
#pragma unroll
                    for (int bj = 0; bj < 2; ++bj)
#pragma unroll
                        for (int n = 0; n < 2; ++n) { const int c = col0 + bj * 128 + n * 16; *(f32x4*)(slab + ((size_t)u.part * NSA + (mrow - NPR)) * D + c) = *(const f32x4*)(gp + c) * wsc * acc[ai][bj][m][n]; }
                    if (m & 1) asm volatile("" ::: "memory");
                }
        }
    }
};
template <int QM> struct EpiGlu {
    static constexpr bool PERM = true, AFTER_DRAIN = false;
    bf16* H; float wsc; const float* su; const float* sw;
    __device__ __forceinline__ void operator()(const f32x4 (&acc)[2][2][4][2], const pg8::Unit& u, int wr, int wc, int fr, int fq) const {
        asm volatile("" : "+v"(fr), "+v"(fq));
        const int col = u.pn * 128 + wc * 32 + 8 * fq;
        f32x4 sg[2], sp[2]; float rs[2][4];
        if (QM == 2) { const float* p = sw + u.pn * 256 + wc * 32 + 8 * fq; sg[0] = *(const f32x4*)p * (1.f / 127.f); sg[1] = *(const f32x4*)(p + 4) * (1.f / 127.f); sp[0] = *(const f32x4*)(p + 128) * (1.f / 127.f); sp[1] = *(const f32x4*)(p + 132) * (1.f / 127.f);
#pragma unroll
            for (int ai = 0; ai < 2; ++ai)
#pragma unroll
                for (int m = 0; m < 4; ++m) rs[ai][m] = su[(size_t)u.pm * 256 + ai * 128 + wr * 64 + m * 16 + fr]; }
#pragma unroll
        for (int ai = 0; ai < 2; ++ai)
#pragma unroll
            for (int m = 0; m < 4; ++m) { const size_t mrow = (size_t)u.pm * 256 + ai * 128 + wr * 64 + m * 16 + fr;
                f32x4 v[2];
#pragma unroll
                for (int n = 0; n < 2; ++n) { f32x4 g, up;
                    if (QM == 2) {
#pragma unroll
                        for (int j = 0; j < 4; ++j) { const float ga = acc[ai][0][m][n][j], ua = acc[ai][1][m][n][j];
                            g[j] = (float)__builtin_bit_cast(int, ga) * (rs[ai][m] * sg[n][j]); up[j] = (float)__builtin_bit_cast(int, ua) * (rs[ai][m] * sp[n][j]); } }
                    else { g = acc[ai][0][m][n] * wsc; up = acc[ai][1][m][n] * wsc; }
#pragma unroll
                    for (int j = 0; j < 4; ++j) v[n][j] = g[j] * fast_sigmoid(g[j]) * up[j]; }
                if (F8_DOWN) { u32x2 w; w.x = pk4_fp8(v[0][0], v[0][1], v[0][2], v[0][3]); w.y = pk4_fp8(v[1][0], v[1][1], v[1][2], v[1][3]); *(u32x2*)((unsigned char*)H + mrow * DFF + col) = w; }
                else { u32x4 w; w.x = cvt_pk_bf16(v[0][0], v[0][1]); w.y = cvt_pk_bf16(v[0][2], v[0][3]); w.z = cvt_pk_bf16(v[1][0], v[1][1]); w.w = cvt_pk_bf16(v[1][2], v[1][3]);
                    *(u32x4*)(H + mrow * DFF + col) = w; } }
    }
};
#define XB_TMO      128
#define XB_XCNT(j)  (256  + 64 * (j))
#define XB_XSUB(j)  (1280 + 64 * (j))
#define XB_XGEN(j)  (2304 + 64 * (j))
#define XB_TOP      3328
#define XB_TOPGEN   3392
#define XCD_BAR_WORDS 3456
#define XB_SPIN_CAP (1u << 18)
#define LAS __attribute__((address_space(3)))

__device__ __forceinline__ unsigned xb_ld(unsigned* p)              { return __hip_atomic_load(p, __ATOMIC_RELAXED, __HIP_MEMORY_SCOPE_AGENT); }
__device__ __forceinline__ unsigned xb_add(unsigned* p, unsigned v) { return __hip_atomic_fetch_add(p, v, __ATOMIC_RELAXED, __HIP_MEMORY_SCOPE_AGENT); }
__device__ __forceinline__ unsigned xb_xcc_id() { return (unsigned)__builtin_amdgcn_s_getreg((3 << 11) | 20) & 0xFu; }
#define XB_SPIN(cond, bar) do { unsigned _sp = 0; while (cond) { __builtin_amdgcn_s_sleep(1); \
    if ((++_sp & 255u) == 0u) { if (xb_ld(&(bar)[XB_TMO])) break; if (_sp > XB_SPIN_CAP) { atomicAdd(&(bar)[XB_TMO], 1u); break; } } } } while (0)

struct XcdBarrier {
    unsigned* bar; unsigned x;
    volatile LAS unsigned* st;
};

__device__ __forceinline__ XcdBarrier xcd_barrier_post(unsigned* bar, volatile LAS unsigned* st) {
    XcdBarrier b; b.bar = bar; b.x = xb_xcc_id(); b.st = st;
    if (threadIdx.x == 0) (void)xb_add(&bar[XB_XCNT(b.x)], 1u);
    return b;
}
__device__ __forceinline__ void xcd_barrier_complete(unsigned* bar, unsigned x, unsigned& nloc, unsigned& nx) {
    const unsigned G = gridDim.x * gridDim.y * gridDim.z;
    unsigned sum, cnt, mine, sp = 0u;
    for (;;) {
        sum = 0u; cnt = 0u; mine = 0u;
#pragma unroll
        for (unsigned j = 0; j < 16; ++j) { const unsigned c = xb_ld(&bar[XB_XCNT(j)]); sum += c; cnt += (c > 0u) ? 1u : 0u; mine = (j == x) ? c : mine; }
        if (sum == G) break;
        __builtin_amdgcn_s_sleep(1);
        if ((++sp & 255u) == 0u) { if (xb_ld(&bar[XB_TMO])) break; if (sp > XB_SPIN_CAP) { atomicAdd(&bar[XB_TMO], 1u); break; } }
    }
    nloc = mine > 0u ? mine : 1u; nx = cnt > 0u ? cnt : 1u;
}

__device__ __forceinline__ void xcd_barrier(const XcdBarrier& b) {
    asm volatile("s_waitcnt vmcnt(0)" ::: "memory");
    __syncthreads();
    if (threadIdx.x == 0) {
        unsigned* bar = b.bar;
        __builtin_amdgcn_s_waitcnt(0);
        unsigned nloc = b.st[0], nx = b.st[1];
        if (nloc == 0u) { xcd_barrier_complete(bar, b.x, nloc, nx); b.st[0] = nloc; b.st[1] = nx; }
        const unsigned old = xb_add(&bar[XB_XSUB(b.x)], 1u);
        const unsigned gen = old / nloc;
        if (old + 1u == (gen + 1u) * nloc) {
            __builtin_amdgcn_fence(__ATOMIC_RELEASE, "agent");
            asm volatile("s_waitcnt vmcnt(0)" ::: "memory");
            const unsigned og = xb_add(&bar[XB_TOP], 1u);
            const unsigned tg = og / nx;
            if (og + 1u == (tg + 1u) * nx) xb_add(&bar[XB_TOPGEN], 1u);
            else XB_SPIN(xb_ld(&bar[XB_TOPGEN]) == tg, bar);
            __builtin_amdgcn_fence(__ATOMIC_ACQUIRE, "agent");
            xb_add(&bar[XB_XGEN(b.x)], 1u);
            asm volatile("s_waitcnt vmcnt(0)" ::: "memory");
        } else {
            XB_SPIN(xb_ld(&bar[XB_XGEN(b.x)]) == gen, bar);
            __builtin_amdgcn_fence(__ATOMIC_ACQUIRE, "agent");
            asm volatile("s_waitcnt vmcnt(0)" ::: "memory");
        }
    }
    __syncthreads();
}
constexpr int NWAVES = 8;
struct Params {
    const float* in[27];
    float* out; unsigned char* ws;
    int ph_lo, ph_hi;
    int sub, pad;
};
enum { I_XP = 0, I_XS, I_CK, I_CV, I_SCONV, I_SH, I_CP, I_CS, I_G1, I_G2, I_WMOD, I_BMOD, I_WIN, I_QG, I_KG, I_RELB, I_CONVW, I_CONVB, I_WRA, I_BRA, I_WRX, I_BRX, I_LAM, I_WOUT, I_WG, I_WU, I_WD };

__device__ __forceinline__ float wave_sum(float v) {
#pragma unroll
    for (int o = 1; o < 64; o <<= 1) v += __shfl_xor(v, o);
    return v;
}
__device__ __forceinline__ unsigned f2bf(float f) { unsigned u = __builtin_bit_cast(unsigned, f); return (u + 0x7fffu + ((u >> 16) & 1u)) >> 16; }
__device__ __forceinline__ unsigned pk2(float lo, float hi) { return f2bf(lo) | (f2bf(hi) << 16); }

#ifndef NT_WEIGHTS
#define NT_WEIGHTS 0
#endif
#if NT_WEIGHTS
#define NT_LOAD(p) __builtin_nontemporal_load(p)
#else
#define NT_LOAD(p) (*(p))
#endif
__device__ __forceinline__ void transpose_item(const float* src, size_t sld, bf16* dst, size_t dld, LAS float* scr, int lane, size_t blk = 32) {
    { f32x4 v[8]; const int r8 = lane >> 3, c4 = lane & 7;
#pragma unroll
      for (int i = 0; i < 8; ++i) v[i] = NT_LOAD((const f32x4*)(src + (size_t)(8 * i + r8) * sld + 4 * c4));
#pragma unroll
      for (int i = 0; i < 8; ++i) { LAS float* d = scr + (8 * i + r8) * 33 + 4 * c4; d[0] = v[i][0]; d[1] = v[i][1]; d[2] = v[i][2]; d[3] = v[i][3]; } }
    LDS_WAIT(); asm volatile("" ::: "memory");
    const int c = lane & 7;
#pragma unroll
    for (int j = 0; j < 4; ++j) { const int n = (lane >> 3) + 8 * j; const LAS float* s = scr + (8 * c) * 33 + n;
        u32x4 o; o.x = pk2(s[0 * 33], s[1 * 33]); o.y = pk2(s[2 * 33], s[3 * 33]); o.z = pk2(s[4 * 33], s[5 * 33]); o.w = pk2(s[6 * 33], s[7 * 33]);
        *(u32x4*)(dst + (size_t)n * dld + (size_t)(c >> 2) * blk + 8 * (c & 3)) = o; }
    LDS_WAIT(); asm volatile("" ::: "memory");
}
__device__ __forceinline__ void transpose_item_f8(const float* src, size_t sld, unsigned char* dst, size_t dld, LAS float* scr, int lane) {
    { f32x4 v[8]; const int r8 = lane >> 3, c4 = lane & 7;
#pragma unroll
      for (int i = 0; i < 8; ++i) v[i] = NT_LOAD((const f32x4*)(src + (size_t)(8 * i + r8) * sld + 4 * c4));
#pragma unroll
      for (int i = 0; i < 8; ++i) { LAS float* d = scr + (8 * i + r8) * 33 + 4 * c4; d[0] = v[i][0]; d[1] = v[i][1]; d[2] = v[i][2]; d[3] = v[i][3]; } }
    LDS_WAIT(); asm volatile("" ::: "memory");
#pragma unroll
    for (int j = 0; j < 2; ++j) { const int p = lane + 64 * j, n = p >> 2, c = p & 3; const LAS float* s = scr + (16 * c) * 33 + n;
        u32x4 o; o.x = pk4_fp8(s[0 * 33] * W8_SCALE, s[1 * 33] * W8_SCALE, s[2 * 33] * W8_SCALE, s[3 * 33] * W8_SCALE); o.y = pk4_fp8(s[4 * 33] * W8_SCALE, s[5 * 33] * W8_SCALE, s[6 * 33] * W8_SCALE, s[7 * 33] * W8_SCALE);
        o.z = pk4_fp8(s[8 * 33] * W8_SCALE, s[9 * 33] * W8_SCALE, s[10 * 33] * W8_SCALE, s[11 * 33] * W8_SCALE); o.w = pk4_fp8(s[12 * 33] * W8_SCALE, s[13 * 33] * W8_SCALE, s[14 * 33] * W8_SCALE, s[15 * 33] * W8_SCALE);
        *(u32x4*)(dst + (size_t)n * dld + 16 * c) = o; }
    LDS_WAIT(); asm volatile("" ::: "memory");
}
__device__ __forceinline__ void transpose_item_i8(const float* src, size_t sld, unsigned char* dst, size_t dld, LAS float* scr, int lane, const float* amax) {
    { f32x4 v[8]; const int r8 = lane >> 3, c4 = lane & 7;
#pragma unroll
      for (int i = 0; i < 8; ++i) v[i] = NT_LOAD((const f32x4*)(src + (size_t)(8 * i + r8) * sld + 4 * c4));
#pragma unroll
      for (int i = 0; i < 8; ++i) { LAS float* d = scr + (8 * i + r8) * 33 + 4 * c4; d[0] = v[i][0]; d[1] = v[i][1]; d[2] = v[i][2]; d[3] = v[i][3]; } }
    LDS_WAIT(); asm volatile("" ::: "memory");
#pragma unroll
    for (int j = 0; j < 2; ++j) { const int p = lane + 64 * j, n = p >> 2, c = p & 3; const LAS float* s = scr + (16 * c) * 33 + n;
        const float a = amax[n], inv = a > 0.f ? 127.f / a : 0.f;
        u32x4 o; o.x = pk4_i8(s[0 * 33], s[1 * 33], s[2 * 33], s[3 * 33], inv); o.y = pk4_i8(s[4 * 33], s[5 * 33], s[6 * 33], s[7 * 33], inv);
        o.z = pk4_i8(s[8 * 33], s[9 * 33], s[10 * 33], s[11 * 33], inv); o.w = pk4_i8(s[12 * 33], s[13 * 33], s[14 * 33], s[15 * 33], inv);
        *(u32x4*)(dst + (size_t)n * dld + 16 * c) = o; }
    LDS_WAIT(); asm volatile("" ::: "memory");
}
__device__ __forceinline__ void transpose_item_dual(const float* src, size_t sld, bf16* dst, size_t dld, unsigned char* dst8, size_t dld8, LAS float* scr, int lane, const float* amax) {
    { f32x4 v[8]; const int r8 = lane >> 3, c4 = lane & 7;
#pragma unroll
      for (int i = 0; i < 8; ++i) v[i] = NT_LOAD((const f32x4*)(src + (size_t)(8 * i + r8) * sld + 4 * c4));
#pragma unroll
      for (int i = 0; i < 8; ++i) { LAS float* d = scr + (8 * i + r8) * 33 + 4 * c4; d[0] = v[i][0]; d[1] = v[i][1]; d[2] = v[i][2]; d[3] = v[i][3]; } }
    LDS_WAIT(); asm volatile("" ::: "memory");
    { const int c = lane & 7;
#pragma unroll
      for (int j = 0; j < 4; ++j) { const int n = (lane >> 3) + 8 * j; const LAS float* s = scr + (8 * c) * 33 + n;
          u32x4 o; o.x = pk2(s[0 * 33], s[1 * 33]); o.y = pk2(s[2 * 33], s[3 * 33]); o.z = pk2(s[4 * 33], s[5 * 33]); o.w = pk2(s[6 * 33], s[7 * 33]);
          *(u32x4*)(dst + (size_t)n * dld + 8 * c) = o; } }
#pragma unroll
    for (int j = 0; j < 2; ++j) { const int p = lane + 64 * j, n = p >> 2, c = p & 3; const LAS float* s = scr + (16 * c) * 33 + n;
        const float a = amax[n], inv = a > 0.f ? 127.f / a : 0.f;
        u32x4 o; o.x = pk4_i8(s[0 * 33], s[1 * 33], s[2 * 33], s[3 * 33], inv); o.y = pk4_i8(s[4 * 33], s[5 * 33], s[6 * 33], s[7 * 33], inv);
        o.z = pk4_i8(s[8 * 33], s[9 * 33], s[10 * 33], s[11 * 33], inv); o.w = pk4_i8(s[12 * 33], s[13 * 33], s[14 * 33], s[15 * 33], inv);
        *(u32x4*)(dst8 + (size_t)n * dld8 + 16 * c) = o; }
    LDS_WAIT(); asm volatile("" ::: "memory");
}
__device__ __forceinline__ void p0_amax(const Params& P, int gw, int NGW, int lane) {
    unsigned* amax = (unsigned*)(P.ws + WS_CTL + WS_AMAX);
    constexpr int CC = DFF / 256, KC = D / 32, NIT = 2 * KC * CC;
    for (int it = gw; it < NIT; it += NGW) {
        const int up = it >= KC * CC, r = up ? it - KC * CC : it, kc = r / CC, cc = r % CC;
        const float* src = P.in[up ? I_WU : I_WG] + (size_t)kc * 32 * DFF + cc * 256 + 4 * lane;
        f32x4 m = (f32x4){0.f, 0.f, 0.f, 0.f};
#pragma unroll
        for (int h = 0; h < 2; ++h) { f32x4 v[16];
#pragma unroll
            for (int i = 0; i < 16; ++i) v[i] = NT_LOAD((const f32x4*)(src + (size_t)(h * 16 + i) * DFF));
#pragma unroll
            for (int i = 0; i < 16; ++i) { m[0] = fmaxf(m[0], fabsf(v[i][0])); m[1] = fmaxf(m[1], fabsf(v[i][1])); m[2] = fmaxf(m[2], fabsf(v[i][2])); m[3] = fmaxf(m[3], fabsf(v[i][3])); } }
        const int n = cc * 256 + 4 * lane, ni = 256 * (n >> 7) + (n & 127) + (up ? 128 : 0);
#pragma unroll
        for (int j = 0; j < 4; ++j) { const float mj = m[j]; __hip_atomic_fetch_max(amax + ni + j, __builtin_bit_cast(unsigned, mj), __ATOMIC_RELAXED, __HIP_MEMORY_SCOPE_AGENT); }
    }
    unsigned* amax1 = (unsigned*)(P.ws + WS_CTL + WS_AMAX1);
    for (int it = gw; it < KC * 32; it += NGW) {
        const int kc = it >> 5, c5 = it & 31, cc = c5 < 24 ? c5 : c5 + 8;
        const float* src = P.in[I_WIN] + (size_t)kc * 32 * INC + cc * 256 + 4 * lane;
        f32x4 m = (f32x4){0.f, 0.f, 0.f, 0.f};
#pragma unroll
        for (int h = 0; h < 2; ++h) { f32x4 v[16];
#pragma unroll
            for (int i = 0; i < 16; ++i) v[i] = NT_LOAD((const f32x4*)(src + (size_t)(h * 16 + i) * INC));
#pragma unroll
            for (int i = 0; i < 16; ++i) { m[0] = fmaxf(m[0], fabsf(v[i][0])); m[1] = fmaxf(m[1], fabsf(v[i][1])); m[2] = fmaxf(m[2], fabsf(v[i][2])); m[3] = fmaxf(m[3], fabsf(v[i][3])); } }
#pragma unroll
        for (int j = 0; j < 4; ++j) { const float mj = m[j]; __hip_atomic_fetch_max(amax1 + cc * 256 + 4 * lane + j, __builtin_bit_cast(unsigned, mj), __ATOMIC_RELAXED, __HIP_MEMORY_SCOPE_AGENT); }
    }
}
__device__ __forceinline__ void cvt_item(const float* src, bf16* dst, int lane) {
#pragma unroll
    for (int j = 0; j < 4; ++j) { const f32x4 a = *(const f32x4*)(src + j * 512 + lane * 8), b = *(const f32x4*)(src + j * 512 + lane * 8 + 4);
        u32x4 o; o.x = pk2(a[0], a[1]); o.y = pk2(a[2], a[3]); o.z = pk2(b[0], b[1]); o.w = pk2(b[2], b[3]); *(u32x4*)(dst + j * 512 + lane * 8) = o; }
}
__device__ __forceinline__ void p0_convert(const Params& P, LAS unsigned char* lds, int gw, int NGW, int wave, int lane) {
    LAS float* scr = (LAS float*)(lds + wave * 8704);
    unsigned char* ws = P.ws;
    bf16* WinT = (bf16*)(ws + WS_WIN); bf16* WoutT = (bf16*)(ws + WS_WOUT); bf16* WguT = (bf16*)(ws + WS_WGU); bf16* WdT = (bf16*)(ws + WS_WD); bf16* WrgT = (bf16*)(ws + WS_WRG);
    bf16* VtS = (bf16*)(ws + WS_VTS); bf16* Kc = (bf16*)(ws + WS_KC);
    constexpr int I_IN = (D / 64) * (INC / 32), I_OUT = (D / 64) * (D / 32), I_GA = (D / 64) * (DFF / 32), I_DN = (DFF / 64) * (D / 32), I_CVT = SB * NH * (CROWS / 64) * (HD / 32), I_RG = 16 * (128 / 64) * (128 / 32),
                  I_KC = SB * NH * (CROWS / 16);
    constexpr int I_XR = (D / 64) * (LW / 32);
    constexpr int NITEMS = I_XR + I_OUT + I_DN + I_CVT + 2 * I_RG + I_KC;
    for (int it = gw; it < NITEMS; it += NGW) {
        int r = it;
        if (r < I_XR) { const int nb = 192 + r % (LW / 32), kb = r / (LW / 32); transpose_item(P.in[I_WIN] + (size_t)kb * 64 * INC + nb * 32, INC, WinT + (size_t)nb * 32 * D + kb * 64, D, scr, lane); continue; } r -= I_XR;
        if (r < I_OUT) { const int nb = r % (D / 32), kb = r / (D / 32); transpose_item(P.in[I_WOUT] + (size_t)kb * 64 * D + nb * 32, D, WoutT + (size_t)nb * 32 * D + kb * 64, D, scr, lane); continue; } r -= I_OUT;
        if (r < I_DN) { const int nb = r % (D / 32), kb = r / (D / 32);
            if (F8_DOWN) transpose_item_f8(P.in[I_WD] + (size_t)kb * 64 * D + nb * 32, D, (unsigned char*)WdT + (size_t)nb * 32 * DFF + kb * 64, DFF, scr, lane);
            else transpose_item(P.in[I_WD] + (size_t)kb * 64 * D + nb * 32, D, WdT + (size_t)nb * 32 * DFF + kb * 64, DFF, scr, lane); continue; } r -= I_DN;
        if (r < I_CVT) { const int sub = r & 31, bh = r >> 5, b = bh >> 4, h = bh & 15, kb = sub >> 2, nb = sub & 3;
            transpose_item(P.in[I_CV] + ((size_t)(b * CROWS + kb * 64) * NH + h) * HD + nb * 32, (size_t)NH * HD, VtS + (((size_t)(b * NH + h) * (KS_LD / 32) + kb * 2) * HD + nb * 32) * 32, 32, scr, lane, HD * 32); continue; } r -= I_CVT;
        if (r < 2 * I_RG) { const int x = r >= I_RG; if (x) r -= I_RG; const int sub = r & 7, n = r >> 3, kb = sub >> 2, nb = sub & 3;
            transpose_item(P.in[x ? I_WRX : I_WRA] + (size_t)n * 16384 + kb * 64 * 128 + nb * 32, 128, WrgT + ((size_t)n * 256 + x * 128 + nb * 32) * 128 + kb * 64, 128, scr, lane); continue; } r -= 2 * I_RG;
        { const int kc = r & 31, bh = r >> 5, b = bh >> 4, h = bh & 15;
#pragma unroll
          for (int j = 0; j < 4; ++j) { const int key = kc * 16 + 4 * j + (lane >> 4), d8 = (lane & 15) * 8; const float* sp = P.in[I_CK] + ((size_t)(b * CROWS + key) * NH + h) * HD + d8;
              const f32x4 a = *(const f32x4*)sp, c4 = *(const f32x4*)(sp + 4); u32x4 o; o.x = pk2(a[0], a[1]); o.y = pk2(a[2], a[3]); o.z = pk2(c4[0], c4[1]); o.w = pk2(c4[2], c4[3]);
              *(u32x4*)(Kc + ((size_t)bh * CROWS + key) * HD + d8) = o; } }
    }
    { unsigned* ctl = (unsigned*)(ws + WS_CTL);
      if (threadIdx.x == 0) {
          unsigned sp = 0;
          while (__hip_atomic_load(ctl + CW_ARRIVE + 896, __ATOMIC_RELAXED, __HIP_MEMORY_SCOPE_AGENT) < gridDim.x) { __builtin_amdgcn_s_sleep(2);
              if ((++sp & 255u) == 0u) { if (__hip_atomic_load(ctl + CW_TMO2, __ATOMIC_RELAXED, __HIP_MEMORY_SCOPE_AGENT)) break; if (sp > (1u << 20)) { __hip_atomic_store(ctl + CW_TMO2, 1u, __ATOMIC_RELAXED, __HIP_MEMORY_SCOPE_AGENT); break; } } }
          __builtin_amdgcn_fence(__ATOMIC_ACQUIRE, "agent"); VM_WAIT();
      }
      __syncthreads(); }
    const float* amax = (const float*)(ws + WS_CTL + WS_AMAX);
    for (int it = gw; it < 2 * I_GA; it += NGW) {
        int r = it; const int up = r >= I_GA; if (up) r -= I_GA; const int nb = r % (DFF / 32), kb = r / (DFF / 32); const int n0 = nb * 32, row0 = 256 * (n0 >> 7) + (n0 & 127) + (up ? 128 : 0);
        transpose_item_i8(P.in[up ? I_WU : I_WG] + (size_t)kb * 64 * DFF + n0, DFF, (unsigned char*)WguT + (size_t)row0 * D + kb * 64, D, scr, lane, amax + row0);
    }
    const float* amax1 = (const float*)(ws + WS_CTL + WS_AMAX1); unsigned char* Win8 = ws + WS_WIN8;
    for (int it = gw; it < (D / 64) * 256; it += NGW) {
        const int kb = it >> 8, n5 = it & 255, nb = n5 < 192 ? n5 : n5 + 64;
        const float* src = P.in[I_WIN] + (size_t)kb * 64 * INC + nb * 32;
        if (nb >= 64 && nb < 192) transpose_item_dual(src, INC, WinT + (size_t)nb * 32 * D + kb * 64, D, Win8 + (size_t)nb * 32 * D + kb * 64, D, scr, lane, amax1 + nb * 32);
        else transpose_item_i8(src, INC, Win8 + (size_t)nb * 32 * D + kb * 64, D, scr, lane, amax1 + nb * 32);
    }
}
__device__ __forceinline__ void p0_mod(const Params& P, LAS unsigned char* lds, int tid, int wave, int lane) {
    LAS float* Sw = (LAS float*)lds + wave * 640;
    LAS float* Rb = (LAS float*)(lds + 20480);
    const float* Wm = P.in[I_WMOD]; float* mod = (float*)(P.ws + WS_MOD);
    for (int cb = blockIdx.x; cb < NMOD / 96; cb += gridDim.x) {
        const int n0 = cb * 96, rs = lane / 24, c4 = lane % 24;
        f32x4 acc[NSEQ];
#pragma unroll
        for (int s = 0; s < NSEQ; ++s) acc[s] = (f32x4){0.f, 0.f, 0.f, 0.f};
        __syncthreads();
        for (int idx = lane; idx < NSEQ * 16; idx += 64) { const int sq = idx >> 4, r = idx & 15; const float v = sq < NB ? P.in[I_CP][sq * D + wave * 16 + r] : P.in[I_CS][(sq - NB) * D + wave * 16 + r]; Sw[r * 20 + sq] = v * fast_sigmoid(v); }
        f32x4 w[8];
        if (lane < 48) {
#pragma unroll
            for (int p = 0; p < 8; ++p) w[p] = NT_LOAD((const f32x4*)(Wm + (size_t)(wave * 16 + 2 * p + rs) * NMOD + n0 + 4 * c4)); }
        for (int ch = 0; ch < D / 128; ++ch) {
            const int k0 = ch * 128; LAS float* Sc = Sw + (ch & 1) * 320; LAS float* Sn = Sw + ((ch + 1) & 1) * 320;
            const int kn = (ch + 1 < D / 128) ? k0 + 128 : k0;
            for (int idx = lane; idx < NSEQ * 16; idx += 64) { const int sq = idx >> 4, r = idx & 15; const float v = sq < NB ? P.in[I_CP][sq * D + kn + wave * 16 + r] : P.in[I_CS][(sq - NB) * D + kn + wave * 16 + r]; Sn[r * 20 + sq] = v * fast_sigmoid(v); }
            LDS_WAIT(); asm volatile("" ::: "memory");
            if (lane < 48) {
                f32x4 wn[8];
#pragma unroll
                for (int p = 0; p < 8; ++p) wn[p] = NT_LOAD((const f32x4*)(Wm + (size_t)(kn + wave * 16 + 2 * p + rs) * NMOD + n0 + 4 * c4));
#pragma unroll
                for (int p = 0; p < 8; ++p) { const LAS float* sp = Sc + (2 * p + rs) * 20;
                    const f32x4 s0 = *(const LAS f32x4*)sp, s1 = *(const LAS f32x4*)(sp + 4), s2 = *(const LAS f32x4*)(sp + 8), s3 = *(const LAS f32x4*)(sp + 12); const f32x2 s4 = *(const LAS f32x2*)(sp + 16);
#pragma unroll
                    for (int j = 0; j < 4; ++j) { acc[j] += w[p] * s0[j]; acc[4 + j] += w[p] * s1[j]; acc[8 + j] += w[p] * s2[j]; acc[12 + j] += w[p] * s3[j]; }
                    acc[16] += w[p] * s4[0]; acc[17] += w[p] * s4[1]; }
#pragma unroll
                for (int p = 0; p < 8; ++p) w[p] = wn[p];
            }
            LDS_WAIT(); asm volatile("" ::: "memory");
        }
        if (lane < 48) {
#pragma unroll
            for (int s = 0; s < NSEQ; ++s) *(LAS f32x4*)(Rb + ((wave * 2 + rs) * NSEQ + s) * 96 + 4 * c4) = acc[s];
        }
        __syncthreads();
        for (int idx = tid; idx < NSEQ * 96; idx += NWAVES * 64) { const int s = idx / 96, c = idx % 96; float v = P.in[I_BMOD][n0 + c];
#pragma unroll
            for (int q = 0; q < 16; ++q) v += Rb[(q * NSEQ + s) * 96 + c];
            mod[(size_t)s * NMOD + n0 + c] = v; }
    }
    __syncthreads();
}
template <bool X0_BF16, int UQ = 0> __device__ __forceinline__ void norm_rows(const float* __restrict__ x0, const float* __restrict__ x1, const float* __restrict__ gain, const float* __restrict__ mod, int sh_off, int sc_off, bf16* __restrict__ U, const float* __restrict__ slab, float* __restrict__ x1out, int nrows, int gw, int NGW, int lane, float* __restrict__ su = nullptr, unsigned char* __restrict__ U8p = nullptr) {
    for (int m = gw; m < nrows; m += NGW) {
        const float* xr = m < NPR ? x0 + (X0_BF16 ? 0 : (size_t)m * D) : x1 + (size_t)(m - NPR) * D;
        const int seq = m < NPR ? m / T : NB + (m - NPR) / ST;
        const float* mp = mod + (size_t)seq * NMOD;
        f32x4 v[16]; float ss = 0.f;
#pragma unroll
        for (int j = 0; j < 16; ++j) {
            if (X0_BF16 && m < NPR) { const u32x2 w = *(const u32x2*)((const bf16*)x0 + (size_t)m * D + 4 * (lane + 64 * j)); v[j] = (f32x4){__uint_as_float(w.x << 16), __uint_as_float(w.x & 0xffff0000u), __uint_as_float(w.y << 16), __uint_as_float(w.y & 0xffff0000u)}; }
            else v[j] = *(const f32x4*)(xr + 4 * (lane + 64 * j)); }
        if (slab && m >= NPR) {
            for (int q = 0; q < 8; ++q) {
#pragma unroll
                for (int j = 0; j < 16; ++j) v[j] += *(const f32x4*)(slab + ((size_t)q * NSA + (m - NPR)) * D + 4 * (lane + 64 * j)); }
#pragma unroll
            for (int j = 0; j < 16; ++j) *(f32x4*)(x1out + (size_t)(m - NPR) * D + 4 * (lane + 64 * j)) = v[j];
        }
#pragma unroll
        for (int j = 0; j < 16; ++j) ss += (v[j][0] * v[j][0] + v[j][1] * v[j][1]) + (v[j][2] * v[j][2] + v[j][3] * v[j][3]);
        const float rstd = __builtin_amdgcn_rsqf(wave_sum(ss) * (1.0f / D) + RMS_EPS);
        bf16* up = U + (size_t)m * D; unsigned char* up8 = (unsigned char*)U + (size_t)m * D;
        constexpr int JB = UQ ? 4 : 8;
        float amx = 0.f;
#pragma unroll
        for (int jb = 0; jb < 16; jb += JB) {
            f32x4 g[JB], sc[JB], sh[JB];
#pragma unroll
            for (int j = 0; j < JB; ++j) { const int c = 4 * (lane + 64 * (jb + j)); g[j] = *(const f32x4*)(gain + c); sc[j] = *(const f32x4*)(mp + sc_off + c); sh[j] = *(const f32x4*)(mp + sh_off + c); }
#pragma unroll
            for (int j = 0; j < JB; ++j) { const int c = 4 * (lane + 64 * (jb + j));
                const f32x4 o = v[jb + j] * rstd * g[j] * (sc[j] + 1.0f) + sh[j];
                if (UQ >= 2) { v[jb + j] = o; amx = fmaxf(fmaxf(amx, fmaxf(fabsf(o[0]), fabsf(o[1]))), fmaxf(fabsf(o[2]), fabsf(o[3]))); }
                if (UQ != 2) { u32x2 w; w.x = cvt_pk_bf16(o[0], o[1]); w.y = cvt_pk_bf16(o[2], o[3]); *(u32x2*)(up + c) = w; } }
            if (UQ) asm volatile("" ::: "memory");
        }
        if (UQ >= 2) {
#pragma unroll
            for (int o = 1; o < 64; o <<= 1) amx = fmaxf(amx, __shfl_xor(amx, o));
            const float inv = amx > 0.f ? 127.f / amx : 0.f;
            if (lane == 0) su[m] = amx * (1.f / 127.f);
            unsigned char* q8 = UQ == 3 ? U8p + (size_t)m * D : up8;
#pragma unroll
            for (int j = 0; j < 16; ++j) *(unsigned*)(q8 + 4 * (lane + 64 * j)) = pk4_i8(v[j][0], v[j][1], v[j][2], v[j][3], inv);
        }
    }
}

template <bool SLAB, int UQ = 0> __device__ __forceinline__ void norm_sample_split(const Params& P, LAS unsigned char* lds, const float* __restrict__ xs, const float* __restrict__ gain, const float* __restrict__ mod, int sh_off, int sc_off,
                                                  bf16* __restrict__ U, const float* __restrict__ slab, float* __restrict__ x1out, int wave, int lane, float* __restrict__ su = nullptr, unsigned char* __restrict__ U8p = nullptr) {
    LAS float* part = (LAS float*)lds;
    for (int rb = blockIdx.x; rb < NSA / 2; rb += gridDim.x) {
        const int r = 2 * rb + (wave >> 2), col0 = 1024 * (wave & 3), seq = NB + r / ST;
        const float* mp = mod + (size_t)seq * NMOD;
        f32x4 v[4];
#pragma unroll
        for (int j = 0; j < 4; ++j) v[j] = *(const f32x4*)(xs + (size_t)r * D + col0 + 4 * (lane + 64 * j));
        if (SLAB) {
#pragma unroll
            for (int q = 0; q < 8; ++q)
#pragma unroll
                for (int j = 0; j < 4; ++j) v[j] += *(const f32x4*)(slab + ((size_t)q * NSA + r) * D + col0 + 4 * (lane + 64 * j)); }
        float ss = 0.f;
#pragma unroll
        for (int j = 0; j < 4; ++j) { if (SLAB) *(f32x4*)(x1out + (size_t)r * D + col0 + 4 * (lane + 64 * j)) = v[j]; ss += (v[j][0] * v[j][0] + v[j][1] * v[j][1]) + (v[j][2] * v[j][2] + v[j][3] * v[j][3]); }
        ss = wave_sum(ss);
        __syncthreads();
        if (lane == 0) part[wave] = ss;
        __syncthreads();
        const int w0 = wave & 4; const float tot = (part[w0] + part[w0 + 1]) + (part[w0 + 2] + part[w0 + 3]);
        const float rstd = __builtin_amdgcn_rsqf(tot * (1.0f / D) + RMS_EPS);
        bf16* up = U + (size_t)(NPR + r) * D; unsigned char* up8 = (unsigned char*)U + (size_t)(NPR + r) * D;
        float amx = 0.f;
#pragma unroll
        for (int j = 0; j < 4; ++j) { const int c = col0 + 4 * (lane + 64 * j);
            const f32x4 o = v[j] * rstd * *(const f32x4*)(gain + c) * (*(const f32x4*)(mp + sc_off + c) + 1.0f) + *(const f32x4*)(mp + sh_off + c);
            if (UQ >= 2) { v[j] = o; amx = fmaxf(fmaxf(amx, fmaxf(fabsf(o[0]), fabsf(o[1]))), fmaxf(fabsf(o[2]), fabsf(o[3]))); }
            if (UQ != 2) { u32x2 w; w.x = cvt_pk_bf16(o[0], o[1]); w.y = cvt_pk_bf16(o[2], o[3]); *(u32x2*)(up + c) = w; } }
        if (UQ >= 2) {
#pragma unroll
            for (int o = 1; o < 64; o <<= 1) amx = fmaxf(amx, __shfl_xor(amx, o));
            if (lane == 0) part[8 + wave] = amx;
            __syncthreads();
            const float rmx = fmaxf(fmaxf(part[8 + w0], part[8 + w0 + 1]), fmaxf(part[8 + w0 + 2], part[8 + w0 + 3]));
            const float inv = rmx > 0.f ? 127.f / rmx : 0.f;
            if (lane == 0 && (wave & 3) == 0) su[NPR + r] = rmx * (1.f / 127.f);
            unsigned char* q8 = UQ == 3 ? U8p + (size_t)(NPR + r) * D : up8;
#pragma unroll
            for (int j = 0; j < 4; ++j) *(unsigned*)(q8 + col0 + 4 * (lane + 64 * j)) = pk4_i8(v[j][0], v[j][1], v[j][2], v[j][3], inv);
        }
    }
}
__device__ __forceinline__ void attn_unit(const bf16* Qp, const bf16* Kp0, const bf16* Kp1, int nks, int ks_split, const bf16* Vt, int dq0, const LAS float* tab, bf16* Op, int lane) {
    const int c = lane & 15, g = lane >> 4;
    bf16x8 qf[2][4];
#pragma unroll
    for (int qt = 0; qt < 2; ++qt)
#pragma unroll
        for (int ds = 0; ds < 4; ++ds) qf[qt][ds] = *(const bf16x8*)(Qp + (unsigned)((16 * qt + c) * HD + 32 * ds + 8 * g));
    f32x4 o[8][2];
#pragma unroll
    for (int dt = 0; dt < 8; ++dt) { o[dt][0] = (f32x4){0.f, 0.f, 0.f, 0.f}; o[dt][1] = (f32x4){0.f, 0.f, 0.f, 0.f}; }
    float mrun[2] = {-1e30f, -1e30f}, lrun[2] = {0.f, 0.f};
    const int kr0 = 8 * (c >> 2) + (c & 3);
    const float bfar = tab[256];
    const unsigned koff = (unsigned)(kr0 * HD + 8 * g), voff = (unsigned)(c * 32 + 8 * g);
    bf16x8 kf[2][4], vf[8];
    {
        const bf16* kb = 0 < ks_split ? Kp0 : Kp1;
#pragma unroll
        for (int tau = 0; tau < 2; ++tau)
#pragma unroll
            for (int ds = 0; ds < 4; ++ds) kf[tau][ds] = *(const bf16x8*)(kb + tau * 4 * HD + 32 * ds + koff);
#pragma unroll
        for (int dt = 0; dt < 8; ++dt) vf[dt] = *(const bf16x8*)(Vt + dt * 512 + voff);
    }
    for (int ks = 0; ks < nks; ++ks) {
        f32x4 s[2][2];
#pragma unroll
        for (int qt = 0; qt < 2; ++qt)
#pragma unroll
            for (int tau = 0; tau < 2; ++tau) { f32x4 a = (f32x4){0.f, 0.f, 0.f, 0.f};
#pragma unroll
                for (int ds = 0; ds < 4; ++ds) a = __builtin_amdgcn_mfma_f32_16x16x32_bf16(kf[tau][ds], qf[qt][ds], a, 0, 0, 0);
                s[qt][tau] = a; }
        __builtin_amdgcn_sched_barrier(0);
        if (ks + 1 < nks) {
            const int kn = ks + 1; const bf16* kb = kn < ks_split ? Kp0 + (size_t)(32 * kn) * HD : Kp1 + (size_t)(32 * (kn - ks_split)) * HD;
#pragma unroll
            for (int tau = 0; tau < 2; ++tau)
#pragma unroll
                for (int ds = 0; ds < 4; ++ds) kf[tau][ds] = *(const bf16x8*)(kb + tau * 4 * HD + 32 * ds + koff);
        }
        __builtin_amdgcn_sched_barrier(0);
        const int dstep = dq0 - 32 * ks;
        if (dstep - 31 >= 128) {
#pragma unroll
            for (int qt = 0; qt < 2; ++qt)
#pragma unroll
                for (int tau = 0; tau < 2; ++tau) s[qt][tau] += bfar;
        } else {
#pragma unroll
            for (int qt = 0; qt < 2; ++qt)
#pragma unroll
                for (int tau = 0; tau < 2; ++tau)
#pragma unroll
                    for (int e = 0; e < 4; ++e) { int rel = dstep + 16 * qt + c - (8 * g + 4 * tau + e); rel = rel < -128 ? -128 : (rel > 128 ? 128 : rel); s[qt][tau][e] += tab[rel + 128]; }
        }
        bf16x8 pf[2];
#pragma unroll
        for (int qt = 0; qt < 2; ++qt) {
            float mx = fmaxf(fmaxf(fmaxf(s[qt][0][0], s[qt][0][1]), fmaxf(s[qt][0][2], s[qt][0][3])), fmaxf(fmaxf(s[qt][1][0], s[qt][1][1]), fmaxf(s[qt][1][2], s[qt][1][3])));
            mx = xrow16_max(mx);
            const float mn = fmaxf(mrun[qt], mx), alpha = __builtin_amdgcn_exp2f(mrun[qt] - mn);
            const bool grew = __any(mn > mrun[qt]); mrun[qt] = mn;
            f32x4 p0, p1;
#pragma unroll
            for (int e = 0; e < 4; ++e) { p0[e] = __builtin_amdgcn_exp2f(s[qt][0][e] - mn); p1[e] = __builtin_amdgcn_exp2f(s[qt][1][e] - mn); }
            lrun[qt] = lrun[qt] * alpha + ((p0[0] + p0[1]) + (p0[2] + p0[3])) + ((p1[0] + p1[1]) + (p1[2] + p1[3]));
            if (grew) {
#pragma unroll
                for (int dt = 0; dt < 8; ++dt) o[dt][qt] *= alpha; }
            u32x4 w; w.x = cvt_pk_bf16(p0[0], p0[1]); w.y = cvt_pk_bf16(p0[2], p0[3]); w.z = cvt_pk_bf16(p1[0], p1[1]); w.w = cvt_pk_bf16(p1[2], p1[3]);
            pf[qt] = __builtin_bit_cast(bf16x8, w);
        }
#pragma unroll
        for (int dt = 0; dt < 8; ++dt)
#pragma unroll
            for (int qt = 0; qt < 2; ++qt) o[dt][qt] = __builtin_amdgcn_mfma_f32_16x16x32_bf16(vf[dt], pf[qt], o[dt][qt], 0, 0, 0);
        __builtin_amdgcn_sched_barrier(0);
        if (ks + 1 < nks) {
            const bf16* vb = Vt + (size_t)(ks + 1) * (HD * 32);
#pragma unroll
            for (int dt = 0; dt < 8; ++dt) vf[dt] = *(const bf16x8*)(vb + dt * 512 + voff);
        }
        __builtin_amdgcn_sched_barrier(0);
    }
#pragma unroll
    for (int qt = 0; qt < 2; ++qt) {
        const float l = xrow16_sum(lrun[qt]);
        const float inv = 1.0f / l;
        bf16* op = Op + (unsigned)((16 * qt + c) * D + 4 * g);
#pragma unroll
        for (int dt = 0; dt < 8; ++dt) { const f32x4 v = o[dt][qt] * inv; u32x2 w; w.x = cvt_pk_bf16(v[0], v[1]); w.y = cvt_pk_bf16(v[2], v[3]); *(u32x2*)(op + 16 * dt) = w; }
    }
}
__device__ __forceinline__ void attn_block_unit(const bf16* Qh, const bf16* Kh, const bf16* VtP, bf16* MIX, int bh, int qb, const LAS float* tabh, LAS unsigned char* ring, int wave, int lane) {
    const int c = lane & 15, g = lane >> 4, b = bh >> 4, h = bh & 15;
    const int ci0 = 4 * qb, ci = ci0 + (wave >> 1), q0 = 64 * ci + 32 * (wave & 1);
    const int kt0 = ci0 > 8 ? ci0 - 8 : 0, nt = ci0 + 3 - kt0 + 1;
    const bf16* Qp = Qh + ((size_t)bh * T + q0) * HD;
    bf16x8 qf[2][4];
#pragma unroll
    for (int qt = 0; qt < 2; ++qt)
#pragma unroll
        for (int ds = 0; ds < 4; ++ds) qf[qt][ds] = *(const bf16x8*)(Qp + (unsigned)((16 * qt + c) * HD + 32 * ds + 8 * g));
    f32x4 o[8][2];
#pragma unroll
    for (int dt = 0; dt < 8; ++dt) { o[dt][0] = (f32x4){0.f, 0.f, 0.f, 0.f}; o[dt][1] = (f32x4){0.f, 0.f, 0.f, 0.f}; }
    float mrun[2] = {-1e30f, -1e30f};
    f32x4 ol[2] = {(f32x4){0.f, 0.f, 0.f, 0.f}, (f32x4){0.f, 0.f, 0.f, 0.f}};
    const bf16x8 ones = (bf16x8){0x3F80, 0x3F80, 0x3F80, 0x3F80, 0x3F80, 0x3F80, 0x3F80, 0x3F80};
    const float bfar = tabh[256];
    unsigned ksrc[2];
#pragma unroll
    for (int j = 0; j < 2; ++j) { const int r = 4 * (2 * wave + j) + (lane >> 4), pos = lane & 15, sw = (((r >> 3) & 3) << 2) | (r & 3); ksrc[j] = (unsigned)(r * HD + ((pos ^ sw) << 3)); }
    const unsigned vsrc = (unsigned)(wave * 1024 + lane * 8);
    const bf16* Kbase = Kh + (size_t)bh * T * HD; const bf16* Vbase = VtP + (size_t)bh * (T / 32) * HD * 32;
#define ATTN_DMA(kt, slot) do { const bf16* kp_ = Kbase + (size_t)(kt) * (64 * HD); const bf16* vp_ = Vbase + (size_t)(kt) * (64 * HD) + vsrc; LAS unsigned char* sl_ = ring + (slot) * 32768 + wave * 2048; \
        __builtin_amdgcn_global_load_lds((const unsigned*)(kp_ + ksrc[0]), (LAS unsigned*)(sl_), 16, 0, 0); \
        __builtin_amdgcn_global_load_lds((const unsigned*)(kp_ + ksrc[1]), (LAS unsigned*)(sl_ + 1024), 16, 0, 0); \
        __builtin_amdgcn_global_load_lds((const unsigned*)(vp_), (LAS unsigned*)(sl_ + 16384), 16, 0, 0); \
        __builtin_amdgcn_global_load_lds((const unsigned*)(vp_ + 512), (LAS unsigned*)(sl_ + 16384 + 1024), 16, 0, 0); } while (0)
    asm volatile("s_waitcnt vmcnt(0)" ::: "memory");
    ATTN_DMA(kt0, 0); ATTN_DMA(kt0 + 1, 1);
    const int kr0 = 8 * (c >> 2) + (c & 3);
    int slot = 0;
    for (int i = 0; i < nt; ++i) {
        asm volatile("s_waitcnt vmcnt(4)" ::: "memory");
        __builtin_amdgcn_s_barrier();
        asm volatile("" ::: "memory");
        { const int in = i + 2 < nt ? i + 2 : nt - 1; int sn = slot + 2; sn = sn >= 3 ? sn - 3 : sn; ATTN_DMA(kt0 + in, sn); }
        const int kt = kt0 + i;
        if (kt >= ci - 8 && kt <= ci) {
            const LAS unsigned char* ks_ = ring + slot * 32768; const LAS unsigned char* vs_ = ks_ + 16384;
#pragma unroll
            for (int st = 0; st < 2; ++st) {
                bf16x8 kf[2][4];
#pragma unroll
                for (int tau = 0; tau < 2; ++tau)
#pragma unroll
                    for (int ds = 0; ds < 4; ++ds) kf[tau][ds] = *(const LAS bf16x8*)(ks_ + (32 * st + kr0 + 4 * tau) * 256 + (((4 * ds + g) ^ c) << 4));
                f32x4 s[2][2];
#pragma unroll
                for (int qt = 0; qt < 2; ++qt)
#pragma unroll
                    for (int tau = 0; tau < 2; ++tau) { f32x4 a = (f32x4){0.f, 0.f, 0.f, 0.f};
#pragma unroll
                        for (int ds = 0; ds < 4; ++ds) a = __builtin_amdgcn_mfma_f32_16x16x32_bf16(kf[tau][ds], qf[qt][ds], a, 0, 0, 0);
                        s[qt][tau] = a; }
                bf16x8 vf[8];
#pragma unroll
                for (int dt = 0; dt < 8; ++dt) vf[dt] = *(const LAS bf16x8*)(vs_ + st * 8192 + (16 * dt + c) * 64 + g * 16);
                const int dstep = q0 - (64 * kt + 32 * st);
                const bool far = dstep - 31 >= 128;
                const float badd = far ? bfar : 0.f;
                if (!far) {
#pragma unroll
                    for (int qt = 0; qt < 2; ++qt)
#pragma unroll
                        for (int tau = 0; tau < 2; ++tau)
#pragma unroll
                            for (int e = 0; e < 4; ++e) { int rel = dstep + 16 * qt + c - (8 * g + 4 * tau + e); rel = rel < -128 ? -128 : (rel > 128 ? 128 : rel); s[qt][tau][e] += tabh[rel + 128]; }
                }
                bf16x8 pf[2];
#pragma unroll
                for (int qt = 0; qt < 2; ++qt) {
                    float mx = fmaxf(fmaxf(fmaxf(s[qt][0][0], s[qt][0][1]), fmaxf(s[qt][0][2], s[qt][0][3])), fmaxf(fmaxf(s[qt][1][0], s[qt][1][1]), fmaxf(s[qt][1][2], s[qt][1][3])));
                    mx = xrow16_max(mx) + badd;
                    const float mn = fmaxf(mrun[qt], mx), alpha = __builtin_amdgcn_exp2f(mrun[qt] - mn), coff = badd - mn;
                    const bool grew = __any(mn > mrun[qt]); mrun[qt] = mn;
                    f32x4 p0, p1;
#pragma unroll
                    for (int e = 0; e < 4; ++e) { p0[e] = __builtin_amdgcn_exp2f(s[qt][0][e] + coff); p1[e] = __builtin_amdgcn_exp2f(s[qt][1][e] + coff); }
                    if (grew) {
#pragma unroll
                        for (int dt = 0; dt < 8; ++dt) o[dt][qt] *= alpha;
                        ol[qt] *= alpha; }
                    u32x4 w; w.x = cvt_pk_bf16(p0[0], p0[1]); w.y = cvt_pk_bf16(p0[2], p0[3]); w.z = cvt_pk_bf16(p1[0], p1[1]); w.w = cvt_pk_bf16(p1[2], p1[3]);
                    pf[qt] = __builtin_bit_cast(bf16x8, w);
                }
#pragma unroll
                for (int dt = 0; dt < 8; ++dt)
#pragma unroll
                    for (int qt = 0; qt < 2; ++qt) o[dt][qt] = __builtin_amdgcn_mfma_f32_16x16x32_bf16(vf[dt], pf[qt], o[dt][qt], 0, 0, 0);
#pragma unroll
                for (int qt = 0; qt < 2; ++qt) ol[qt] = __builtin_amdgcn_mfma_f32_16x16x32_bf16(ones, pf[qt], ol[qt], 0, 0, 0);
            }
            asm volatile("s_waitcnt lgkmcnt(0)" ::: "memory");
        }
        slot = slot == 2 ? 0 : slot + 1;
    }
#undef ATTN_DMA
    bf16* Op = MIX + (size_t)(b * T + q0) * D + h * HD;
#pragma unroll
    for (int qt = 0; qt < 2; ++qt) {
        const float inv = 1.0f / ol[qt][0];
        bf16* op = Op + (unsigned)((16 * qt + c) * D + 4 * g);
#pragma unroll
        for (int dt = 0; dt < 8; ++dt) { const f32x4 v = o[dt][qt] * inv; u32x2 w; w.x = cvt_pk_bf16(v[0], v[1]); w.y = cvt_pk_bf16(v[2], v[3]); *(u32x2*)(op + 16 * dt) = w; }
    }
    asm volatile("s_waitcnt vmcnt(0)" ::: "memory");
    __builtin_amdgcn_s_barrier();
    asm volatile("" ::: "memory");
}
__device__ __forceinline__ void attn_phase(const Params& P, LAS unsigned char* lds, int tid, int wave, int lane) {
    LAS float* tab = (LAS float*)(lds + 98304);
    for (int i = tid; i < NH * 257; i += NWAVES * 64) { const int h = i / 257, r = i % 257; tab[h * 260 + r] = P.in[I_RELB][i] * LOG2E; }
    __syncthreads();
    const bf16* Q = (const bf16*)(P.ws + WS_Q); const bf16* K = (const bf16*)(P.ws + WS_K); const bf16* Kc = (const bf16*)(P.ws + WS_KC);
    const bf16* VtP = (const bf16*)(P.ws + WS_VTP); const bf16* VtS = (const bf16*)(P.ws + WS_VTS); bf16* MIX = (bf16*)(P.ws + WS_MIX);
    if (P.sub & 4) for (int u = blockIdx.x; u < NB * NH * 16; u += gridDim.x) {
        const int bh = u & 31, qb = u >> 5;
        attn_block_unit(Q, K, VtP, MIX, bh, qb, tab + (bh & 15) * 260, lds, wave, lane);
    }
    {
        unsigned* ctl = (unsigned*)(P.ws + WS_CTL);
        if (tid == 0) {
            unsigned sp = 0;
            while (__hip_atomic_load(ctl + CW_ARRIVE + 768, __ATOMIC_RELAXED, __HIP_MEMORY_SCOPE_AGENT) < gridDim.x) { __builtin_amdgcn_s_sleep(2);
                if ((++sp & 255u) == 0u) { if (__hip_atomic_load(ctl + CW_TMO2, __ATOMIC_RELAXED, __HIP_MEMORY_SCOPE_AGENT)) break; if (sp > (1u << 20)) { __hip_atomic_store(ctl + CW_TMO2, 1u, __ATOMIC_RELAXED, __HIP_MEMORY_SCOPE_AGENT); break; } } }
            __builtin_amdgcn_fence(__ATOMIC_ACQUIRE, "agent"); VM_WAIT();
        }
        __syncthreads();
    }
    if ((P.sub & 2) && wave == (int)(blockIdx.x & 7)) for (int su = blockIdx.x; su < SB * NH; su += gridDim.x) {
        const int b = su >> 4, h = su & 15; const size_t srow = (size_t)NPR * AW + (size_t)(b * NH + h) * ST * HD;
        attn_unit(Q + srow, Kc + (size_t)(b * NH + h) * CROWS * HD, K + srow, 17, 16, VtS + (size_t)(b * NH + h) * (KS_LD / 32) * HD * 32, 512, tab + h * 260, MIX + (size_t)(NPR + b * ST) * D + h * HD, lane);
    }
}
__device__ __forceinline__ float neg_expm1(float z, float ez) {
    float p = 1.0f + z * (1.0f / 7.0f); p = 1.0f + z * (1.0f / 6.0f) * p; p = 1.0f + z * 0.2f * p; p = 1.0f + z * 0.25f * p; p = 1.0f + z * (1.0f / 3.0f) * p; p = 1.0f + z * 0.5f * p;
    return z > -0.25f ? -z * p : 1.0f - ez;
}
template <int PASS> __device__ __forceinline__ void lru_unit(const Params& P, LAS unsigned char* lds, int unit, int tid, int wave, int lane) {
    int seq, chunk, n;
    if (unit < NB * 64 * 16) { n = unit & 15; chunk = (unit >> 4) & 63; seq = unit >> 10; } else { const int r = unit - NB * 64 * 16; n = r & 15; chunk = 0; seq = NB + (r >> 4); }
    const bool prompt = seq < NB; const int rows = prompt ? 64 : 32; const int m0 = prompt ? seq * T + chunk * 64 : NPR + (seq - NB) * ST;
    LAS float* XF = (LAS float*)lds;
    LAS bf16* XB = (LAS bf16*)(lds + 64 * 132 * 4);
    const float* XR = (const float*)(P.ws + WS_XR);
    const int c = lane & 15, g = lane >> 4, cw = wave * 16 + c, ch = n * 128 + cw;
    bf16x8 ba[4], bx[4];
    {
        const bf16* wp = (const bf16*)(P.ws + WS_WRG) + ((size_t)n * 256 + cw) * 128 + 8 * g;
#pragma unroll
        for (int ks = 0; ks < 4; ++ks) { ba[ks] = *(const bf16x8*)(wp + 32 * ks); bx[ks] = *(const bf16x8*)(wp + 128 * 128 + 32 * ks); }
    }
    const float bra = P.in[I_BRA][ch], brx = P.in[I_BRX][ch], lam = P.in[I_LAM][ch];
    float hin = 0.f;
    if (PASS == 2) {
        if (prompt) {
            const f32x2* ls = (const f32x2*)(P.ws + WS_LSUM) + (size_t)seq * 64 * LW + ch;
            f32x2 sm[16];
#pragma unroll
            for (int i = 0; i < 16; ++i) { const int ci = 16 * g + i; sm[i] = ci < chunk ? ls[(size_t)ci * LW] : (f32x2){1.f, 0.f}; }
            float Ag = 1.f, Hg = 0.f;
#pragma unroll
            for (int i = 0; i < 16; ++i) { Hg = sm[i][0] * Hg + sm[i][1]; Ag *= sm[i][0]; }
#pragma unroll
            for (int q = 0; q < 4; ++q) { const float Aq = __shfl(Ag, c + 16 * q), Hq = __shfl(Hg, c + 16 * q); hin = Aq * hin + Hq; }
        } else hin = P.in[I_SH][(seq - NB) * LW + ch];
    }
    {
        const int t = tid >> 3, cg = (tid & 7) * 16, col = n * 128 + cg;
        const bool live = t < rows;
        f32x4 xv[4][4], wv[4][4], xc[4];
#pragma unroll
        for (int i = 0; i < 4; ++i) { const int tt = t - 3 + i;
            const bool fromx = tt >= 0 || (prompt && chunk > 0), froms = !fromx && !prompt;
            const float* src = froms ? P.in[I_SCONV] + (size_t)((seq - NB) * 3 + 3 + tt) * LW : XR + (size_t)(m0 + ((fromx && live) ? tt : 0)) * LW;
            const float wsc = (live && (fromx || froms)) ? 1.f : 0.f;
#pragma unroll
            for (int q = 0; q < 4; ++q) { xv[i][q] = *(const f32x4*)(src + col + 4 * q); wv[i][q] = *(const f32x4*)(P.in[I_CONVW] + (size_t)i * LW + col + 4 * q) * wsc; } }
#pragma unroll
        for (int q = 0; q < 4; ++q) { xc[q] = live ? *(const f32x4*)(P.in[I_CONVB] + col + 4 * q) : (f32x4){0.f, 0.f, 0.f, 0.f};
#pragma unroll
            for (int i = 0; i < 4; ++i) xc[q] += wv[i][q] * xv[i][q]; }
#pragma unroll
        for (int q = 0; q < 4; ++q) *(LAS f32x4*)(XF + t * 132 + cg + 4 * q) = xc[q];
        u32x4 w0, w1; w0.x = cvt_pk_bf16(xc[0][0], xc[0][1]); w0.y = cvt_pk_bf16(xc[0][2], xc[0][3]); w0.z = cvt_pk_bf16(xc[1][0], xc[1][1]); w0.w = cvt_pk_bf16(xc[1][2], xc[1][3]);
        w1.x = cvt_pk_bf16(xc[2][0], xc[2][1]); w1.y = cvt_pk_bf16(xc[2][2], xc[2][3]); w1.z = cvt_pk_bf16(xc[3][0], xc[3][1]); w1.w = cvt_pk_bf16(xc[3][2], xc[3][3]);
        *(LAS u32x4*)(XB + t * 136 + cg) = w0; *(LAS u32x4*)(XB + t * 136 + cg + 8) = w1;
    }
    __syncthreads();
    f32x4 accA[4], accX[4];
#pragma unroll
    for (int mt = 0; mt < 4; ++mt) { accA[mt] = (f32x4){0.f, 0.f, 0.f, 0.f}; accX[mt] = (f32x4){0.f, 0.f, 0.f, 0.f};
#pragma unroll
        for (int ks = 0; ks < 4; ++ks) { const bf16x8 af = *(const LAS bf16x8*)(XB + (16 * mt + c) * 136 + 32 * ks + 8 * g);
            accA[mt] = __builtin_amdgcn_mfma_f32_16x16x32_bf16(af, ba[ks], accA[mt], 0, 0, 0); accX[mt] = __builtin_amdgcn_mfma_f32_16x16x32_bf16(af, bx[ks], accX[mt], 0, 0, 0); } }
    const float c8 = -8.0f * log1pf(__expf(-lam));
    float av[4][4], bv[4][4];
#pragma unroll
    for (int mt = 0; mt < 4; ++mt)
#pragma unroll
        for (int e = 0; e < 4; ++e) { const float r = fast_sigmoid(accA[mt][e] + bra), ig = fast_sigmoid(accX[mt][e] + brx), la = c8 * r;
            const float a = __builtin_amdgcn_exp2f(la * LOG2E); av[mt][e] = a; bv[mt][e] = __builtin_amdgcn_sqrtf(neg_expm1(2.0f * la, a * a)) * ig * XF[(16 * mt + 4 * g + e) * 132 + cw]; }
    if (PASS == 1) {
        float Am[4], Bm[4];
#pragma unroll
        for (int mt = 0; mt < 4; ++mt) { Am[mt] = av[mt][0] * av[mt][1] * av[mt][2] * av[mt][3]; Bm[mt] = ((bv[mt][0] * av[mt][1] + bv[mt][1]) * av[mt][2] + bv[mt][2]) * av[mt][3] + bv[mt][3]; }
#pragma unroll
        for (int mt = 0; mt < 4; ++mt) { const float Ao = __shfl_xor(Am[mt], 16), Bo = __shfl_xor(Bm[mt], 16);
            const float A1 = (g & 1) ? Ao : Am[mt], B1 = (g & 1) ? Bo : Bm[mt], A2 = (g & 1) ? Am[mt] : Ao, B2 = (g & 1) ? Bm[mt] : Bo; Am[mt] = A1 * A2; Bm[mt] = A2 * B1 + B2; }
#pragma unroll
        for (int mt = 0; mt < 4; ++mt) { const float Ao = __shfl_xor(Am[mt], 32), Bo = __shfl_xor(Bm[mt], 32);
            const float A1 = (g & 2) ? Ao : Am[mt], B1 = (g & 2) ? Bo : Bm[mt], A2 = (g & 2) ? Am[mt] : Ao, B2 = (g & 2) ? Bm[mt] : Bo; Am[mt] = A1 * A2; Bm[mt] = A2 * B1 + B2; }
        float at = Am[0], ht = Bm[0];
#pragma unroll
        for (int mt = 1; mt < 4; ++mt) { ht = Am[mt] * ht + Bm[mt]; at *= Am[mt]; }
        if (g == 0) ((f32x2*)(P.ws + WS_LSUM))[((size_t)seq * 64 + chunk) * LW + ch] = (f32x2){at, ht};
        f32x4* ab = (f32x4*)(P.ws + WS_AB) + ((size_t)unit * 8 + wave) * 512 + lane;
#pragma unroll
        for (int mt = 0; mt < 4; ++mt) { ab[mt * 64] = (f32x4){av[mt][0], av[mt][1], av[mt][2], av[mt][3]}; ab[(4 + mt) * 64] = (f32x4){bv[mt][0], bv[mt][1], bv[mt][2], bv[mt][3]}; }
        __syncthreads();
        return;
    }
    float atot = 1.f;
    const int lastmt = rows / 16 - 1;
#pragma unroll
    for (int mt = 0; mt < 4; ++mt) {
        float A = av[mt][0] * av[mt][1] * av[mt][2] * av[mt][3];
        float B = ((bv[mt][0] * av[mt][1] + bv[mt][1]) * av[mt][2] + bv[mt][2]) * av[mt][3] + bv[mt][3];
        { const float Ap = __shfl_up(A, 16), Bp = __shfl_up(B, 16); if (g >= 1) { B = A * Bp + B; A = A * Ap; } }
        { const float Ap = __shfl_up(A, 32), Bp = __shfl_up(B, 32); if (g >= 2) { B = A * Bp + B; A = A * Ap; } }
        const float hend = A * hin + B;
        const float hprev = __shfl_up(hend, 16);
        if (PASS == 2) {
            float h = g == 0 ? hin : hprev;
#pragma unroll
            for (int e = 0; e < 4; ++e) { h = av[mt][e] * h + bv[mt][e]; XF[(16 * mt + 4 * g + e) * 132 + cw] = h; }
            if (mt == lastmt && g == 3 && (!prompt || chunk == 63)) { if (prompt) P.out[O_HP + (size_t)seq * LW + ch] = h; else P.out[O_HS + (size_t)(seq - NB) * LW + ch] = h; }
        }
        hin = __shfl(hend, c + 48); atot *= __shfl(A, c + 48);
    }
    if (PASS == 1) {
        if (g == 0) ((f32x2*)(P.ws + WS_LSUM))[((size_t)seq * 64 + chunk) * LW + ch] = (f32x2){atot, hin};
        f32x4* ab = (f32x4*)(P.ws + WS_AB) + ((size_t)unit * 8 + wave) * 512 + lane;
#pragma unroll
        for (int mt = 0; mt < 4; ++mt) { ab[mt * 64] = (f32x4){av[mt][0], av[mt][1], av[mt][2], av[mt][3]}; ab[(4 + mt) * 64] = (f32x4){bv[mt][0], bv[mt][1], bv[mt][2], bv[mt][3]}; }
    }
    if (PASS == 2) {
        __syncthreads();
        const int t = tid >> 3, cg = (tid & 7) * 16;
        if (t < rows) {
            const bf16* gp = (const bf16*)(P.ws + WS_GG) + (size_t)(m0 + t) * LW + n * 128 + cg; bf16* op = (bf16*)(P.ws + WS_MIX) + (size_t)(m0 + t) * D + AW + n * 128 + cg;
#pragma unroll
            for (int q = 0; q < 2; ++q) { const u32x4 gw4 = *(const u32x4*)(gp + 8 * q); const f32x4 h0 = *(const LAS f32x4*)(XF + t * 132 + cg + 8 * q), h1 = *(const LAS f32x4*)(XF + t * 132 + cg + 8 * q + 4);
                u32x4 w;
                w.x = cvt_pk_bf16(h0[0] * gelu_tanh(__uint_as_float(gw4.x << 16)), h0[1] * gelu_tanh(__uint_as_float(gw4.x & 0xffff0000u))); w.y = cvt_pk_bf16(h0[2] * gelu_tanh(__uint_as_float(gw4.y << 16)), h0[3] * gelu_tanh(__uint_as_float(gw4.y & 0xffff0000u)));
                w.z = cvt_pk_bf16(h1[0] * gelu_tanh(__uint_as_float(gw4.z << 16)), h1[1] * gelu_tanh(__uint_as_float(gw4.z & 0xffff0000u))); w.w = cvt_pk_bf16(h1[2] * gelu_tanh(__uint_as_float(gw4.w << 16)), h1[3] * gelu_tanh(__uint_as_float(gw4.w & 0xffff0000u)));
                *(u32x4*)(op + 8 * q) = w; }
        }
    }
    __syncthreads();
}

__device__ __forceinline__ void lru_final_wave(const Params& P, int wu, int lane) {
    asm volatile("" : "+v"(lane));
    const int unit = wu >> 3, w = wu & 7, n = unit & 15, chunk = (unit >> 4) & 63, seq = unit >> 10;
    const int c = lane & 15, g = lane >> 4, cw = w * 16 + c, ch = n * 128 + cw, m0 = seq * T + chunk * 64;
    const f32x4* ab = (const f32x4*)(P.ws + WS_AB) + (size_t)wu * 512 + lane;
    f32x4 a4[4], b4[4];
#pragma unroll
    for (int mt = 0; mt < 4; ++mt) { a4[mt] = ab[mt * 64]; b4[mt] = ab[(4 + mt) * 64]; }
    const bf16* gp = (const bf16*)(P.ws + WS_GG) + (size_t)m0 * LW + ch;
    bf16 gg[4][4];
#pragma unroll
    for (int mt = 0; mt < 4; ++mt)
#pragma unroll
        for (int e = 0; e < 4; ++e) gg[mt][e] = gp[(size_t)(16 * mt + 4 * g + e) * LW];
    float hin = 0.f;
    {
        const f32x2* ls = (const f32x2*)(P.ws + WS_LSUM) + (size_t)seq * 64 * LW + ch;
        f32x2 sm[16];
#pragma unroll
        for (int i = 0; i < 16; ++i) { const int ci = 16 * g + i; sm[i] = ci < chunk ? ls[(size_t)ci * LW] : (f32x2){1.f, 0.f}; }
        float Ag = 1.f, Hg = 0.f;
#pragma unroll
        for (int i = 0; i < 16; ++i) { Hg = sm[i][0] * Hg + sm[i][1]; Ag *= sm[i][0]; }
#pragma unroll
        for (int q = 0; q < 4; ++q) { const float Aq = __shfl(Ag, c + 16 * q), Hq = __shfl(Hg, c + 16 * q); hin = Aq * hin + Hq; }
    }
    bf16* op = (bf16*)(P.ws + WS_MIX) + (size_t)m0 * D + AW + ch;
#pragma unroll
    for (int mt = 0; mt < 4; ++mt) {
        float A = a4[mt][0] * a4[mt][1] * a4[mt][2] * a4[mt][3];
        float B = ((b4[mt][0] * a4[mt][1] + b4[mt][1]) * a4[mt][2] + b4[mt][2]) * a4[mt][3] + b4[mt][3];
        { const float Ap = __shfl_up(A, 16), Bp = __shfl_up(B, 16); if (g >= 1) { B = A * Bp + B; A = A * Ap; } }
        { const float Ap = __shfl_up(A, 32), Bp = __shfl_up(B, 32); if (g >= 2) { B = A * Bp + B; A = A * Ap; } }
        const float hend = A * hin + B;
        const float hprev = __shfl_up(hend, 16);
        float h = g == 0 ? hin : hprev;
#pragma unroll
        for (int e = 0; e < 4; ++e) { h = a4[mt][e] * h + b4[mt][e]; op[(size_t)(16 * mt + 4 * g + e) * D] = (bf16)f2bf(h * gelu_tanh(__uint_as_float((unsigned)gg[mt][e] << 16))); }
        if (mt == 3 && g == 3 && chunk == 63) P.out[O_HP + (size_t)seq * LW + ch] = h;
        hin = __shfl(hend, c + 48);
    }
}
#ifndef MK_N_LAUNCHES
#define MK_N_LAUNCHES 1
#endif
constexpr int N_PHASES = 8;
constexpr int LRU1_IN_P2 = 1152;
#ifndef PG8_SP2
#define PG8_SP2 true
#endif
#ifndef PG8_ALIGN
#define PG8_ALIGN true
#endif
#ifdef PROBE_SAME
struct SameOrder { int ntf; __device__ bool next(int i, pg8::Unit& u) const { if (i >= 12) return false; u.pm = PROBE_SAME ? (int)(blockIdx.x & 7) : 0; u.pn = PROBE_SAME ? (int)((blockIdx.x >> 3) & 3) + 4 * (i & 1) : 0; u.kb = 0; u.nt = ntf; u.part = -1; return true; }
    __device__ __forceinline__ void a_ready(const pg8::Unit&) const {} __device__ __forceinline__ void done(const pg8::Unit&) const {} };
#endif
__global__ void __launch_bounds__(NWAVES * 64, 2) fwd(Params P) {
    extern __shared__ __attribute__((aligned(16))) unsigned char lds_raw[];
    LAS unsigned char* lds = (LAS unsigned char*)lds_raw;
    const int tid = threadIdx.x, lane = tid & 63, wave = __builtin_amdgcn_readfirstlane(tid >> 6);
    const int G = gridDim.x, gw = blockIdx.x * NWAVES + wave, NGW = G * NWAVES;
    volatile LAS unsigned* MISC = (volatile LAS unsigned*)(lds + MISC_OFF);
    if (tid < 32) MISC[tid] = 0u;
    __syncthreads();
    unsigned* ctl = (unsigned*)(P.ws + WS_CTL);
    XcdBarrier bar; bar.bar = ctl + CW_BAR; bar.x = 0; bar.st = nullptr;
    if (MK_N_LAUNCHES == 1) bar = xcd_barrier_post(ctl + CW_BAR, MISC + 8);
    const int lo = P.ph_lo, hi = P.ph_hi;
#ifndef PHASE_MASK
#define PHASE_MASK 0xff
#endif
#define IN(k) (((PHASE_MASK >> (k)) & 1) && lo <= (k) && (k) < hi)
#define SEAM(k) do { if (IN(k) && IN((k) + 1)) xcd_barrier(bar); } while (0)
    unsigned char* ws = P.ws;
    float* mod = (float*)(ws + WS_MOD);
    bf16* U = (bf16*)(ws + WS_U);

#ifdef PROBE_NT
    if (lo == 9) {
        pg8::Gemm g{U, (const bf16*)(ws + WS_WGU), NTOK, 2 * DFF, D};
#ifdef PROBE_SAME
        SameOrder S; S.ntf = PROBE_NT;
        EpiGlu<0> E{(bf16*)(ws + WS_END), 1.0f, nullptr, nullptr};
#ifndef PROBE_VAR
#define PROBE_VAR 0
#endif
        pg8::gemm_phase<EpiGlu<0>, SameOrder, PG8_ALIGN, PG8_SP2, PROBE_VAR>(lds, g, S, E);
#else
        pg8::StaticOrder S; S.init(NTOK, 2 * DFF, D, G, (int)blockIdx.x); S.ntf = PROBE_NT;
        EpiGlu<0> E{(bf16*)(ws + WS_END), 1.0f, nullptr, nullptr};
        pg8::gemm_phase<EpiGlu<0>, pg8::StaticOrder, PG8_ALIGN, PG8_SP2>(lds, g, S, E);
#endif
    }
#endif
    if (IN(0)) {
        p0_amax(P, gw, NGW, lane);
        VM_WAIT(); __syncthreads();
        if (tid == 0) { __builtin_amdgcn_fence(__ATOMIC_RELEASE, "agent"); VM_WAIT(); __hip_atomic_fetch_add(ctl + CW_ARRIVE + 896, 1u, __ATOMIC_RELAXED, __HIP_MEMORY_SCOPE_AGENT); }
        if (P.sub & 16) p0_mod(P, lds, tid, wave, lane);
        VM_WAIT(); __syncthreads();
        if (tid == 0) { __builtin_amdgcn_fence(__ATOMIC_RELEASE, "agent"); VM_WAIT(); __hip_atomic_fetch_add(ctl + CW_ARRIVE + 512, 1u, __ATOMIC_RELAXED, __HIP_MEMORY_SCOPE_AGENT); }
        if (P.sub & 32) p0_convert(P, lds, gw, NGW, wave, lane);
    }
    if (IN(1)) {
        if (tid == 0) {
            unsigned sp = 0;
            while (__hip_atomic_load(ctl + CW_ARRIVE + 512, __ATOMIC_RELAXED, __HIP_MEMORY_SCOPE_AGENT) < (unsigned)G) { __builtin_amdgcn_s_sleep(2);
                if ((++sp & 255u) == 0u) { if (__hip_atomic_load(ctl + CW_TMO2, __ATOMIC_RELAXED, __HIP_MEMORY_SCOPE_AGENT)) break; if (sp > (1u << 20)) { __hip_atomic_store(ctl + CW_TMO2, 1u, __ATOMIC_RELAXED, __HIP_MEMORY_SCOPE_AGENT); break; } } }
            __builtin_amdgcn_fence(__ATOMIC_ACQUIRE, "agent"); VM_WAIT();
        }
        __syncthreads();
        norm_sample_split<false, 3>(P, lds, P.in[I_XS], P.in[I_G1], mod, 0 * D, 1 * D, U, nullptr, nullptr, wave, lane, (float*)(ws + WS_CTL + WS_SU1), ws + WS_U8);
        norm_rows<false, 3>(P.in[I_XP], P.in[I_XS], P.in[I_G1], mod, 0 * D, 1 * D, U, nullptr, nullptr, NPR, gw, NGW, lane, (float*)(ws + WS_CTL + WS_SU1), ws + WS_U8);
    }
    SEAM(1);
    if (IN(2)) {
        pg8::Gemm g{U, (const bf16*)(ws + WS_WIN), NTOK, INC, D};
        EpiIn<0> E{(bf16*)(ws + WS_Q), (bf16*)(ws + WS_K), (bf16*)(ws + WS_VTP), (bf16*)(ws + WS_VTS), (float*)(ws + WS_XR), (bf16*)(ws + WS_GG), P.out, P.in[I_QG], P.in[I_KG], (LAS float*)(lds + XCH_OFF), nullptr, nullptr};
        { XrOrder S; S.init(G, (int)blockIdx.x); pg8::gemm_phase<EpiIn<0>, XrOrder, PG8_ALIGN, PG8_SP2>(lds, g, S, E); }
        VM_WAIT(); __syncthreads();
        if (tid == 0) { __builtin_amdgcn_fence(__ATOMIC_RELEASE, "agent"); VM_WAIT(); __hip_atomic_fetch_add(ctl + CW_ARRIVE, 1u, __ATOMIC_RELAXED, __HIP_MEMORY_SCOPE_AGENT); }
        { B2Order S; S.init(G, (int)blockIdx.x); pg8::gemm_phase<EpiIn<0>, B2Order, PG8_ALIGN, PG8_SP2>(lds, g, S, E); }
        if (tid == 0) {
            unsigned sp = 0;
            while (__hip_atomic_load(ctl + CW_ARRIVE, __ATOMIC_RELAXED, __HIP_MEMORY_SCOPE_AGENT) < (unsigned)G) { __builtin_amdgcn_s_sleep(2);
                if ((++sp & 255u) == 0u) { if (__hip_atomic_load(ctl + CW_TMO2, __ATOMIC_RELAXED, __HIP_MEMORY_SCOPE_AGENT)) break; if (sp > (1u << 20)) { __hip_atomic_store(ctl + CW_TMO2, 1u, __ATOMIC_RELAXED, __HIP_MEMORY_SCOPE_AGENT); break; } } }
            __builtin_amdgcn_fence(__ATOMIC_ACQUIRE, "agent"); VM_WAIT();
        }
        __syncthreads();
        if (P.sub & 1) {
            unsigned nextu = 0; if (tid == 0) nextu = __hip_atomic_fetch_add(ctl + CW_LQ, 1u, __ATOMIC_RELAXED, __HIP_MEMORY_SCOPE_AGENT);
            for (;;) {
                if (tid == 0) MISC[16] = nextu;
                __syncthreads();
                const int u = (int)MISC[16];
                if (u >= LRU1_IN_P2) break;
                if (tid == 0) nextu = __hip_atomic_fetch_add(ctl + CW_LQ, 1u, __ATOMIC_RELAXED, __HIP_MEMORY_SCOPE_AGENT);
                lru_unit<1>(P, lds, u, tid, wave, lane);
            }
        }
        { pg8::Gemm g8{(const bf16*)(ws + WS_U8), (const bf16*)(ws + WS_WIN8), NTOK, INC, D / 2}; I8Order S8; S8.init(G, (int)blockIdx.x);
          EpiIn<2> E8{(bf16*)(ws + WS_Q), (bf16*)(ws + WS_K), (bf16*)(ws + WS_VTP), (bf16*)(ws + WS_VTS), (float*)(ws + WS_XR), (bf16*)(ws + WS_GG), P.out, P.in[I_QG], P.in[I_KG], (LAS float*)(lds + XCH_OFF),
                      (const float*)(ws + WS_CTL + WS_SU1), (const float*)(ws + WS_CTL + WS_AMAX1)};
          pg8::gemm_phase<EpiIn<2>, I8Order, PG8_ALIGN, PG8_SP2, 0, 2>(lds, g8, S8, E8); }
    }
    SEAM(2);
    if (IN(3)) {
        if (P.sub & 1) for (int u = LRU1_IN_P2 + (int)blockIdx.x; u < NB * 64 * 16; u += G) lru_unit<1>(P, lds, u, tid, wave, lane);
        VM_WAIT(); __syncthreads();
        if (tid == 0) { __builtin_amdgcn_fence(__ATOMIC_RELEASE, "agent"); VM_WAIT(); __hip_atomic_fetch_add(ctl + CW_ARRIVE + 768, 1u, __ATOMIC_RELAXED, __HIP_MEMORY_SCOPE_AGENT); }
        attn_phase(P, lds, tid, wave, lane);
        if (P.sub & 8) {
            constexpr int NWU = NB * 64 * 16 * 8; const int per = (NWU + G - 1) / G, w0 = (int)blockIdx.x * per, w1 = w0 + per < NWU ? w0 + per : NWU;
            for (;;) {
                int idx = 0; if (lane == 0) idx = (int)__hip_atomic_fetch_add((LAS unsigned*)(lds + MISC_OFF) + 17, 1u, __ATOMIC_RELAXED, __HIP_MEMORY_SCOPE_WORKGROUP);
                idx = __builtin_amdgcn_readfirstlane(idx);
                if (w0 + idx >= w1) break;
                lru_final_wave(P, w0 + idx, lane);
            }
        }
        __syncthreads();
        if (P.sub & 8) for (int u = NB * 64 * 16 + blockIdx.x; u < NB * 64 * 16 + SB * 16; u += G) lru_unit<2>(P, lds, u, tid, wave, lane);
    }
    SEAM(3);
    if (IN(4)) {
        pg8::Gemm g{(const bf16*)(ws + WS_MIX), (const bf16*)(ws + WS_WOUT), NTOK, D, D}; SplitOrder S; S.init(D, G, (int)blockIdx.x);
        EpiRes<false, true> E{P.in[I_XP], ws + WS_X1, mod + 2 * D, (float*)(ws + WS_SLAB), (P.sub >> 6) & 1, 1.0f};
        pg8::gemm_phase<EpiRes<false, true>, SplitOrder, PG8_ALIGN, PG8_SP2>(lds, g, S, E);
    }
    SEAM(4);
    if (IN(5)) {
        norm_sample_split<true, 2>(P, lds, P.in[I_XS], P.in[I_G2], mod, 3 * D, 4 * D, U, (const float*)(ws + WS_SLAB), (float*)(ws + WS_X1) + (size_t)NPR * D, wave, lane, (float*)(ws + WS_CTL + WS_SU));
        norm_rows<true, 2>((const float*)(ws + WS_X1), P.in[I_XS], P.in[I_G2], mod, 3 * D, 4 * D, U, nullptr, nullptr, NPR, gw, NGW, lane, (float*)(ws + WS_CTL + WS_SU));
    }
    SEAM(5);
    if (IN(6)) {
        pg8::Gemm g{U, (const bf16*)(ws + WS_WGU), NTOK, 2 * DFF, D / 2}; GluOrder S; S.init(D / 2, G, (int)blockIdx.x); S.mode = 1;
        EpiGlu<2> E{(bf16*)(ws + WS_H), 1.0f, (const float*)(ws + WS_CTL + WS_SU), (const float*)(ws + WS_CTL + WS_AMAX)};
        pg8::gemm_phase<EpiGlu<2>, GluOrder, PG8_ALIGN, PG8_SP2, 0, 2>(lds, g, S, E);
        VM_WAIT(); __syncthreads();
        if (tid == 0) { __builtin_amdgcn_fence(__ATOMIC_RELEASE, "agent"); VM_WAIT(); __hip_atomic_fetch_add(ctl + CW_ARRIVE + 256, 1u, __ATOMIC_RELAXED, __HIP_MEMORY_SCOPE_AGENT); }
        S.mode = 0;
        pg8::gemm_phase<EpiGlu<2>, GluOrder, PG8_ALIGN, PG8_SP2, 0, 2>(lds, g, S, E);
        if (tid == 0) {
            unsigned sp = 0;
            while (__hip_atomic_load(ctl + CW_ARRIVE + 256, __ATOMIC_RELAXED, __HIP_MEMORY_SCOPE_AGENT) < (unsigned)G) { __builtin_amdgcn_s_sleep(2);
                if ((++sp & 255u) == 0u) { if (__hip_atomic_load(ctl + CW_TMO2, __ATOMIC_RELAXED, __HIP_MEMORY_SCOPE_AGENT)) break; if (sp > (1u << 20)) { __hip_atomic_store(ctl + CW_TMO2, 1u, __ATOMIC_RELAXED, __HIP_MEMORY_SCOPE_AGENT); break; } } }
            __builtin_amdgcn_fence(__ATOMIC_ACQUIRE, "agent"); VM_WAIT();
        }
        __syncthreads();
        constexpr int KD = F8_DOWN ? DFF / 2 : DFF;
        pg8::Gemm g2{(const bf16*)(ws + WS_H), (const bf16*)(ws + WS_WD), NTOK, D, KD}; TailSplit S2; S2.init(KD, G, (int)blockIdx.x);
        EpiRes<true, false> E2{ws + WS_X1, P.out + O_Y, mod + 5 * D, (float*)(ws + WS_SLAB), 0, F8_DOWN ? W8_INV : 1.0f};
        pg8::gemm_phase<EpiRes<true, false>, TailSplit, PG8_ALIGN, PG8_SP2, 0, F8_DOWN ? 1 : 0>(lds, g2, S2, E2);
    }
    SEAM(6);
    if (IN(7)) {
        {
            const float* slab = (const float*)(ws + WS_SLAB); const float* x1s = (const float*)(ws + WS_X1) + (size_t)NPR * D; float* ys = P.out + O_Y + (size_t)NPR * D;
            for (int t = gw; t < NSA * 4; t += NGW) {
                const int r = t >> 2, col0 = 1024 * (t & 3);
                f32x4 v[4];
#pragma unroll
                for (int j = 0; j < 4; ++j) v[j] = *(const f32x4*)(x1s + (size_t)r * D + col0 + 4 * (lane + 64 * j));
#pragma unroll
                for (int q = 0; q < 8; ++q)
#pragma unroll
                    for (int j = 0; j < 4; ++j) v[j] += *(const f32x4*)(slab + ((size_t)q * NSA + r) * D + col0 + 4 * (lane + 64 * j));
#pragma unroll
                for (int j = 0; j < 4; ++j) *(f32x4*)(ys + (size_t)r * D + col0 + 4 * (lane + 64 * j)) = v[j];
            }
        }
        constexpr int KD = F8_DOWN ? DFF / 2 : DFF;
        pg8::Gemm g{(const bf16*)(ws + WS_H), (const bf16*)(ws + WS_WD), NTOK, D, KD}; pg8::StaticOrder S; S.init(NPR, D, KD, G, (int)blockIdx.x);
        EpiRes<true, false> E{ws + WS_X1, P.out + O_Y, mod + 5 * D, (float*)(ws + WS_SLAB), (P.sub >> 6) & 1, F8_DOWN ? W8_INV : 1.0f};
        pg8::gemm_phase<EpiRes<true, false>, pg8::StaticOrder, PG8_ALIGN, PG8_SP2, 0, F8_DOWN ? 1 : 0>(lds, g, S, E);
    }
#undef IN
#undef SEAM
}

extern "C" void kernel_launch(void* const* d_in, const int* in_sizes, int n_in, void* d_out, int out_size, void* d_ws, size_t ws_size, hipStream_t stream) {
    static int grid = 0;
    if (grid == 0) {
        if (n_in != 27 || in_sizes[0] != NPR * D || out_size != (int)O_END || ws_size < WS_END2) {
            fprintf(stderr, "kernel_launch: built for 27 inputs, x_prompt of %d floats, %zu outputs, >= %zu bytes of workspace; got n_in %d, in0 %d, out %d, ws %zu; nothing launched\n", NPR * D, (size_t)O_END, (size_t)WS_END2, n_in, n_in > 0 ? in_sizes[0] : -1, out_size, ws_size);
            grid = -1; return; }
        int dev = 0, cus = 0, per_cu = 0;
        if (hipGetDevice(&dev) != hipSuccess || hipDeviceGetAttribute(&cus, hipDeviceAttributeMultiprocessorCount, dev) != hipSuccess) { fprintf(stderr, "kernel_launch: device query failed\n"); grid = -1; return; }
        if (hipFuncSetAttribute((const void*)fwd, hipFuncAttributeMaxDynamicSharedMemorySize, LDS_BYTES) != hipSuccess) { fprintf(stderr, "kernel_launch: hipFuncSetAttribute failed\n"); grid = -1; return; }
        if (hipOccupancyMaxActiveBlocksPerMultiprocessor(&per_cu, (const void*)fwd, NWAVES * 64, LDS_BYTES) != hipSuccess || per_cu < 1)
            fprintf(stderr, "kernel_launch: note: occupancy query reports %d workgroups per CU\n", per_cu);
        (void)hipGetLastError();
        grid = cus;
    }
    if (grid < 0) return;
    if (hipMemsetAsync((char*)d_ws + WS_CTL, 0, CTL_ZERO_BYTES, stream) != hipSuccess) { fprintf(stderr, "kernel_launch: hipMemsetAsync failed\n"); return; }
    Params p{};
    for (int i = 0; i < 27; ++i) p.in[i] = (const float*)d_in[i];
    p.out = (float*)d_out; p.ws = (unsigned char*)d_ws; p.sub = 63;
#ifdef PROBE_PREFIX
    p.ph_lo = 0; p.ph_hi = PROBE_PREFIX;
#ifdef PROBE_SUB
    p.sub = PROBE_SUB;
#endif
    hipLaunchKernelGGL(fwd, dim3(grid), dim3(NWAVES * 64), LDS_BYTES, stream, p);
    (void)hipMemsetAsync((char*)d_ws + WS_CTL, 0, CTL_ZERO_BYTES, stream);
    p.sub = 63;
#endif
    for (int li = 0; li < MK_N_LAUNCHES; ++li) {
        p.ph_lo = (MK_N_LAUNCHES == 1) ? 0 : li; p.ph_hi = (MK_N_LAUNCHES == 1) ? N_PHASES : li + 1;
        hipLaunchKernelGGL(fwd, dim3(grid), dim3(NWAVES * 64), LDS_BYTES, stream, p);
        const hipError_t le = hipPeekAtLastError();
        if (le != hipSuccess) { fprintf(stderr, "kernel_launch: launch %d failed: %s\n", li, hipGetErrorName(le)); break; }
    }
#ifdef PROBE_PHASE
    p.ph_lo = PROBE_PHASE; p.ph_hi = PROBE_PHASE + 1;
#ifdef PROBE_SUB
    p.sub = PROBE_SUB;
#endif
    hipLaunchKernelGGL(fwd, dim3(grid), dim3(NWAVES * 64), LDS_BYTES, stream, p);
#endif
}
```

```cpp
#include <hip/hip_runtime.h>
#include <cstdio>
#include <cstdint>
namespace pg8 {
#define PG8_LAS __attribute__((address_space(3)))
typedef unsigned short bf16_t;
typedef short bf16x8 __attribute__((ext_vector_type(8)));
typedef float f32x4 __attribute__((ext_vector_type(4)));
typedef unsigned u32x4 __attribute__((ext_vector_type(4)));
typedef int i32x4 __attribute__((ext_vector_type(4)));
typedef int i32x8 __attribute__((ext_vector_type(8)));
constexpr int BM = 256, BK = 64, HALF = 128, HTB = HALF * BK * 2  , STAGE_BYTES = 8 * HTB, NXCD = 8, WGM = 8;

__host__ __device__ __forceinline__ int lds_byte(int r, int c) { const int st = (r >> 4) * 2 + (c >> 5), rr = r & 15, cc = c & 31, ob = rr * 64 + cc * 2; return st * 1024 + (ob ^ (((ob >> 9) & 1) << 5)); }
__host__ __device__ __forceinline__ void stage_rc(int b, int& R, int& C) { const int st = b / 1024, sb = b % 1024, swz = sb ^ (((sb >> 9) & 1) << 5); R = (st >> 1) * 16 + swz / 64; C = (st & 1) * 32 + (swz % 64) / 2; }
__host__ __device__ __forceinline__ int perm32(int rho) { const int n = rho >> 4, i = rho & 15; return 8 * (i >> 2) + 4 * n + (i & 3); }

struct Unit { int pm, pn, kb, nt, part; };
struct Gemm { const bf16_t* A; const bf16_t* Bt; int M, N, K; };

struct StaticOrder {
    int nM, nN, nwg, G, c, ntf;
    __host__ __device__ void init(int M, int N, int K, int G_, int c_) { nM = M / BM; nN = N / BM; nwg = nM * nN; G = G_; c = c_; ntf = K / BK; }
    __host__ __device__ bool next(int i, Unit& u) const {
        const long L = (long)i * G + c; if (L >= nwg) return false;
        int wgid = (int)L; { const int q = nwg / NXCD, r = nwg % NXCD, xcd = wgid % NXCD, off = wgid / NXCD; wgid = (xcd < r ? xcd * (q + 1) : r * (q + 1) + (xcd - r) * q) + off; }
        const int nig = WGM * nN, gid = wgid / nig, fm = gid * WGM, gsz = (nM - fm) < WGM ? (nM - fm) : WGM;
        u.pm = fm + ((wgid % nig) % gsz); u.pn = (wgid % nig) / gsz; u.kb = 0; u.nt = ntf; u.part = -1; return true;
    }
    __device__ __forceinline__ void a_ready(const Unit&) const {}
    __device__ __forceinline__ void done(const Unit&) const {}
};
__device__ __forceinline__ unsigned cvt_pk_bf16(float lo, float hi) { unsigned r; asm volatile("v_cvt_pk_bf16_f32 %0, %1, %2" : "=v"(r) : "v"(lo), "v"(hi)); return r; }
typedef float f32x2 __attribute__((ext_vector_type(2)));
#ifndef F8_DOWN
#define F8_DOWN true
#endif
constexpr float W8_SCALE = 512.f, W8_INV = 1.f / 512.f;
__device__ __forceinline__ unsigned pk4_fp8(float a, float b, float c, float d) {
    a = __builtin_amdgcn_fmed3f(a, -448.f, 448.f); b = __builtin_amdgcn_fmed3f(b, -448.f, 448.f); c = __builtin_amdgcn_fmed3f(c, -448.f, 448.f); d = __builtin_amdgcn_fmed3f(d, -448.f, 448.f);
    int w = __builtin_amdgcn_cvt_pk_fp8_f32(a, b, 0, false); w = __builtin_amdgcn_cvt_pk_fp8_f32(c, d, w, true); return (unsigned)w; }
__device__ __forceinline__ unsigned pk4_i8(float a, float b, float c, float d, float inv) {
    const unsigned ua = __builtin_bit_cast(unsigned, __builtin_fmaf(a, inv, 12582912.f)), ub = __builtin_bit_cast(unsigned, __builtin_fmaf(b, inv, 12582912.f)),
                   uc = __builtin_bit_cast(unsigned, __builtin_fmaf(c, inv, 12582912.f)), ud = __builtin_bit_cast(unsigned, __builtin_fmaf(d, inv, 12582912.f));
    return (ua & 0xffu) | ((ub & 0xffu) << 8) | ((uc & 0xffu) << 16) | (ud << 24); }
#ifndef PG8_KOUTER
#define PG8_KOUTER 1
#endif
template <class Epi, class Sched, bool ALIGN_EPI = false, bool SP2 = false, int VAR = 0, int QM = 0>
__device__ __forceinline__ void gemm_phase(PG8_LAS unsigned char* lds, const Gemm g, const Sched& S, const Epi& E) {
    const int tid = threadIdx.x, wid = __builtin_amdgcn_readfirstlane(tid >> 6), lane = tid & 63, wr = wid >> 2, wc = wid & 3, fr = lane & 15, fq = lane >> 4;
    const int K = g.K; int nt;
    unsigned voffA[2], voffB[2];
#pragma unroll
    for (int i = 0; i < 2; ++i) { int R, C; stage_rc(tid * 16 + i * 8192, R, C); const int Rb = Epi::PERM ? ((R & ~31) + perm32(R & 31)) : R;
        voffA[i] = (unsigned)(R * K + C) * 2u; voffB[i] = (unsigned)(Rb * K + C) * 2u; }
    const size_t kstep = (size_t)(BK * 2);
    const size_t hstep = (size_t)HALF * K * 2;
    const size_t tstep = 2 * hstep;
    const unsigned ldsw = (unsigned)wid * 1024u;
    const int aoff = lds_byte(wr * 64 + fr, fq * 8), boff = lds_byte(wc * 32 + fr, fq * 8);
#define PG8_SA(b, h) (((b) * 2 + (h)) * HTB)
#define PG8_SB(b, h) ((4 + (b) * 2 + (h)) * HTB)
#define PG8_STAGE(bufoff, gbase, voff) do { if constexpr (VAR != 3) { _Pragma("unroll") for (int _i = 0; _i < 2; ++_i) \
        __builtin_amdgcn_global_load_lds((const unsigned*)((const char*)(gbase) + (voff)[_i]), (PG8_LAS unsigned*)(lds + (bufoff) + ldsw + _i * 8192), 16, 0, 0); } } while (0)
#define PG8_LDA(dst, b, h) do { if constexpr (VAR != 2) _Pragma("unroll") for (int m = 0; m < 4; ++m) _Pragma("unroll") for (int k = 0; k < 2; ++k) dst[m][k] = *(const PG8_LAS bf16x8*)(lds + PG8_SA(b, h) + aoff + m * 2048 + k * 1024); } while (0)
#define PG8_LDB(dst, b, h) do { if constexpr (VAR != 2) _Pragma("unroll") for (int n = 0; n < 2; ++n) _Pragma("unroll") for (int k = 0; k < 2; ++k) dst[n][k] = *(const PG8_LAS bf16x8*)(lds + PG8_SB(b, h) + boff + n * 2048 + k * 1024); } while (0)
#define PG8_MMA(ai, bj, At, Bt) do { if constexpr (VAR != 5) __builtin_amdgcn_s_setprio(1); \
        if constexpr (QM == 2) { _Pragma("unroll") for (int k = 0; k < 2; ++k) _Pragma("unroll") for (int m = 0; m < 4; ++m) _Pragma("unroll") for (int n = 0; n < 2; ++n) \
            acc[ai][bj][m][n] = __builtin_bit_cast(f32x4, __builtin_amdgcn_mfma_i32_16x16x64_i8(__builtin_bit_cast(i32x4, Bt[n][k]), __builtin_bit_cast(i32x4, At[m][k]), __builtin_bit_cast(i32x4, acc[ai][bj][m][n]), 0, 0, 0)); } \
        else if constexpr (QM == 1) { _Pragma("unroll") for (int m = 0; m < 4; ++m) _Pragma("unroll") for (int n = 0; n < 2; ++n) \
            asm volatile("v_mfma_f32_16x16x128_f8f6f4 %0, %1, %2, %0" : "+v"(acc[ai][bj][m][n]) : "v"(__builtin_shufflevector(__builtin_bit_cast(i32x4, Bt[n][0]), __builtin_bit_cast(i32x4, Bt[n][1]), 0, 1, 2, 3, 4, 5, 6, 7)), \
                "v"(__builtin_shufflevector(__builtin_bit_cast(i32x4, At[m][0]), __builtin_bit_cast(i32x4, At[m][1]), 0, 1, 2, 3, 4, 5, 6, 7))); } \
        else if constexpr (VAR == 4 || (VAR == 0 && PG8_KOUTER)) { _Pragma("unroll") for (int k = 0; k < 2; ++k) _Pragma("unroll") for (int m = 0; m < 4; ++m) _Pragma("unroll") for (int n = 0; n < 2; ++n) \
            acc[ai][bj][m][n] = __builtin_amdgcn_mfma_f32_16x16x32_bf16(Bt[n][k], At[m][k], acc[ai][bj][m][n], 0, 0, 0); } \
        else { _Pragma("unroll") for (int m = 0; m < 4; ++m) _Pragma("unroll") for (int n = 0; n < 2; ++n) _Pragma("unroll") for (int k = 0; k < (VAR == 1 ? 1 : 2); ++k) \
            acc[ai][bj][m][n] = __builtin_amdgcn_mfma_f32_16x16x32_bf16(Bt[n][k], At[m][k], acc[ai][bj][m][n], 0, 0, 0); } \
        if constexpr (VAR != 5) __builtin_amdgcn_s_setprio(0); } while (0)
#define PG8_WAIT_V(n) asm volatile("s_waitcnt vmcnt(" #n ")" ::: "memory")
#define PG8_WAIT_L(n) asm volatile("s_waitcnt lgkmcnt(" #n ")" ::: "memory")
#define PG8_BAR __builtin_amdgcn_s_barrier()
#define PG8_SCHED __builtin_amdgcn_sched_barrier(0)
    Unit cur, nxt; int ui = 0;
    if (!S.next(0, cur)) return;
    nt = cur.nt;
    f32x4 acc[2][2][4][2];
#pragma unroll
    for (int a = 0; a < 2; ++a)
#pragma unroll
        for (int b = 0; b < 2; ++b)
#pragma unroll
            for (int m = 0; m < 4; ++m)
#pragma unroll
                for (int n = 0; n < 2; ++n) acc[a][b][m][n] = (f32x4){0.f, 0.f, 0.f, 0.f};
    bf16x8 At[4][2], B0[2][2], B1[2][2];
    const char* cA = (const char*)g.A + (size_t)cur.pm * tstep + (size_t)cur.kb * kstep; const char* cB = (const char*)g.Bt + (size_t)cur.pn * tstep + (size_t)cur.kb * kstep;
    S.a_ready(cur);
    if constexpr (SP2) {
        PG8_STAGE(PG8_SB(0, 0), cB, voffB); PG8_STAGE(PG8_SB(0, 1), cB + hstep, voffB); PG8_STAGE(PG8_SA(0, 0), cA, voffA); PG8_STAGE(PG8_SA(0, 1), cA + hstep, voffA);
        if (wr == 1) PG8_BAR;
        PG8_WAIT_V(2); PG8_BAR;
        PG8_STAGE(PG8_SB(1, 0), cB + kstep, voffB); PG8_STAGE(PG8_SA(1, 0), cA + kstep, voffA); PG8_STAGE(PG8_SB(1, 1), cB + hstep + kstep, voffB);
        PG8_WAIT_V(6); PG8_BAR;
    } else {
        PG8_STAGE(PG8_SB(0, 0), cB, voffB); PG8_STAGE(PG8_SA(0, 0), cA, voffA); PG8_STAGE(PG8_SB(0, 1), cB + hstep, voffB); PG8_STAGE(PG8_SA(0, 1), cA + hstep, voffA);
        if (wr == 1) PG8_BAR;
        PG8_WAIT_V(4); PG8_BAR;
        PG8_STAGE(PG8_SB(1, 0), cB + kstep, voffB); PG8_STAGE(PG8_SA(1, 0), cA + kstep, voffA); PG8_STAGE(PG8_SB(1, 1), cB + hstep + kstep, voffB);
        PG8_WAIT_V(6); PG8_BAR;
    }
    for (;;) {
        const bool has_next = S.next(ui + 1, nxt);
        const char* nA = has_next ? (const char*)g.A + (size_t)nxt.pm * tstep + (size_t)nxt.kb * kstep : cA; const char* nB = has_next ? (const char*)g.Bt + (size_t)nxt.pn * tstep + (size_t)nxt.kb * kstep : cB;
        for (int t = 0; t < nt; t += 2) {
            const bool last = (t == nt - 2);
            const char* a1 = cA + (size_t)(t + 1) * kstep;
            const char* a2 = last ? nA : cA + (size_t)(t + 2) * kstep; const char* b2 = last ? nB : cB + (size_t)(t + 2) * kstep;
            const char* a3 = a2 + kstep; const char* b3 = b2 + kstep;
            if (last && has_next) S.a_ready(nxt);
            if constexpr (SP2) {
            PG8_LDB(B0, 0, 0); PG8_LDB(B1, 0, 1); PG8_SCHED; PG8_LDA(At, 0, 0); PG8_STAGE(PG8_SA(1, 1), a1 + hstep, voffA);
            PG8_WAIT_V(8); PG8_WAIT_L(0); PG8_BAR; PG8_MMA(0, 0, At, B0); PG8_MMA(0, 1, At, B1); PG8_BAR; PG8_SCHED;
            PG8_LDA(At, 0, 1); PG8_STAGE(PG8_SB(0, 0), b2, voffB); PG8_STAGE(PG8_SB(0, 1), b2 + hstep, voffB); PG8_STAGE(PG8_SA(0, 0), a2, voffA);
            PG8_WAIT_V(8); PG8_WAIT_L(0); PG8_BAR; PG8_MMA(1, 0, At, B0); PG8_MMA(1, 1, At, B1); PG8_BAR; PG8_SCHED;
            PG8_LDB(B0, 1, 0); PG8_LDB(B1, 1, 1); PG8_SCHED; PG8_LDA(At, 1, 0); PG8_STAGE(PG8_SA(0, 1), a2 + hstep, voffA);
            PG8_WAIT_V(8); PG8_WAIT_L(0); PG8_BAR; PG8_MMA(0, 0, At, B0); PG8_MMA(0, 1, At, B1); PG8_BAR; PG8_SCHED;
            PG8_LDA(At, 1, 1); PG8_STAGE(PG8_SB(1, 0), b3, voffB); PG8_STAGE(PG8_SB(1, 1), b3 + hstep, voffB); PG8_STAGE(PG8_SA(1, 0), a3, voffA);
            PG8_WAIT_V(8); PG8_WAIT_L(0); PG8_BAR; PG8_MMA(1, 0, At, B0); PG8_MMA(1, 1, At, B1); PG8_BAR; PG8_SCHED;
            } else {
            PG8_LDB(B0, 0, 0); PG8_SCHED; PG8_LDA(At, 0, 0); PG8_STAGE(PG8_SA(1, 1), a1 + hstep, voffA);
            PG8_WAIT_L(8); PG8_BAR; PG8_WAIT_L(0); PG8_MMA(0, 0, At, B0); PG8_BAR; PG8_SCHED;
            PG8_LDB(B1, 0, 1); PG8_STAGE(PG8_SB(0, 0), b2, voffB);
            PG8_BAR; PG8_WAIT_L(0); PG8_MMA(0, 1, At, B1); PG8_BAR;
            PG8_LDA(At, 0, 1); PG8_STAGE(PG8_SA(0, 0), a2, voffA);
            PG8_BAR; PG8_WAIT_L(0); PG8_MMA(1, 0, At, B0); PG8_BAR; PG8_SCHED;
            PG8_STAGE(PG8_SB(0, 1), b2 + hstep, voffB);
            PG8_WAIT_V(6); PG8_BAR; PG8_MMA(1, 1, At, B1); PG8_BAR;
            PG8_LDB(B0, 1, 0); PG8_SCHED; PG8_LDA(At, 1, 0); PG8_STAGE(PG8_SA(0, 1), a2 + hstep, voffA);
            PG8_WAIT_L(8); PG8_BAR; PG8_WAIT_L(0); PG8_MMA(0, 0, At, B0); PG8_BAR; PG8_SCHED;
            PG8_LDB(B1, 1, 1); PG8_STAGE(PG8_SB(1, 0), b3, voffB);
            PG8_BAR; PG8_WAIT_L(0); PG8_MMA(0, 1, At, B1); PG8_BAR;
            PG8_LDA(At, 1, 1); PG8_STAGE(PG8_SA(1, 0), a3, voffA);
            PG8_BAR; PG8_WAIT_L(0); PG8_MMA(1, 0, At, B0); PG8_BAR; PG8_SCHED;
            PG8_STAGE(PG8_SB(1, 1), b3 + hstep, voffB);
            PG8_WAIT_V(6); PG8_BAR; PG8_MMA(1, 1, At, B1); PG8_BAR;
            }
        }
        if constexpr (ALIGN_EPI) { if (wr == 0) PG8_BAR; }
        if constexpr (QM == 1) { PG8_SCHED; asm volatile("s_nop 15\n\ts_nop 7" ::: "memory"); PG8_SCHED; }
        if constexpr (!Epi::AFTER_DRAIN) { E(acc, cur, wr, wc, fr, fq); S.done(cur); }
        if (!has_next) break;
#pragma unroll
        for (int a = 0; a < 2; ++a)
#pragma unroll
            for (int b = 0; b < 2; ++b)
#pragma unroll
                for (int m = 0; m < 4; ++m)
#pragma unroll
                    for (int n = 0; n < 2; ++n) acc[a][b][m][n] = (f32x4){0.f, 0.f, 0.f, 0.f};
        cur = nxt; cA = nA; cB = nB; ++ui; nt = cur.nt;
        if constexpr (ALIGN_EPI) { if (wr == 1) PG8_BAR; }
    }
    PG8_WAIT_V(0);
    if constexpr (!ALIGN_EPI) { if (wr == 0) PG8_BAR; }
    PG8_BAR;
    if constexpr (Epi::AFTER_DRAIN) { E.fused(acc, cur, wr, wc, fr, fq, lds, wid, lane); S.done(cur); }
#undef PG8_SA
#undef PG8_SB
#undef PG8_STAGE
#undef PG8_LDA
#undef PG8_LDB
#undef PG8_MMA
#undef PG8_WAIT_V
#undef PG8_WAIT_L
#undef PG8_BAR
#undef PG8_SCHED
}
}
constexpr int D = 4096, T = 4096, NB = 2, NPR = NB * T, SB = 16, ST = 32, NSA = SB * ST, NTOK = NPR + NSA;
constexpr int NSEQ = NB + SB, AW = 2048, LW = 2048, HD = 128, NH = 16, DFF = 11008, INC = 10240, NMOD = 6 * D;
constexpr int CROWS = 512, KS_LD = 544;
constexpr float RMS_EPS = 1e-6f;
constexpr float QSCALE = 0.08838834764831845f * 1.4426950408889634f;
constexpr float LOG2E = 1.4426950408889634f;
constexpr size_t O_Y = 0, O_KP = (size_t)NTOK * D, O_VP = O_KP + (size_t)NB * 512 * AW, O_CP = O_VP + (size_t)NB * 512 * AW, O_HP = O_CP + (size_t)NB * 3 * LW,
                 O_KS = O_HP + (size_t)NB * LW, O_VS = O_KS + (size_t)NSA * AW, O_CS = O_VS + (size_t)NSA * AW, O_HS = O_CS + (size_t)SB * 3 * LW, O_END = O_HS + (size_t)SB * LW;
static_assert(O_END == 42090496, "output size");
constexpr size_t MiB = 1u << 20;
constexpr size_t WS_CTL = 0, CTL_ZERO_BYTES = 163840, WS_AMAX = 32768  ,
                 WS_AMAX1 = 122880  , WS_SU = 163840  , WS_SU1 = 262144  ;
constexpr size_t WS_MOD = 1 * MiB, WS_LSUM = 3 * MiB, WS_WRG = 5 * MiB, WS_WIN = 6 * MiB, WS_WOUT = 86 * MiB, WS_WGU = 118 * MiB, WS_WD = 290 * MiB, WS_U = 376 * MiB,
                 WS_Q = 444 * MiB, WS_K = 478 * MiB, WS_KC = 512 * MiB, WS_VTP = 544 * MiB, WS_VTS = 576 * MiB, WS_XR = 610 * MiB, WS_GG = 678 * MiB, WS_MIX = 712 * MiB,
                 WS_X1 = 780 * MiB, WS_H = 916 * MiB, WS_END = 1099 * MiB;
static_assert(WS_H + (size_t)NTOK * DFF * 2 <= WS_END && WS_X1 + (size_t)NTOK * D * 4 <= WS_H && WS_WGU + (size_t)2 * DFF * D * 2 <= WS_WD && WS_WD + (size_t)D * DFF * 2 <= WS_U, "d_ws map");
constexpr size_t WS_AB = WS_END;
constexpr size_t WS_END2 = WS_END + 128 * MiB;
constexpr size_t WS_WIN8 = WS_H + 96 * MiB, WS_U8 = WS_H + 140 * MiB;
static_assert(WS_H + (size_t)NTOK * DFF <= WS_WIN8 && WS_WIN8 + (size_t)INC * D <= WS_U8 && WS_U8 + (size_t)NTOK * D <= WS_END, "int8 images");
constexpr size_t WS_SLAB = WS_Q;
static_assert(WS_SLAB + (size_t)8 * NSA * D * 4 <= WS_KC, "slab overlay");
static_assert((4096 + 3456) * 4 <= 32768, "control words inside the zeroed region");
constexpr int CW_BAR = 4096, CW_ARRIVE = 64, CW_LQ = 128, CW_TMO2 = 192;
constexpr int RING_BYTES = 131072;
constexpr int XCH_OFF = RING_BYTES;
constexpr int MISC_OFF = XCH_OFF + 8192;
constexpr int LDS_BYTES = 147456;

#define LAS __attribute__((address_space(3)))
typedef unsigned short bf16;
typedef float f32x4 __attribute__((ext_vector_type(4)));
typedef float f32x2 __attribute__((ext_vector_type(2)));
typedef short bf16x8 __attribute__((ext_vector_type(8)));
typedef unsigned u32x4 __attribute__((ext_vector_type(4)));
typedef unsigned u32x2 __attribute__((ext_vector_type(2)));
using pg8::cvt_pk_bf16; using pg8::pk4_fp8; using pg8::pk4_i8; using pg8::W8_SCALE; using pg8::W8_INV;
#define LDS_WAIT() asm volatile("s_waitcnt lgkmcnt(0)" ::: "memory")
#define VM_WAIT() asm volatile("s_waitcnt vmcnt(0)" ::: "memory")

__device__ __forceinline__ float fast_sigmoid(float x) { return __builtin_amdgcn_rcpf(1.0f + __builtin_amdgcn_exp2f(-LOG2E * x)); }
__device__ __forceinline__ float gelu_tanh(float x) { return x * __builtin_amdgcn_rcpf(1.0f + __builtin_amdgcn_exp2f(-2.302208198f * (x + 0.044715f * x * x * x))); }

__device__ __forceinline__ float xrow16_max(float x) {
    auto s = __builtin_amdgcn_permlane16_swap(__float_as_uint(x), __float_as_uint(x), false, false); x = fmaxf(__uint_as_float(s[0]), __uint_as_float(s[1]));
    auto t = __builtin_amdgcn_permlane32_swap(__float_as_uint(x), __float_as_uint(x), false, false); return fmaxf(__uint_as_float(t[0]), __uint_as_float(t[1]));
}
__device__ __forceinline__ float xrow16_sum(float x) {
    auto s = __builtin_amdgcn_permlane16_swap(__float_as_uint(x), __float_as_uint(x), false, false); x = __uint_as_float(s[0]) + __uint_as_float(s[1]);
    auto t = __builtin_amdgcn_permlane32_swap(__float_as_uint(x), __float_as_uint(x), false, false); return __uint_as_float(t[0]) + __uint_as_float(t[1]);
}
template <int QM> struct EpiIn {
    static constexpr bool PERM = true, AFTER_DRAIN = false;
    bf16* Q; bf16* K; bf16* VtP; bf16* VtS; float* XR; bf16* GG; float* out; const float* qg; const float* kg; LAS float* xch; const float* su; const float* sw;
    __device__ __forceinline__ void operator()(const f32x4 (&acc)[2][2][4][2], const pg8::Unit& u, int wr, int wc, int fr, int fq) const {
        asm volatile("" : "+v"(fr), "+v"(fq));
        if (QM == 2) {
            f32x4 (&A)[2][2][4][2] = const_cast<f32x4 (&)[2][2][4][2]>(acc);
            const float* p = sw + u.pn * 256 + wc * 32 + 8 * fq; f32x4 cs[2][2];
#pragma unroll
            for (int bj = 0; bj < 2; ++bj)
#pragma unroll
                for (int n = 0; n < 2; ++n) cs[bj][n] = *(const f32x4*)(p + 128 * bj + 4 * n) * (1.f / 127.f);
#pragma unroll
            for (int ai = 0; ai < 2; ++ai)
#pragma unroll
                for (int m = 0; m < 4; ++m) { const float r = su[(size_t)u.pm * 256 + ai * 128 + wr * 64 + m * 16 + fr];
#pragma unroll
                    for (int bj = 0; bj < 2; ++bj)
#pragma unroll
                        for (int n = 0; n < 2; ++n)
#pragma unroll
                            for (int j = 0; j < 4; ++j) { const float x = A[ai][bj][m][n][j]; A[ai][bj][m][n][j] = (float)__builtin_bit_cast(int, x) * (r * cs[bj][n][j]); } }
        }
        const int region = u.pn >> 3, pl = u.pn & 7;
        const int rl0 = wr * 64 + fr, cl0 = wc * 32 + 8 * fq;
        const bool prompt = u.pm < 32;
        const int pb = u.pm >> 4, pt0 = (u.pm & 15) * 256, s0 = (u.pm - 32) * 256;
#ifndef RMASK
#define RMASK 31
#endif
        if ((RMASK & 3) && region < 2) {
#pragma unroll
            for (int ai = 0; ai < 2; ++ai)
#pragma unroll
                for (int m = 0; m < 4; ++m)
#pragma unroll
                    for (int bj = 0; bj < 2; ++bj) {
                        const f32x4 a = acc[ai][bj][m][0], b = acc[ai][bj][m][1];
                        float s = (a[0] * a[0] + a[1] * a[1]) + (a[2] * a[2] + a[3] * a[3]) + (b[0] * b[0] + b[1] * b[1]) + (b[2] * b[2] + b[3] * b[3]);
                        s = xrow16_sum(s);
                        if (fq == 0) xch[((ai * 128 + m * 16 + rl0) * 2 + bj) * 4 + wc] = s;
                    }
            asm volatile("s_waitcnt lgkmcnt(0)" ::: "memory"); __builtin_amdgcn_s_barrier(); asm volatile("" ::: "memory");
            const float* gp = (region == 0 ? qg : kg) + cl0;
            const float osc = region == 0 ? QSCALE : 1.0f;
            const f32x4 g0 = *(const f32x4*)gp * osc, g1 = *(const f32x4*)(gp + 4) * osc;
            bf16* dst = region == 0 ? Q : K;
            const bool newk = (region == 1) && (!prompt || (u.pm & 15) >= 14);
            float* ok = prompt ? out + O_KP + (size_t)(pb * 512 + pt0 - 3584) * AW : out + O_KS + (size_t)s0 * AW;
#pragma unroll
            for (int ai = 0; ai < 2; ++ai)
#pragma unroll
                for (int m = 0; m < 4; ++m) {
                    const int rl = ai * 128 + m * 16 + rl0; const size_t mrow = (size_t)u.pm * 256 + rl;
#pragma unroll
                    for (int bj = 0; bj < 2; ++bj) {
                        const f32x4 p = *(const LAS f32x4*)&xch[(rl * 2 + bj) * 4];
                        const float rs = __builtin_amdgcn_rsqf(((p[0] + p[1]) + (p[2] + p[3])) * (1.0f / 128.0f) + RMS_EPS);
                        const f32x4 v0 = acc[ai][bj][m][0] * rs * g0, v1 = acc[ai][bj][m][1] * rs * g1;
                        const int col = (pl * 2 + bj) * 128 + cl0;
                        u32x4 w; w.x = cvt_pk_bf16(v0[0], v0[1]); w.y = cvt_pk_bf16(v0[2], v0[3]); w.z = cvt_pk_bf16(v1[0], v1[1]); w.w = cvt_pk_bf16(v1[2], v1[3]);
                        const size_t hidx = prompt ? ((size_t)(pb * NH + pl * 2 + bj) * T + pt0 + rl) * HD + cl0 : (size_t)NPR * AW + ((size_t)(((s0 + rl) >> 5) * NH + pl * 2 + bj) * ST + ((s0 + rl) & 31)) * HD + cl0;
                        *(u32x4*)(dst + hidx) = w;
                        if (newk) { float* o = ok + (size_t)rl * AW + col; *(f32x4*)o = v0; *(f32x4*)(o + 4) = v1; }
                    }
                    asm volatile("" ::: "memory");
                }
        } else if ((RMASK & 4) && region == 2) {
            const bool newv = !prompt || (u.pm & 15) >= 14;
            float* ov = prompt ? out + O_VP + (size_t)(pb * 512 + pt0 - 3584) * AW : out + O_VS + (size_t)s0 * AW;
#pragma unroll
            for (int bj = 0; bj < 2; ++bj) {
                const int h = pl * 2 + bj;
#pragma unroll
                for (int n = 0; n < 2; ++n)
#pragma unroll
                    for (int j = 0; j < 4; j += 2) {
                        const int d = cl0 + 4 * n + j;
                        if (prompt) {
                            bf16* p0 = VtP + (((size_t)(pb * NH + h) * (T / 32) + (pt0 >> 5)) * HD + d) * 32 + (rl0 & 31) + (size_t)(rl0 >> 5) * (HD * 32);
#pragma unroll
                            for (int ai = 0; ai < 2; ++ai)
#pragma unroll
                                for (int m = 0; m < 4; ++m) { const unsigned w = cvt_pk_bf16(acc[ai][bj][m][n][j], acc[ai][bj][m][n][j + 1]); bf16* q0 = p0 + (ai * 4 + (m >> 1)) * (HD * 32) + (m & 1) * 16; q0[0] = (bf16)(w & 0xffffu); q0[32] = (bf16)(w >> 16); }
                        } else {
#pragma unroll
                            for (int ai = 0; ai < 2; ++ai)
#pragma unroll
                                for (int m = 0; m < 4; ++m) { const int s = s0 + ai * 128 + m * 16 + rl0; bf16* q0 = VtS + (((size_t)((s >> 5) * NH + h) * (KS_LD / 32) + CROWS / 32) * HD + d) * 32 + (s & 31);
                                    const unsigned w = cvt_pk_bf16(acc[ai][bj][m][n][j], acc[ai][bj][m][n][j + 1]); q0[0] = (bf16)(w & 0xffffu); q0[32] = (bf16)(w >> 16); }
                        }
                    }
            }
            if (newv) {
#pragma unroll
                for (int ai = 0; ai < 2; ++ai)
#pragma unroll
                    for (int m = 0; m < 4; ++m) { const int rl = ai * 128 + m * 16 + rl0;
#pragma unroll
                        for (int bj = 0; bj < 2; ++bj) { float* o = ov + (size_t)rl * AW + (pl * 2 + bj) * 128 + cl0; *(f32x4*)o = acc[ai][bj][m][0]; *(f32x4*)(o + 4) = acc[ai][bj][m][1]; } }
            }
        } else if ((RMASK & 8) && region == 3) {
#pragma unroll
            for (int ai = 0; ai < 2; ++ai)
#pragma unroll
                for (int m = 0; m < 4; ++m) { const int rl = ai * 128 + m * 16 + rl0; const size_t mrow = (size_t)u.pm * 256 + rl;
                    int ci = -1; float* oc = out;
                    if (prompt) { if ((u.pm & 15) == 15 && rl >= 253) { ci = rl - 253; oc = out + O_CP + (size_t)(pb * 3 + ci) * LW; } }
                    else { const int s = s0 + rl; if ((s & 31) >= 29) { ci = (s & 31) - 29; oc = out + O_CS + (size_t)((s >> 5) * 3 + ci) * LW; } }
#pragma unroll
                    for (int bj = 0; bj < 2; ++bj) { const int col = pl * 256 + bj * 128 + cl0; float* o = XR + mrow * LW + col; *(f32x4*)o = acc[ai][bj][m][0]; *(f32x4*)(o + 4) = acc[ai][bj][m][1];
                        if (ci >= 0) { *(f32x4*)(oc + col) = acc[ai][bj][m][0]; *(f32x4*)(oc + col + 4) = acc[ai][bj][m][1]; } } }
        } else if (RMASK & 16) {
#pragma unroll
            for (int ai = 0; ai < 2; ++ai)
#pragma unroll
                for (int m = 0; m < 4; ++m) { const size_t mrow = (size_t)u.pm * 256 + ai * 128 + m * 16 + rl0;
#pragma unroll
                    for (int bj = 0; bj < 2; ++bj) { const f32x4 a = acc[ai][bj][m][0], b = acc[ai][bj][m][1];
                        u32x4 w; w.x = cvt_pk_bf16(a[0], a[1]); w.y = cvt_pk_bf16(a[2], a[3]); w.z = cvt_pk_bf16(b[0], b[1]); w.w = cvt_pk_bf16(b[2], b[3]);
                        *(u32x4*)(GG + mrow * LW + pl * 256 + bj * 128 + cl0) = w; } }
        }
    }
};
struct SplitOrder {
    pg8::StaticOrder full; int G, c, np;
    __device__ __forceinline__ void init(int K, int G_, int c_) { full.init(NPR, D, K, G_, c_); G = G_; c = c_; np = K / 128; }
    __device__ __forceinline__ bool next(int i, pg8::Unit& u) const {
        const int L = i * G + c;
        if (L < full.nwg) return full.next(i, u);
        const int j = L - full.nwg; if (j >= 256) return false;
        const int tile = j >> 3, part = j & 7, base = np >> 3, rem = np & 7;
        u.pm = 32 + (tile >> 4); u.pn = tile & 15; u.kb = 2 * (part * base + (part < rem ? part : rem)); u.nt = 2 * (base + (part < rem ? 1 : 0)); u.part = part; return true;
    }
    __device__ __forceinline__ void a_ready(const pg8::Unit&) const {}
    __device__ __forceinline__ void done(const pg8::Unit&) const {}
};
struct XrOrder {
    int G, c;
    __device__ __forceinline__ void init(int G_, int c_) { G = G_; c = c_; }
    __device__ __forceinline__ bool next(int i, pg8::Unit& u) const {
        const int L = i * G + c; if (L >= 256) return false;
        const int wg = (L & 7) * 32 + (L >> 3); u.pm = wg >> 3; u.pn = 24 + (wg & 7); u.kb = 0; u.nt = D / 64; u.part = -1; return true;
    }
    __device__ __forceinline__ void a_ready(const pg8::Unit&) const {}
    __device__ __forceinline__ void done(const pg8::Unit&) const {}
};
struct B2Order {
    int G, c;
    __device__ __forceinline__ void init(int G_, int c_) { G = G_; c = c_; }
    __device__ __forceinline__ bool next(int i, pg8::Unit& u) const {
        const int L = i * G + c; if (L >= 112) return false;
        const int idx = (L & 7) * 14 + (L >> 3);
        if (idx < 64) { u.pm = 14 + ((idx >> 4) & 1) + 16 * (idx >> 5); u.pn = 8 + (idx & 15); }
        else { const int j = idx - 64; u.pm = 32 + j / 24; u.pn = 8 + j % 24; }
        u.kb = 0; u.nt = D / 64; u.part = -1; return true;
    }
    __device__ __forceinline__ void a_ready(const pg8::Unit&) const {}
    __device__ __forceinline__ void done(const pg8::Unit&) const {}
};
struct I8Order {
    int G, c;
    __device__ __forceinline__ void init(int G_, int c_) { G = G_; c = c_; }
    __device__ __forceinline__ bool next(int i, pg8::Unit& u) const {
        const int L = i * G + c; if (L >= 992) return false;
        const int t = (L & 7) * 124 + (L >> 3);
        if (t < 896) { const int pi = t >> 5, ct = t & 31; u.pm = pi < 14 ? pi : pi + 2; u.pn = ct < 24 ? ct : ct + 8; }
        else { const int s = t - 896, pi = s >> 4, ct = s & 15; u.pm = pi < 2 ? 14 + pi : 28 + pi; u.pn = ct < 8 ? ct : ct + 24; }
        u.kb = 0; u.nt = D / 128; u.part = -1; return true;
    }
    __device__ __forceinline__ void a_ready(const pg8::Unit&) const {}
    __device__ __forceinline__ void done(const pg8::Unit&) const {}
};
struct GluOrder {
    pg8::StaticOrder full; int G, c, mode;
    __device__ __forceinline__ void init(int K, int G_, int c_) { full.init(NPR, 2 * DFF, K, G_, c_); G = G_; c = c_; mode = 0; }
    __device__ __forceinline__ bool next(int i, pg8::Unit& u) const {
        if (mode == 0) return full.next(i, u);
        const int cc = (G == 256) ? ((c + 256 - 84) & 255) : c, L = i * G + cc; if (L >= 2 * (2 * DFF / 256)) return false;
        u.pm = 32 + L / (2 * DFF / 256); u.pn = L % (2 * DFF / 256); u.kb = 0; u.nt = full.ntf; u.part = -1; return true;
    }
    __device__ __forceinline__ void a_ready(const pg8::Unit&) const {}
    __device__ __forceinline__ void done(const pg8::Unit&) const {}
};
struct TailSplit {
    int rank, nrank, np;
    __device__ __forceinline__ void init(int K, int G, int c) { np = K / 128; if (G == 256) { rank = c < 84 ? c : (c >= 192 ? 84 + (c - 192) : -1); nrank = 148; } else { rank = c; nrank = G; } }
    __device__ __forceinline__ bool next(int i, pg8::Unit& u) const {
        if (rank < 0) return false;
        const int j = rank + i * nrank; if (j >= 256) return false;
        const int tile = j >> 3, part = j & 7, base = np >> 3, rem = np & 7;
        u.pm = 32 + (tile >> 4); u.pn = tile & 15; u.kb = 2 * (part * base + (part < rem ? part : rem)); u.nt = 2 * (base + (part < rem ? 1 : 0)); u.part = part; return true;
    }
    __device__ __forceinline__ void a_ready(const pg8::Unit&) const {}
    __device__ __forceinline__ void done(const pg8::Unit&) const {}
};
template <bool BASE_BF16, bool OUT_BF16> struct EpiRes {
    static constexpr bool PERM = false, AFTER_DRAIN = false;
    const void* base; void* outp; const float* gate; float* slab; int probe_skip; float wsc;
    __device__ __forceinline__ void operator()(const f32x4 (&acc)[2][2][4][2], const pg8::Unit& u, int wr, int wc, int fr, int fq) const {
        asm volatile("" : "+v"(fr), "+v"(fq));
        const int col0 = u.pn * 256 + wc * 32 + 4 * fq;
        if (probe_skip) return;
        if (u.part < 0) {
            const float* gp = gate + (size_t)(u.pm >> 4) * NMOD + col0;
            f32x4 gv[2][2];
#pragma unroll
            for (int bj = 0; bj < 2; ++bj)
#pragma unroll
                for (int n = 0; n < 2; ++n) gv[bj][n] = *(const f32x4*)(gp + bj * 128 + n * 16) * wsc;
#pragma unroll
            for (int ai = 0; ai < 2; ++ai) {
                const size_t row0 = (size_t)u.pm * 256 + ai * 128 + wr * 64 + fr;
                f32x4 bs[4][2][2]; u32x2 bw[4][2][2];
#pragma unroll
                for (int m = 0; m < 4; ++m)
#pragma unroll
                    for (int bj = 0; bj < 2; ++bj)
#pragma unroll
                        for (int n = 0; n < 2; ++n) { const size_t off = (row0 + m * 16) * D + col0 + bj * 128 + n * 16;
                            if (BASE_BF16) bw[m][bj][n] = *(const u32x2*)((const bf16*)base + off); else bs[m][bj][n] = *(const f32x4*)((const float*)base + off); }
#pragma unroll
                for (int m = 0; m < 4; ++m)
#pragma unroll
                    for (int bj = 0; bj < 2; ++bj)
#pragma unroll
                        for (int n = 0; n < 2; ++n) { const size_t off = (row0 + m * 16) * D + col0 + bj * 128 + n * 16;
                            f32x4 bsv;
                            if (BASE_BF16) { const u32x2 w = bw[m][bj][n]; bsv = (f32x4){__uint_as_float(w.x << 16), __uint_as_float(w.x & 0xffff0000u), __uint_as_float(w.y << 16), __uint_as_float(w.y & 0xffff0000u)}; }
                            else bsv = bs[m][bj][n];
                            const f32x4 o = bsv + gv[bj][n] * acc[ai][bj][m][n];
                            if (OUT_BF16) { u32x2 w; w.x = cvt_pk_bf16(o[0], o[1]); w.y = cvt_pk_bf16(o[2], o[3]); *(u32x2*)((bf16*)outp + off) = w; }
                            else __builtin_nontemporal_store(o, (f32x4*)((float*)outp + off)); }
                asm volatile("" ::: "memory");
            }
        } else {
#pragma unroll
            for (int ai = 0; ai < 2; ++ai)
#pragma unroll
                for (int m = 0; m < 4; ++m) {
                    const int rl = ai * 128 + wr * 64 + m * 16 + fr; const size_t mrow = (size_t)u.pm * 256 + rl;
                    const int seq = NB + (((u.pm - 32) * 256 + rl) >> 5);
                    const float* gp = gate + (size_t)seq * NMOD;
#pragma unroll
                    for (int bj = 0; bj < 2; ++bj)
#pragma unroll
                        for (int n = 0; n < 2; ++n) { const int c = col0 + bj * 128 + n * 16; *(f32x4*)(slab + ((size_t)u.part * NSA + (mrow - NPR)) * D + c) = *(const f32x4*)(gp + c) * wsc * acc[ai][bj][m][n]; }
                    if (m & 1) asm volatile("" ::: "memory");
                }
        }
    }
};
template <int QM> struct EpiGlu {
    static constexpr bool PERM = true, AFTER_DRAIN = false;
    bf16* H; float wsc; const float* su; const float* sw;
    __device__ __forceinline__ void operator()(const f32x4 (&acc)[2][2][4][2], const pg8::Unit& u, int wr, int wc, int fr, int fq) const {
        asm volatile("" : "+v"(fr), "+v"(fq));
        const int col = u.pn * 128 + wc * 32 + 8 * fq;
        f32x4 sg[2], sp[2]; float rs[2][4];
        if (QM == 2) { const float* p = sw + u.pn * 256 + wc * 32 + 8 * fq; sg[0] = *(const f32x4*)p * (1.f / 127.f); sg[1] = *(const f32x4*)(p + 4) * (1.f / 127.f); sp[0] = *(const f32x4*)(p + 128) * (1.f / 127.f); sp[1] = *(const f32x4*)(p + 132) * (1.f / 127.f);
#pragma unroll
            for (int ai = 0; ai < 2; ++ai)
#pragma unroll
                for (int m = 0; m < 4; ++m) rs[ai][m] = su[(size_t)u.pm * 256 + ai * 128 + wr * 64 + m * 16 + fr]; }
#pragma unroll
        for (int ai = 0; ai < 2; ++ai)
#pragma unroll
            for (int m = 0; m < 4; ++m) { const size_t mrow = (size_t)u.pm * 256 + ai * 128 + wr * 64 + m * 16 + fr;
                f32x4 v[2];
#pragma unroll
                for (int n = 0; n < 2; ++n) { f32x4 g, up;
                    if (QM == 2) {
#pragma unroll
                        for (int j = 0; j < 4; ++j) { const float ga = acc[ai][0][m][n][j], ua = acc[ai][1][m][n][j];
                            g[j] = (float)__builtin_bit_cast(int, ga) * (rs[ai][m] * sg[n][j]); up[j] = (float)__builtin_bit_cast(int, ua) * (rs[ai][m] * sp[n][j]); } }
                    else { g = acc[ai][0][m][n] * wsc; up = acc[ai][1][m][n] * wsc; }
#pragma unroll
                    for (int j = 0; j < 4; ++j) v[n][j] = g[j] * fast_sigmoid(g[j]) * up[j]; }
                if (F8_DOWN) { u32x2 w; w.x = pk4_fp8(v[0][0], v[0][1], v[0][2], v[0][3]); w.y = pk4_fp8(v[1][0], v[1][1], v[1][2], v[1][3]); *(u32x2*)((unsigned char*)H + mrow * DFF + col) = w; }
                else { u32x4 w; w.x = cvt_pk_bf16(v[0][0], v[0][1]); w.y = cvt_pk_bf16(v[0][2], v[0][3]); w.z = cvt_pk_bf16(v[1][0], v[1][1]); w.w = cvt_pk_bf16(v[1][2], v[1][3]);
                    *(u32x4*)(H + mrow * DFF + col) = w; } }
    }
};
#define XB_TMO      128
#define XB_XCNT(j)  (256  + 64 * (j))
#define XB_XSUB(j)  (1280 + 64 * (j))
#define XB_XGEN(j)  (2304 + 64 * (j))
#define XB_TOP      3328
#define XB_TOPGEN   3392
#define XCD_BAR_WORDS 3456
#define XB_SPIN_CAP (1u << 18)
#define LAS __attribute__((address_space(3)))

__device__ __forceinline__ unsigned xb_ld(unsigned* p)              { return __hip_atomic_load(p, __ATOMIC_RELAXED, __HIP_MEMORY_SCOPE_AGENT); }
__device__ __forceinline__ unsigned xb_add(unsigned* p, unsigned v) { return __hip_atomic_fetch_add(p, v, __ATOMIC_RELAXED, __HIP_MEMORY_SCOPE_AGENT); }
__device__ __forceinline__ unsigned xb_xcc_id() { return (unsigned)__builtin_amdgcn_s_getreg((3 << 11) | 20) & 0xFu; }
#define XB_SPIN(cond, bar) do { unsigned _sp = 0; while (cond) { __builtin_amdgcn_s_sleep(1); \
    if ((++_sp & 255u) == 0u) { if (xb_ld(&(bar)[XB_TMO])) break; if (_sp > XB_SPIN_CAP) { atomicAdd(&(bar)[XB_TMO], 1u); break; } } } } while (0)

struct XcdBarrier {
    unsigned* bar; unsigned x;
    volatile LAS unsigned* st;
};

__device__ __forceinline__ XcdBarrier xcd_barrier_post(unsigned* bar, volatile LAS unsigned* st) {
    XcdBarrier b; b.bar = bar; b.x = xb_xcc_id(); b.st = st;
    if (threadIdx.x == 0) (void)xb_add(&bar[XB_XCNT(b.x)], 1u);
    return b;
}
__device__ __forceinline__ void xcd_barrier_complete(unsigned* bar, unsigned x, unsigned& nloc, unsigned& nx) {
    const unsigned G = gridDim.x * gridDim.y * gridDim.z;
    unsigned sum, cnt, mine, sp = 0u;
    for (;;) {
        sum = 0u; cnt = 0u; mine = 0u;
#pragma unroll
        for (unsigned j = 0; j < 16; ++j) { const unsigned c = xb_ld(&bar[XB_XCNT(j)]); sum += c; cnt += (c > 0u) ? 1u : 0u; mine = (j == x) ? c : mine; }
        if (sum == G) break;
        __builtin_amdgcn_s_sleep(1);
        if ((++sp & 255u) == 0u) { if (xb_ld(&bar[XB_TMO])) break; if (sp > XB_SPIN_CAP) { atomicAdd(&bar[XB_TMO], 1u); break; } }
    }
    nloc = mine > 0u ? mine : 1u; nx = cnt > 0u ? cnt : 1u;
}

__device__ __forceinline__ void xcd_barrier(const XcdBarrier& b) {
    asm volatile("s_waitcnt vmcnt(0)" ::: "memory");
    __syncthreads();
    if (threadIdx.x == 0) {
        unsigned* bar = b.bar;
        __builtin_amdgcn_s_waitcnt(0);
        unsigned nloc = b.st[0], nx = b.st[1];
        if (nloc == 0u) { xcd_barrier_complete(bar, b.x, nloc, nx); b.st[0] = nloc; b.st[1] = nx; }
        const unsigned old = xb_add(&bar[XB_XSUB(b.x)], 1u);
        const unsigned gen = old / nloc;
        if (old + 1u == (gen + 1u) * nloc) {
            __builtin_amdgcn_fence(__ATOMIC_RELEASE, "agent");
            asm volatile("s_waitcnt vmcnt(0)" ::: "memory");
            const unsigned og = xb_add(&bar[XB_TOP], 1u);
            const unsigned tg = og / nx;
            if (og + 1u == (tg + 1u) * nx) xb_add(&bar[XB_TOPGEN], 1u);
            else XB_SPIN(xb_ld(&bar[XB_TOPGEN]) == tg, bar);
            __builtin_amdgcn_fence(__ATOMIC_ACQUIRE, "agent");
            xb_add(&bar[XB_XGEN(b.x)], 1u);
            asm volatile("s_waitcnt vmcnt(0)" ::: "memory");
        } else {
            XB_SPIN(xb_ld(&bar[XB_XGEN(b.x)]) == gen, bar);
            __builtin_amdgcn_fence(__ATOMIC_ACQUIRE, "agent");
            asm volatile("s_waitcnt vmcnt(0)" ::: "memory");
        }
    }
    __syncthreads();
}
constexpr int NWAVES = 8;
struct Params {
    const float* in[27];
    float* out; unsigned char* ws;
    int ph_lo, ph_hi;
    int sub, pad;
};
enum { I_XP = 0, I_XS, I_CK, I_CV, I_SCONV, I_SH, I_CP, I_CS, I_G1, I_G2, I_WMOD, I_BMOD, I_WIN, I_QG, I_KG, I_RELB, I_CONVW, I_CONVB, I_WRA, I_BRA, I_WRX, I_BRX, I_LAM, I_WOUT, I_WG, I_WU, I_WD };

__device__ __forceinline__ float wave_sum(float v) {
#pragma unroll
    for (int o = 1; o < 64; o <<= 1) v += __shfl_xor(v, o);
    return v;
}
__device__ __forceinline__ unsigned f2bf(float f) { unsigned u = __builtin_bit_cast(unsigned, f); return (u + 0x7fffu + ((u >> 16) & 1u)) >> 16; }
__device__ __forceinline__ unsigned pk2(float lo, float hi) { return f2bf(lo) | (f2bf(hi) << 16); }

#ifndef P0_MALL
#define P0_MALL 1
#endif
#ifndef NT_WEIGHTS
#define NT_WEIGHTS 0
#endif
#if NT_WEIGHTS
#define NT_LOAD(p) __builtin_nontemporal_load(p)
#else
#define NT_LOAD(p) (*(p))
#endif
__device__ __forceinline__ void transpose_item(const float* src, size_t sld, bf16* dst, size_t dld, LAS float* scr, int lane, size_t blk = 32) {
    { f32x4 v[8]; const int r8 = lane >> 3, c4 = lane & 7;
#pragma unroll
      for (int i = 0; i < 8; ++i) v[i] = NT_LOAD((const f32x4*)(src + (size_t)(8 * i + r8) * sld + 4 * c4));
#pragma unroll
      for (int i = 0; i < 8; ++i) { LAS float* d = scr + (8 * i + r8) * 33 + 4 * c4; d[0] = v[i][0]; d[1] = v[i][1]; d[2] = v[i][2]; d[3] = v[i][3]; } }
    LDS_WAIT(); asm volatile("" ::: "memory");
    const int c = lane & 7;
#pragma unroll
    for (int j = 0; j < 4; ++j) { const int n = (lane >> 3) + 8 * j; const LAS float* s = scr + (8 * c) * 33 + n;
        u32x4 o; o.x = pk2(s[0 * 33], s[1 * 33]); o.y = pk2(s[2 * 33], s[3 * 33]); o.z = pk2(s[4 * 33], s[5 * 33]); o.w = pk2(s[6 * 33], s[7 * 33]);
        *(u32x4*)(dst + (size_t)n * dld + (size_t)(c >> 2) * blk + 8 * (c & 3)) = o; }
    LDS_WAIT(); asm volatile("" ::: "memory");
}
__device__ __forceinline__ void transpose_item_f8(const float* src, size_t sld, unsigned char* dst, size_t dld, LAS float* scr, int lane) {
    { f32x4 v[8]; const int r8 = lane >> 3, c4 = lane & 7;
#pragma unroll
      for (int i = 0; i < 8; ++i) v[i] = NT_LOAD((const f32x4*)(src + (size_t)(8 * i + r8) * sld + 4 * c4));
#pragma unroll
      for (int i = 0; i < 8; ++i) { LAS float* d = scr + (8 * i + r8) * 33 + 4 * c4; d[0] = v[i][0]; d[1] = v[i][1]; d[2] = v[i][2]; d[3] = v[i][3]; } }
    LDS_WAIT(); asm volatile("" ::: "memory");
#pragma unroll
    for (int j = 0; j < 2; ++j) { const int p = lane + 64 * j, n = p >> 2, c = p & 3; const LAS float* s = scr + (16 * c) * 33 + n;
        u32x4 o; o.x = pk4_fp8(s[0 * 33] * W8_SCALE, s[1 * 33] * W8_SCALE, s[2 * 33] * W8_SCALE, s[3 * 33] * W8_SCALE); o.y = pk4_fp8(s[4 * 33] * W8_SCALE, s[5 * 33] * W8_SCALE, s[6 * 33] * W8_SCALE, s[7 * 33] * W8_SCALE);
        o.z = pk4_fp8(s[8 * 33] * W8_SCALE, s[9 * 33] * W8_SCALE, s[10 * 33] * W8_SCALE, s[11 * 33] * W8_SCALE); o.w = pk4_fp8(s[12 * 33] * W8_SCALE, s[13 * 33] * W8_SCALE, s[14 * 33] * W8_SCALE, s[15 * 33] * W8_SCALE);
        *(u32x4*)(dst + (size_t)n * dld + 16 * c) = o; }
    LDS_WAIT(); asm volatile("" ::: "memory");
}
__device__ __forceinline__ void transpose_item_i8(const float* src, size_t sld, unsigned char* dst, size_t dld, LAS float* scr, int lane, const float* amax) {
    { f32x4 v[8]; const int r8 = lane >> 3, c4 = lane & 7;
#pragma unroll
      for (int i = 0; i < 8; ++i) v[i] = NT_LOAD((const f32x4*)(src + (size_t)(8 * i + r8) * sld + 4 * c4));
#pragma unroll
      for (int i = 0; i < 8; ++i) { LAS float* d = scr + (8 * i + r8) * 33 + 4 * c4; d[0] = v[i][0]; d[1] = v[i][1]; d[2] = v[i][2]; d[3] = v[i][3]; } }
    LDS_WAIT(); asm volatile("" ::: "memory");
#pragma unroll
    for (int j = 0; j < 2; ++j) { const int p = lane + 64 * j, n = p >> 2, c = p & 3; const LAS float* s = scr + (16 * c) * 33 + n;
        const float a = amax[n], inv = a > 0.f ? 127.f / a : 0.f;
        u32x4 o; o.x = pk4_i8(s[0 * 33], s[1 * 33], s[2 * 33], s[3 * 33], inv); o.y = pk4_i8(s[4 * 33], s[5 * 33], s[6 * 33], s[7 * 33], inv);
        o.z = pk4_i8(s[8 * 33], s[9 * 33], s[10 * 33], s[11 * 33], inv); o.w = pk4_i8(s[12 * 33], s[13 * 33], s[14 * 33], s[15 * 33], inv);
        *(u32x4*)(dst + (size_t)n * dld + 16 * c) = o; }
    LDS_WAIT(); asm volatile("" ::: "memory");
}
__device__ __forceinline__ void transpose_item_dual(const float* src, size_t sld, bf16* dst, size_t dld, unsigned char* dst8, size_t dld8, LAS float* scr, int lane, const float* amax) {
    { f32x4 v[8]; const int r8 = lane >> 3, c4 = lane & 7;
#pragma unroll
      for (int i = 0; i < 8; ++i) v[i] = NT_LOAD((const f32x4*)(src + (size_t)(8 * i + r8) * sld + 4 * c4));
#pragma unroll
      for (int i = 0; i < 8; ++i) { LAS float* d = scr + (8 * i + r8) * 33 + 4 * c4; d[0] = v[i][0]; d[1] = v[i][1]; d[2] = v[i][2]; d[3] = v[i][3]; } }
    LDS_WAIT(); asm volatile("" ::: "memory");
    { const int c = lane & 7;
#pragma unroll
      for (int j = 0; j < 4; ++j) { const int n = (lane >> 3) + 8 * j; const LAS float* s = scr + (8 * c) * 33 + n;
          u32x4 o; o.x = pk2(s[0 * 33], s[1 * 33]); o.y = pk2(s[2 * 33], s[3 * 33]); o.z = pk2(s[4 * 33], s[5 * 33]); o.w = pk2(s[6 * 33], s[7 * 33]);
          *(u32x4*)(dst + (size_t)n * dld + 8 * c) = o; } }
#pragma unroll
    for (int j = 0; j < 2; ++j) { const int p = lane + 64 * j, n = p >> 2, c = p & 3; const LAS float* s = scr + (16 * c) * 33 + n;
        const float a = amax[n], inv = a > 0.f ? 127.f / a : 0.f;
        u32x4 o; o.x = pk4_i8(s[0 * 33], s[1 * 33], s[2 * 33], s[3 * 33], inv); o.y = pk4_i8(s[4 * 33], s[5 * 33], s[6 * 33], s[7 * 33], inv);
        o.z = pk4_i8(s[8 * 33], s[9 * 33], s[10 * 33], s[11 * 33], inv); o.w = pk4_i8(s[12 * 33], s[13 * 33], s[14 * 33], s[15 * 33], inv);
        *(u32x4*)(dst8 + (size_t)n * dld8 + 16 * c) = o; }
    LDS_WAIT(); asm volatile("" ::: "memory");
}
__device__ __forceinline__ void p0_amax_gu(const Params& P, int gw, int NGW, int lane, int up) {
    unsigned* amax = (unsigned*)(P.ws + WS_CTL + WS_AMAX);
    constexpr int CC = DFF / 256, KC = D / 32;
    for (int it = gw; it < KC * CC; it += NGW) {
        const int kc = it / CC, cc = it % CC;
        const float* src = P.in[up ? I_WU : I_WG] + (size_t)kc * 32 * DFF + cc * 256 + 4 * lane;
        f32x4 m = (f32x4){0.f, 0.f, 0.f, 0.f};
#pragma unroll
        for (int h = 0; h < 2; ++h) { f32x4 v[16];
#pragma unroll
            for (int i = 0; i < 16; ++i) v[i] = NT_LOAD((const f32x4*)(src + (size_t)(h * 16 + i) * DFF));
#pragma unroll
            for (int i = 0; i < 16; ++i) { m[0] = fmaxf(m[0], fabsf(v[i][0])); m[1] = fmaxf(m[1], fabsf(v[i][1])); m[2] = fmaxf(m[2], fabsf(v[i][2])); m[3] = fmaxf(m[3], fabsf(v[i][3])); } }
        const int n = cc * 256 + 4 * lane, ni = 256 * (n >> 7) + (n & 127) + (up ? 128 : 0);
#pragma unroll
        for (int j = 0; j < 4; ++j) { const float mj = m[j]; __hip_atomic_fetch_max(amax + ni + j, __builtin_bit_cast(unsigned, mj), __ATOMIC_RELAXED, __HIP_MEMORY_SCOPE_AGENT); }
    }
}
__device__ __forceinline__ void p0_amax_win(const Params& P, int gw, int NGW, int lane) {
    constexpr int KC = D / 32;
    unsigned* amax1 = (unsigned*)(P.ws + WS_CTL + WS_AMAX1);
    for (int it = gw; it < KC * 32; it += NGW) {
        const int kc = it >> 5, c5 = it & 31, cc = c5 < 24 ? c5 : c5 + 8;
        const float* src = P.in[I_WIN] + (size_t)kc * 32 * INC + cc * 256 + 4 * lane;
        f32x4 m = (f32x4){0.f, 0.f, 0.f, 0.f};
#pragma unroll
        for (int h = 0; h < 2; ++h) { f32x4 v[16];
#pragma unroll
            for (int i = 0; i < 16; ++i) v[i] = NT_LOAD((const f32x4*)(src + (size_t)(h * 16 + i) * INC));
#pragma unroll
            for (int i = 0; i < 16; ++i) { m[0] = fmaxf(m[0], fabsf(v[i][0])); m[1] = fmaxf(m[1], fabsf(v[i][1])); m[2] = fmaxf(m[2], fabsf(v[i][2])); m[3] = fmaxf(m[3], fabsf(v[i][3])); } }
#pragma unroll
        for (int j = 0; j < 4; ++j) { const float mj = m[j]; __hip_atomic_fetch_max(amax1 + cc * 256 + 4 * lane + j, __builtin_bit_cast(unsigned, mj), __ATOMIC_RELAXED, __HIP_MEMORY_SCOPE_AGENT); }
    }
}
__device__ __forceinline__ void p0_conv_gu(const Params& P, LAS unsigned char* lds, int gw, int NGW, int wave, int lane, int up) {
    LAS float* scr = (LAS float*)(lds + wave * 8704);
    unsigned char* WguT = P.ws + WS_WGU; const float* amax = (const float*)(P.ws + WS_CTL + WS_AMAX);
    constexpr int I_GA = (D / 64) * (DFF / 32);
    for (int it = gw; it < I_GA; it += NGW) {
        const int nb = it % (DFF / 32), kb = it / (DFF / 32); const int n0 = nb * 32, row0 = 256 * (n0 >> 7) + (n0 & 127) + (up ? 128 : 0);
        transpose_item_i8(P.in[up ? I_WU : I_WG] + (size_t)kb * 64 * DFF + n0, DFF, WguT + (size_t)row0 * D + kb * 64, D, scr, lane, amax + row0);
    }
}
__device__ __forceinline__ void p0_conv_win8(const Params& P, LAS unsigned char* lds, int gw, int NGW, int wave, int lane) {
    LAS float* scr = (LAS float*)(lds + wave * 8704);
    bf16* WinT = (bf16*)(P.ws + WS_WIN);
    const float* amax1 = (const float*)(P.ws + WS_CTL + WS_AMAX1); unsigned char* Win8 = P.ws + WS_WIN8;
    for (int it = gw; it < (D / 64) * 256; it += NGW) {
        const int kb = it >> 8, n5 = it & 255, nb = n5 < 192 ? n5 : n5 + 64;
        const float* src = P.in[I_WIN] + (size_t)kb * 64 * INC + nb * 32;
        if (nb >= 64 && nb < 192) transpose_item_dual(src, INC, WinT + (size_t)nb * 32 * D + kb * 64, D, Win8 + (size_t)nb * 32 * D + kb * 64, D, scr, lane, amax1 + nb * 32);
        else transpose_item_i8(src, INC, Win8 + (size_t)nb * 32 * D + kb * 64, D, scr, lane, amax1 + nb * 32);
    }
}
__device__ __forceinline__ void cvt_item(const float* src, bf16* dst, int lane) {
#pragma unroll
    for (int j = 0; j < 4; ++j) { const f32x4 a = *(const f32x4*)(src + j * 512 + lane * 8), b = *(const f32x4*)(src + j * 512 + lane * 8 + 4);
        u32x4 o; o.x = pk2(a[0], a[1]); o.y = pk2(a[2], a[3]); o.z = pk2(b[0], b[1]); o.w = pk2(b[2], b[3]); *(u32x4*)(dst + j * 512 + lane * 8) = o; }
}
__device__ __forceinline__ void p0_convert(const Params& P, LAS unsigned char* lds, int gw, int NGW, int wave, int lane) {
    LAS float* scr = (LAS float*)(lds + wave * 8704);
    unsigned char* ws = P.ws;
    bf16* WinT = (bf16*)(ws + WS_WIN); bf16* WoutT = (bf16*)(ws + WS_WOUT); bf16* WguT = (bf16*)(ws + WS_WGU); bf16* WdT = (bf16*)(ws + WS_WD); bf16* WrgT = (bf16*)(ws + WS_WRG);
    bf16* VtS = (bf16*)(ws + WS_VTS); bf16* Kc = (bf16*)(ws + WS_KC);
    constexpr int I_IN = (D / 64) * (INC / 32), I_OUT = (D / 64) * (D / 32), I_GA = (D / 64) * (DFF / 32), I_DN = (DFF / 64) * (D / 32), I_CVT = SB * NH * (CROWS / 64) * (HD / 32), I_RG = 16 * (128 / 64) * (128 / 32),
                  I_KC = SB * NH * (CROWS / 16);
    constexpr int I_XR = (D / 64) * (LW / 32);
    constexpr int NITEMS = I_XR + I_OUT + I_DN + I_CVT + 2 * I_RG + I_KC;
    for (int it = gw; it < NITEMS; it += NGW) {
        int r = it;
        if (r < I_XR) { const int nb = 192 + r % (LW / 32), kb = r / (LW / 32); transpose_item(P.in[I_WIN] + (size_t)kb * 64 * INC + nb * 32, INC, WinT + (size_t)nb * 32 * D + kb * 64, D, scr, lane); continue; } r -= I_XR;
        if (r < I_OUT) { const int nb = r % (D / 32), kb = r / (D / 32); transpose_item(P.in[I_WOUT] + (size_t)kb * 64 * D + nb * 32, D, WoutT + (size_t)nb * 32 * D + kb * 64, D, scr, lane); continue; } r -= I_OUT;
        if (r < I_DN) { const int nb = r % (D / 32), kb = r / (D / 32);
            if (F8_DOWN) transpose_item_f8(P.in[I_WD] + (size_t)kb * 64 * D + nb * 32, D, (unsigned char*)WdT + (size_t)nb * 32 * DFF + kb * 64, DFF, scr, lane);
            else transpose_item(P.in[I_WD] + (size_t)kb * 64 * D + nb * 32, D, WdT + (size_t)nb * 32 * DFF + kb * 64, DFF, scr, lane); continue; } r -= I_DN;
        if (r < I_CVT) { const int sub = r & 31, bh = r >> 5, b = bh >> 4, h = bh & 15, kb = sub >> 2, nb = sub & 3;
            transpose_item(P.in[I_CV] + ((size_t)(b * CROWS + kb * 64) * NH + h) * HD + nb * 32, (size_t)NH * HD, VtS + (((size_t)(b * NH + h) * (KS_LD / 32) + kb * 2) * HD + nb * 32) * 32, 32, scr, lane, HD * 32); continue; } r -= I_CVT;
        if (r < 2 * I_RG) { const int x = r >= I_RG; if (x) r -= I_RG; const int sub = r & 7, n = r >> 3, kb = sub >> 2, nb = sub & 3;
            transpose_item(P.in[x ? I_WRX : I_WRA] + (size_t)n * 16384 + kb * 64 * 128 + nb * 32, 128, WrgT + ((size_t)n * 256 + x * 128 + nb * 32) * 128 + kb * 64, 128, scr, lane); continue; } r -= 2 * I_RG;
        { const int kc = r & 31, bh = r >> 5, b = bh >> 4, h = bh & 15;
#pragma unroll
          for (int j = 0; j < 4; ++j) { const int key = kc * 16 + 4 * j + (lane >> 4), d8 = (lane & 15) * 8; const float* sp = P.in[I_CK] + ((size_t)(b * CROWS + key) * NH + h) * HD + d8;
              const f32x4 a = *(const f32x4*)sp, c4 = *(const f32x4*)(sp + 4); u32x4 o; o.x = pk2(a[0], a[1]); o.y = pk2(a[2], a[3]); o.z = pk2(c4[0], c4[1]); o.w = pk2(c4[2], c4[3]);
              *(u32x4*)(Kc + ((size_t)bh * CROWS + key) * HD + d8) = o; } }
    }
#if !P0_MALL
    { unsigned* ctl = (unsigned*)(ws + WS_CTL);
      if (threadIdx.x == 0) {
          unsigned sp = 0;
          while (__hip_atomic_load(ctl + CW_ARRIVE + 896, __ATOMIC_RELAXED, __HIP_MEMORY_SCOPE_AGENT) < gridDim.x) { __builtin_amdgcn_s_sleep(2);
              if ((++sp & 255u) == 0u) { if (__hip_atomic_load(ctl + CW_TMO2, __ATOMIC_RELAXED, __HIP_MEMORY_SCOPE_AGENT)) break; if (sp > (1u << 20)) { __hip_atomic_store(ctl + CW_TMO2, 1u, __ATOMIC_RELAXED, __HIP_MEMORY_SCOPE_AGENT); break; } } }
          __builtin_amdgcn_fence(__ATOMIC_ACQUIRE, "agent"); VM_WAIT();
      }
      __syncthreads(); }
    p0_conv_gu(P, lds, gw, NGW, wave, lane, 0); p0_conv_gu(P, lds, gw, NGW, wave, lane, 1);
    p0_conv_win8(P, lds, gw, NGW, wave, lane);
#endif
}
__device__ __forceinline__ void p0_mod(const Params& P, LAS unsigned char* lds, int tid, int wave, int lane) {
    LAS float* Sw = (LAS float*)lds + wave * 640;
    LAS float* Rb = (LAS float*)(lds + 20480);
    const float* Wm = P.in[I_WMOD]; float* mod = (float*)(P.ws + WS_MOD);
    for (int cb = blockIdx.x; cb < NMOD / 96; cb += gridDim.x) {
        const int n0 = cb * 96, rs = lane / 24, c4 = lane % 24;
        f32x4 acc[NSEQ];
#pragma unroll
        for (int s = 0; s < NSEQ; ++s) acc[s] = (f32x4){0.f, 0.f, 0.f, 0.f};
        __syncthreads();
        for (int idx = lane; idx < NSEQ * 16; idx += 64) { const int sq = idx >> 4, r = idx & 15; const float v = sq < NB ? P.in[I_CP][sq * D + wave * 16 + r] : P.in[I_CS][(sq - NB) * D + wave * 16 + r]; Sw[r * 20 + sq] = v * fast_sigmoid(v); }
        f32x4 w[8];
        if (lane < 48) {
#pragma unroll
            for (int p = 0; p < 8; ++p) w[p] = NT_LOAD((const f32x4*)(Wm + (size_t)(wave * 16 + 2 * p + rs) * NMOD + n0 + 4 * c4)); }
        for (int ch = 0; ch < D / 128; ++ch) {
            const int k0 = ch * 128; LAS float* Sc = Sw + (ch & 1) * 320; LAS float* Sn = Sw + ((ch + 1) & 1) * 320;
            const int kn = (ch + 1 < D / 128) ? k0 + 128 : k0;
            for (int idx = lane; idx < NSEQ * 16; idx += 64) { const int sq = idx >> 4, r = idx & 15; const float v = sq < NB ? P.in[I_CP][sq * D + kn + wave * 16 + r] : P.in[I_CS][(sq - NB) * D + kn + wave * 16 + r]; Sn[r * 20 + sq] = v * fast_sigmoid(v); }
            LDS_WAIT(); asm volatile("" ::: "memory");
            if (lane < 48) {
                f32x4 wn[8];
#pragma unroll
                for (int p = 0; p < 8; ++p) wn[p] = NT_LOAD((const f32x4*)(Wm + (size_t)(kn + wave * 16 + 2 * p + rs) * NMOD + n0 + 4 * c4));
#pragma unroll
                for (int p = 0; p < 8; ++p) { const LAS float* sp = Sc + (2 * p + rs) * 20;
                    const f32x4 s0 = *(const LAS f32x4*)sp, s1 = *(const LAS f32x4*)(sp + 4), s2 = *(const LAS f32x4*)(sp + 8), s3 = *(const LAS f32x4*)(sp + 12); const f32x2 s4 = *(const LAS f32x2*)(sp + 16);
#pragma unroll
                    for (int j = 0; j < 4; ++j) { acc[j] += w[p] * s0[j]; acc[4 + j] += w[p] * s1[j]; acc[8 + j] += w[p] * s2[j]; acc[12 + j] += w[p] * s3[j]; }
                    acc[16] += w[p] * s4[0]; acc[17] += w[p] * s4[1]; }
#pragma unroll
                for (int p = 0; p < 8; ++p) w[p] = wn[p];
            }
            LDS_WAIT(); asm volatile("" ::: "memory");
        }
        if (lane < 48) {
#pragma unroll
            for (int s = 0; s < NSEQ; ++s) *(LAS f32x4*)(Rb + ((wave * 2 + rs) * NSEQ + s) * 96 + 4 * c4) = acc[s];
        }
        __syncthreads();
        for (int idx = tid; idx < NSEQ * 96; idx += NWAVES * 64) { const int s = idx / 96, c = idx % 96; float v = P.in[I_BMOD][n0 + c];
#pragma unroll
            for (int q = 0; q < 16; ++q) v += Rb[(q * NSEQ + s) * 96 + c];
            mod[(size_t)s * NMOD + n0 + c] = v; }
    }
    __syncthreads();
}
template <bool X0_BF16, int UQ = 0> __device__ __forceinline__ void norm_rows(const float* __restrict__ x0, const float* __restrict__ x1, const float* __restrict__ gain, const float* __restrict__ mod, int sh_off, int sc_off, bf16* __restrict__ U, const float* __restrict__ slab, float* __restrict__ x1out, int nrows, int gw, int NGW, int lane, float* __restrict__ su = nullptr, unsigned char* __restrict__ U8p = nullptr) {
    for (int m = gw; m < nrows; m += NGW) {
        const float* xr = m < NPR ? x0 + (X0_BF16 ? 0 : (size_t)m * D) : x1 + (size_t)(m - NPR) * D;
        const int seq = m < NPR ? m / T : NB + (m - NPR) / ST;
        const float* mp = mod + (size_t)seq * NMOD;
        f32x4 v[16]; float ss = 0.f;
#pragma unroll
        for (int j = 0; j < 16; ++j) {
            if (X0_BF16 && m < NPR) { const u32x2 w = *(const u32x2*)((const bf16*)x0 + (size_t)m * D + 4 * (lane + 64 * j)); v[j] = (f32x4){__uint_as_float(w.x << 16), __uint_as_float(w.x & 0xffff0000u), __uint_as_float(w.y << 16), __uint_as_float(w.y & 0xffff0000u)}; }
            else v[j] = *(const f32x4*)(xr + 4 * (lane + 64 * j)); }
        if (slab && m >= NPR) {
            for (int q = 0; q < 8; ++q) {
#pragma unroll
                for (int j = 0; j < 16; ++j) v[j] += *(const f32x4*)(slab + ((size_t)q * NSA + (m - NPR)) * D + 4 * (lane + 64 * j)); }
#pragma unroll
            for (int j = 0; j < 16; ++j) *(f32x4*)(x1out + (size_t)(m - NPR) * D + 4 * (lane + 64 * j)) = v[j];
        }
#pragma unroll
        for (int j = 0; j < 16; ++j) ss += (v[j][0] * v[j][0] + v[j][1] * v[j][1]) + (v[j][2] * v[j][2] + v[j][3] * v[j][3]);
        const float rstd = __builtin_amdgcn_rsqf(wave_sum(ss) * (1.0f / D) + RMS_EPS);
        bf16* up = U + (size_t)m * D; unsigned char* up8 = (unsigned char*)U + (size_t)m * D;
        constexpr int JB = UQ ? 4 : 8;
        float amx = 0.f;
#pragma unroll
        for (int jb = 0; jb < 16; jb += JB) {
            f32x4 g[JB], sc[JB], sh[JB];
#pragma unroll
            for (int j = 0; j < JB; ++j) { const int c = 4 * (lane + 64 * (jb + j)); g[j] = *(const f32x4*)(gain + c); sc[j] = *(const f32x4*)(mp + sc_off + c); sh[j] = *(const f32x4*)(mp + sh_off + c); }
#pragma unroll
            for (int j = 0; j < JB; ++j) { const int c = 4 * (lane + 64 * (jb + j));
                const f32x4 o = v[jb + j] * rstd * g[j] * (sc[j] + 1.0f) + sh[j];
                if (UQ >= 2) { v[jb + j] = o; amx = fmaxf(fmaxf(amx, fmaxf(fabsf(o[0]), fabsf(o[1]))), fmaxf(fabsf(o[2]), fabsf(o[3]))); }
                if (UQ != 2) { u32x2 w; w.x = cvt_pk_bf16(o[0], o[1]); w.y = cvt_pk_bf16(o[2], o[3]); *(u32x2*)(up + c) = w; } }
            if (UQ) asm volatile("" ::: "memory");
        }
        if (UQ >= 2) {
#pragma unroll
            for (int o = 1; o < 64; o <<= 1) amx = fmaxf(amx, __shfl_xor(amx, o));
            const float inv = amx > 0.f ? 127.f / amx : 0.f;
            if (lane == 0) su[m] = amx * (1.f / 127.f);
            unsigned char* q8 = UQ == 3 ? U8p + (size_t)m * D : up8;
#pragma unroll
            for (int j = 0; j < 16; ++j) *(unsigned*)(q8 + 4 * (lane + 64 * j)) = pk4_i8(v[j][0], v[j][1], v[j][2], v[j][3], inv);
        }
    }
}

template <bool SLAB, int UQ = 0> __device__ __forceinline__ void norm_sample_split(const Params& P, LAS unsigned char* lds, const float* __restrict__ xs, const float* __restrict__ gain, const float* __restrict__ mod, int sh_off, int sc_off,
                                                  bf16* __restrict__ U, const float* __restrict__ slab, float* __restrict__ x1out, int wave, int lane, float* __restrict__ su = nullptr, unsigned char* __restrict__ U8p = nullptr) {
    LAS float* part = (LAS float*)lds;
    for (int rb = blockIdx.x; rb < NSA / 2; rb += gridDim.x) {
        const int r = 2 * rb + (wave >> 2), col0 = 1024 * (wave & 3), seq = NB + r / ST;
        const float* mp = mod + (size_t)seq * NMOD;
        f32x4 v[4];
#pragma unroll
        for (int j = 0; j < 4; ++j) v[j] = *(const f32x4*)(xs + (size_t)r * D + col0 + 4 * (lane + 64 * j));
        if (SLAB) {
#pragma unroll
            for (int q = 0; q < 8; ++q)
#pragma unroll
                for (int j = 0; j < 4; ++j) v[j] += *(const f32x4*)(slab + ((size_t)q * NSA + r) * D + col0 + 4 * (lane + 64 * j)); }
        float ss = 0.f;
#pragma unroll
        for (int j = 0; j < 4; ++j) { if (SLAB) *(f32x4*)(x1out + (size_t)r * D + col0 + 4 * (lane + 64 * j)) = v[j]; ss += (v[j][0] * v[j][0] + v[j][1] * v[j][1]) + (v[j][2] * v[j][2] + v[j][3] * v[j][3]); }
        ss = wave_sum(ss);
        __syncthreads();
        if (lane == 0) part[wave] = ss;
        __syncthreads();
        const int w0 = wave & 4; const float tot = (part[w0] + part[w0 + 1]) + (part[w0 + 2] + part[w0 + 3]);
        const float rstd = __builtin_amdgcn_rsqf(tot * (1.0f / D) + RMS_EPS);
        bf16* up = U + (size_t)(NPR + r) * D; unsigned char* up8 = (unsigned char*)U + (size_t)(NPR + r) * D;
        float amx = 0.f;
#pragma unroll
        for (int j = 0; j < 4; ++j) { const int c = col0 + 4 * (lane + 64 * j);
            const f32x4 o = v[j] * rstd * *(const f32x4*)(gain + c) * (*(const f32x4*)(mp + sc_off + c) + 1.0f) + *(const f32x4*)(mp + sh_off + c);
            if (UQ >= 2) { v[j] = o; amx = fmaxf(fmaxf(amx, fmaxf(fabsf(o[0]), fabsf(o[1]))), fmaxf(fabsf(o[2]), fabsf(o[3]))); }
            if (UQ != 2) { u32x2 w; w.x = cvt_pk_bf16(o[0], o[1]); w.y = cvt_pk_bf16(o[2], o[3]); *(u32x2*)(up + c) = w; } }
        if (UQ >= 2) {
#pragma unroll
            for (int o = 1; o < 64; o <<= 1) amx = fmaxf(amx, __shfl_xor(amx, o));
            if (lane == 0) part[8 + wave] = amx;
            __syncthreads();
            const float rmx = fmaxf(fmaxf(part[8 + w0], part[8 + w0 + 1]), fmaxf(part[8 + w0 + 2], part[8 + w0 + 3]));
            const float inv = rmx > 0.f ? 127.f / rmx : 0.f;
            if (lane == 0 && (wave & 3) == 0) su[NPR + r] = rmx * (1.f / 127.f);
            unsigned char* q8 = UQ == 3 ? U8p + (size_t)(NPR + r) * D : up8;
#pragma unroll
            for (int j = 0; j < 4; ++j) *(unsigned*)(q8 + col0 + 4 * (lane + 64 * j)) = pk4_i8(v[j][0], v[j][1], v[j][2], v[j][3], inv);
        }
    }
}
__device__ __forceinline__ void attn_unit(const bf16* Qp, const bf16* Kp0, const bf16* Kp1, int nks, int ks_split, const bf16* Vt, int dq0, const LAS float* tab, bf16* Op, int lane) {
    const int c = lane & 15, g = lane >> 4;
    bf16x8 qf[2][4];
#pragma unroll
    for (int qt = 0; qt < 2; ++qt)
#pragma unroll
        for (int ds = 0; ds < 4; ++ds) qf[qt][ds] = *(const bf16x8*)(Qp + (unsigned)((16 * qt + c) * HD + 32 * ds + 8 * g));
    f32x4 o[8][2];
#pragma unroll
    for (int dt = 0; dt < 8; ++dt) { o[dt][0] = (f32x4){0.f, 0.f, 0.f, 0.f}; o[dt][1] = (f32x4){0.f, 0.f, 0.f, 0.f}; }
    float mrun[2] = {-1e30f, -1e30f}, lrun[2] = {0.f, 0.f};
    const int kr0 = 8 * (c >> 2) + (c & 3);
    const float bfar = tab[256];
    const unsigned koff = (unsigned)(kr0 * HD + 8 * g), voff = (unsigned)(c * 32 + 8 * g);
    bf16x8 kf[2][4], vf[8];
    {
        const bf16* kb = 0 < ks_split ? Kp0 : Kp1;
#pragma unroll
        for (int tau = 0; tau < 2; ++tau)
#pragma unroll
            for (int ds = 0; ds < 4; ++ds) kf[tau][ds] = *(const bf16x8*)(kb + tau * 4 * HD + 32 * ds + koff);
#pragma unroll
        for (int dt = 0; dt < 8; ++dt) vf[dt] = *(const bf16x8*)(Vt + dt * 512 + voff);
    }
    for (int ks = 0; ks < nks; ++ks) {
        f32x4 s[2][2];
#pragma unroll
        for (int qt = 0; qt < 2; ++qt)
#pragma unroll
            for (int tau = 0; tau < 2; ++tau) { f32x4 a = (f32x4){0.f, 0.f, 0.f, 0.f};
#pragma unroll
                for (int ds = 0; ds < 4; ++ds) a = __builtin_amdgcn_mfma_f32_16x16x32_bf16(kf[tau][ds], qf[qt][ds], a, 0, 0, 0);
                s[qt][tau] = a; }
        __builtin_amdgcn_sched_barrier(0);
        if (ks + 1 < nks) {
            const int kn = ks + 1; const bf16* kb = kn < ks_split ? Kp0 + (size_t)(32 * kn) * HD : Kp1 + (size_t)(32 * (kn - ks_split)) * HD;
#pragma unroll
            for (int tau = 0; tau < 2; ++tau)
#pragma unroll
                for (int ds = 0; ds < 4; ++ds) kf[tau][ds] = *(const bf16x8*)(kb + tau * 4 * HD + 32 * ds + koff);
        }
        __builtin_amdgcn_sched_barrier(0);
        const int dstep = dq0 - 32 * ks;
        if (dstep - 31 >= 128) {
#pragma unroll
            for (int qt = 0; qt < 2; ++qt)
#pragma unroll
                for (int tau = 0; tau < 2; ++tau) s[qt][tau] += bfar;
        } else {
#pragma unroll
            for (int qt = 0; qt < 2; ++qt)
#pragma unroll
                for (int tau = 0; tau < 2; ++tau)
#pragma unroll
                    for (int e = 0; e < 4; ++e) { int rel = dstep + 16 * qt + c - (8 * g + 4 * tau + e); rel = rel < -128 ? -128 : (rel > 128 ? 128 : rel); s[qt][tau][e] += tab[rel + 128]; }
        }
        bf16x8 pf[2];
#pragma unroll
        for (int qt = 0; qt < 2; ++qt) {
            float mx = fmaxf(fmaxf(fmaxf(s[qt][0][0], s[qt][0][1]), fmaxf(s[qt][0][2], s[qt][0][3])), fmaxf(fmaxf(s[qt][1][0], s[qt][1][1]), fmaxf(s[qt][1][2], s[qt][1][3])));
            mx = xrow16_max(mx);
            const float mn = fmaxf(mrun[qt], mx), alpha = __builtin_amdgcn_exp2f(mrun[qt] - mn);
            const bool grew = __any(mn > mrun[qt]); mrun[qt] = mn;
            f32x4 p0, p1;
#pragma unroll
            for (int e = 0; e < 4; ++e) { p0[e] = __builtin_amdgcn_exp2f(s[qt][0][e] - mn); p1[e] = __builtin_amdgcn_exp2f(s[qt][1][e] - mn); }
            lrun[qt] = lrun[qt] * alpha + ((p0[0] + p0[1]) + (p0[2] + p0[3])) + ((p1[0] + p1[1]) + (p1[2] + p1[3]));
            if (grew) {
#pragma unroll
                for (int dt = 0; dt < 8; ++dt) o[dt][qt] *= alpha; }
            u32x4 w; w.x = cvt_pk_bf16(p0[0], p0[1]); w.y = cvt_pk_bf16(p0[2], p0[3]); w.z = cvt_pk_bf16(p1[0], p1[1]); w.w = cvt_pk_bf16(p1[2], p1[3]);
            pf[qt] = __builtin_bit_cast(bf16x8, w);
        }
#pragma unroll
        for (int dt = 0; dt < 8; ++dt)
#pragma unroll
            for (int qt = 0; qt < 2; ++qt) o[dt][qt] = __builtin_amdgcn_mfma_f32_16x16x32_bf16(vf[dt], pf[qt], o[dt][qt], 0, 0, 0);
        __builtin_amdgcn_sched_barrier(0);
        if (ks + 1 < nks) {
            const bf16* vb = Vt + (size_t)(ks + 1) * (HD * 32);
#pragma unroll
            for (int dt = 0; dt < 8; ++dt) vf[dt] = *(const bf16x8*)(vb + dt * 512 + voff);
        }
        __builtin_amdgcn_sched_barrier(0);
    }
#pragma unroll
    for (int qt = 0; qt < 2; ++qt) {
        const float l = xrow16_sum(lrun[qt]);
        const float inv = 1.0f / l;
        bf16* op = Op + (unsigned)((16 * qt + c) * D + 4 * g);
#pragma unroll
        for (int dt = 0; dt < 8; ++dt) { const f32x4 v = o[dt][qt] * inv; u32x2 w; w.x = cvt_pk_bf16(v[0], v[1]); w.y = cvt_pk_bf16(v[2], v[3]); *(u32x2*)(op + 16 * dt) = w; }
    }
}
__device__ __forceinline__ void attn_block_unit(const bf16* Qh, const bf16* Kh, const bf16* VtP, bf16* MIX, int bh, int qb, const LAS float* tabh, LAS unsigned char* ring, int wave, int lane) {
    const int c = lane & 15, g = lane >> 4, b = bh >> 4, h = bh & 15;
    const int ci0 = 4 * qb, ci = ci0 + (wave >> 1), q0 = 64 * ci + 32 * (wave & 1);
    const int kt0 = ci0 > 8 ? ci0 - 8 : 0, nt = ci0 + 3 - kt0 + 1;
    const bf16* Qp = Qh + ((size_t)bh * T + q0) * HD;
    bf16x8 qf[2][4];
#pragma unroll
    for (int qt = 0; qt < 2; ++qt)
#pragma unroll
        for (int ds = 0; ds < 4; ++ds) qf[qt][ds] = *(const bf16x8*)(Qp + (unsigned)((16 * qt + c) * HD + 32 * ds + 8 * g));
    f32x4 o[8][2];
#pragma unroll
    for (int dt = 0; dt < 8; ++dt) { o[dt][0] = (f32x4){0.f, 0.f, 0.f, 0.f}; o[dt][1] = (f32x4){0.f, 0.f, 0.f, 0.f}; }
    float mrun[2] = {-1e30f, -1e30f};
    f32x4 ol[2] = {(f32x4){0.f, 0.f, 0.f, 0.f}, (f32x4){0.f, 0.f, 0.f, 0.f}};
    const bf16x8 ones = (bf16x8){0x3F80, 0x3F80, 0x3F80, 0x3F80, 0x3F80, 0x3F80, 0x3F80, 0x3F80};
    const float bfar = tabh[256];
    unsigned ksrc[2];
#pragma unroll
    for (int j = 0; j < 2; ++j) { const int r = 4 * (2 * wave + j) + (lane >> 4), pos = lane & 15, sw = (((r >> 3) & 3) << 2) | (r & 3); ksrc[j] = (unsigned)(r * HD + ((pos ^ sw) << 3)); }
    const unsigned vsrc = (unsigned)(wave * 1024 + lane * 8);
    const bf16* Kbase = Kh + (size_t)bh * T * HD; const bf16* Vbase = VtP + (size_t)bh * (T / 32) * HD * 32;
#define ATTN_DMA(kt, slot) do { const bf16* kp_ = Kbase + (size_t)(kt) * (64 * HD); const bf16* vp_ = Vbase + (size_t)(kt) * (64 * HD) + vsrc; LAS unsigned char* sl_ = ring + (slot) * 32768 + wave * 2048; \
        __builtin_amdgcn_global_load_lds((const unsigned*)(kp_ + ksrc[0]), (LAS unsigned*)(sl_), 16, 0, 0); \
        __builtin_amdgcn_global_load_lds((const unsigned*)(kp_ + ksrc[1]), (LAS unsigned*)(sl_ + 1024), 16, 0, 0); \
        __builtin_amdgcn_global_load_lds((const unsigned*)(vp_), (LAS unsigned*)(sl_ + 16384), 16, 0, 0); \
        __builtin_amdgcn_global_load_lds((const unsigned*)(vp_ + 512), (LAS unsigned*)(sl_ + 16384 + 1024), 16, 0, 0); } while (0)
    asm volatile("s_waitcnt vmcnt(0)" ::: "memory");
    ATTN_DMA(kt0, 0); ATTN_DMA(kt0 + 1, 1);
    const int kr0 = 8 * (c >> 2) + (c & 3);
    int slot = 0;
    for (int i = 0; i < nt; ++i) {
        asm volatile("s_waitcnt vmcnt(4)" ::: "memory");
        __builtin_amdgcn_s_barrier();
        asm volatile("" ::: "memory");
        { const int in = i + 2 < nt ? i + 2 : nt - 1; int sn = slot + 2; sn = sn >= 3 ? sn - 3 : sn; ATTN_DMA(kt0 + in, sn); }
        const int kt = kt0 + i;
        if (kt >= ci - 8 && kt <= ci) {
            const LAS unsigned char* ks_ = ring + slot * 32768; const LAS unsigned char* vs_ = ks_ + 16384;
#pragma unroll
            for (int st = 0; st < 2; ++st) {
                bf16x8 kf[2][4];
#pragma unroll
                for (int tau = 0; tau < 2; ++tau)
#pragma unroll
                    for (int ds = 0; ds < 4; ++ds) kf[tau][ds] = *(const LAS bf16x8*)(ks_ + (32 * st + kr0 + 4 * tau) * 256 + (((4 * ds + g) ^ c) << 4));
                f32x4 s[2][2];
#pragma unroll
                for (int qt = 0; qt < 2; ++qt)
#pragma unroll
                    for (int tau = 0; tau < 2; ++tau) { f32x4 a = (f32x4){0.f, 0.f, 0.f, 0.f};
#pragma unroll
                        for (int ds = 0; ds < 4; ++ds) a = __builtin_amdgcn_mfma_f32_16x16x32_bf16(kf[tau][ds], qf[qt][ds], a, 0, 0, 0);
                        s[qt][tau] = a; }
                bf16x8 vf[8];
#pragma unroll
                for (int dt = 0; dt < 8; ++dt) vf[dt] = *(const LAS bf16x8*)(vs_ + st * 8192 + (16 * dt + c) * 64 + g * 16);
                const int dstep = q0 - (64 * kt + 32 * st);
                const bool far = dstep - 31 >= 128;
                const float badd = far ? bfar : 0.f;
                if (!far) {
#pragma unroll
                    for (int qt = 0; qt < 2; ++qt)
#pragma unroll
                        for (int tau = 0; tau < 2; ++tau)
#pragma unroll
                            for (int e = 0; e < 4; ++e) { int rel = dstep + 16 * qt + c - (8 * g + 4 * tau + e); rel = rel < -128 ? -128 : (rel > 128 ? 128 : rel); s[qt][tau][e] += tabh[rel + 128]; }
                }
                bf16x8 pf[2];
#pragma unroll
                for (int qt = 0; qt < 2; ++qt) {
                    float mx = fmaxf(fmaxf(fmaxf(s[qt][0][0], s[qt][0][1]), fmaxf(s[qt][0][2], s[qt][0][3])), fmaxf(fmaxf(s[qt][1][0], s[qt][1][1]), fmaxf(s[qt][1][2], s[qt][1][3])));
                    mx = xrow16_max(mx) + badd;
                    const float mn = fmaxf(mrun[qt], mx), alpha = __builtin_amdgcn_exp2f(mrun[qt] - mn), coff = badd - mn;
                    const bool grew = __any(mn > mrun[qt]); mrun[qt] = mn;
                    f32x4 p0, p1;
#pragma unroll
                    for (int e = 0; e < 4; ++e) { p0[e] = __builtin_amdgcn_exp2f(s[qt][0][e] + coff); p1[e] = __builtin_amdgcn_exp2f(s[qt][1][e] + coff); }
                    if (grew) {
#pragma unroll
                        for (int dt = 0; dt < 8; ++dt) o[dt][qt] *= alpha;
                        ol[qt] *= alpha; }
                    u32x4 w; w.x = cvt_pk_bf16(p0[0], p0[1]); w.y = cvt_pk_bf16(p0[2], p0[3]); w.z = cvt_pk_bf16(p1[0], p1[1]); w.w = cvt_pk_bf16(p1[2], p1[3]);
                    pf[qt] = __builtin_bit_cast(bf16x8, w);
                }
#pragma unroll
                for (int dt = 0; dt < 8; ++dt)
#pragma unroll
                    for (int qt = 0; qt < 2; ++qt) o[dt][qt] = __builtin_amdgcn_mfma_f32_16x16x32_bf16(vf[dt], pf[qt], o[dt][qt], 0, 0, 0);
#pragma unroll
                for (int qt = 0; qt < 2; ++qt) ol[qt] = __builtin_amdgcn_mfma_f32_16x16x32_bf16(ones, pf[qt], ol[qt], 0, 0, 0);
            }
            asm volatile("s_waitcnt lgkmcnt(0)" ::: "memory");
        }
        slot = slot == 2 ? 0 : slot + 1;
    }
#undef ATTN_DMA
    bf16* Op = MIX + (size_t)(b * T + q0) * D + h * HD;
#pragma unroll
    for (int qt = 0; qt < 2; ++qt) {
        const float inv = 1.0f / ol[qt][0];
        bf16* op = Op + (unsigned)((16 * qt + c) * D + 4 * g);
#pragma unroll
        for (int dt = 0; dt < 8; ++dt) { const f32x4 v = o[dt][qt] * inv; u32x2 w; w.x = cvt_pk_bf16(v[0], v[1]); w.y = cvt_pk_bf16(v[2], v[3]); *(u32x2*)(op + 16 * dt) = w; }
    }
    asm volatile("s_waitcnt vmcnt(0)" ::: "memory");
    __builtin_amdgcn_s_barrier();
    asm volatile("" ::: "memory");
}
__device__ __forceinline__ void attn_phase(const Params& P, LAS unsigned char* lds, int tid, int wave, int lane) {
    LAS float* tab = (LAS float*)(lds + 98304);
    for (int i = tid; i < NH * 257; i += NWAVES * 64) { const int h = i / 257, r = i % 257; tab[h * 260 + r] = P.in[I_RELB][i] * LOG2E; }
    __syncthreads();
    const bf16* Q = (const bf16*)(P.ws + WS_Q); const bf16* K = (const bf16*)(P.ws + WS_K); const bf16* Kc = (const bf16*)(P.ws + WS_KC);
    const bf16* VtP = (const bf16*)(P.ws + WS_VTP); const bf16* VtS = (const bf16*)(P.ws + WS_VTS); bf16* MIX = (bf16*)(P.ws + WS_MIX);
    if (P.sub & 4) for (int u = blockIdx.x; u < NB * NH * 16; u += gridDim.x) {
        const int bh = u & 31, qb = u >> 5;
        attn_block_unit(Q, K, VtP, MIX, bh, qb, tab + (bh & 15) * 260, lds, wave, lane);
    }
    {
        unsigned* ctl = (unsigned*)(P.ws + WS_CTL);
        if (tid == 0) {
            unsigned sp = 0;
            while (__hip_atomic_load(ctl + CW_ARRIVE + 768, __ATOMIC_RELAXED, __HIP_MEMORY_SCOPE_AGENT) < gridDim.x) { __builtin_amdgcn_s_sleep(2);
                if ((++sp & 255u) == 0u) { if (__hip_atomic_load(ctl + CW_TMO2, __ATOMIC_RELAXED, __HIP_MEMORY_SCOPE_AGENT)) break; if (sp > (1u << 20)) { __hip_atomic_store(ctl + CW_TMO2, 1u, __ATOMIC_RELAXED, __HIP_MEMORY_SCOPE_AGENT); break; } } }
            __builtin_amdgcn_fence(__ATOMIC_ACQUIRE, "agent"); VM_WAIT();
        }
        __syncthreads();
    }
    if ((P.sub & 2) && wave == (int)(blockIdx.x & 7)) for (int su = blockIdx.x; su < SB * NH; su += gridDim.x) {
        const int b = su >> 4, h = su & 15; const size_t srow = (size_t)NPR * AW + (size_t)(b * NH + h) * ST * HD;
        attn_unit(Q + srow, Kc + (size_t)(b * NH + h) * CROWS * HD, K + srow, 17, 16, VtS + (size_t)(b * NH + h) * (KS_LD / 32) * HD * 32, 512, tab + h * 260, MIX + (size_t)(NPR + b * ST) * D + h * HD, lane);
    }
}
__device__ __forceinline__ float neg_expm1(float z, float ez) {
    float p = 1.0f + z * (1.0f / 7.0f); p = 1.0f + z * (1.0f / 6.0f) * p; p = 1.0f + z * 0.2f * p; p = 1.0f + z * 0.25f * p; p = 1.0f + z * (1.0f / 3.0f) * p; p = 1.0f + z * 0.5f * p;
    return z > -0.25f ? -z * p : 1.0f - ez;
}
template <int PASS> __device__ __forceinline__ void lru_unit(const Params& P, LAS unsigned char* lds, int unit, int tid, int wave, int lane) {
    int seq, chunk, n;
    if (unit < NB * 64 * 16) { n = unit & 15; chunk = (unit >> 4) & 63; seq = unit >> 10; } else { const int r = unit - NB * 64 * 16; n = r & 15; chunk = 0; seq = NB + (r >> 4); }
    const bool prompt = seq < NB; const int rows = prompt ? 64 : 32; const int m0 = prompt ? seq * T + chunk * 64 : NPR + (seq - NB) * ST;
    LAS float* XF = (LAS float*)lds;
    LAS bf16* XB = (LAS bf16*)(lds + 64 * 132 * 4);
    const float* XR = (const float*)(P.ws + WS_XR);
    const int c = lane & 15, g = lane >> 4, cw = wave * 16 + c, ch = n * 128 + cw;
    bf16x8 ba[4], bx[4];
    {
        const bf16* wp = (const bf16*)(P.ws + WS_WRG) + ((size_t)n * 256 + cw) * 128 + 8 * g;
#pragma unroll
        for (int ks = 0; ks < 4; ++ks) { ba[ks] = *(const bf16x8*)(wp + 32 * ks); bx[ks] = *(const bf16x8*)(wp + 128 * 128 + 32 * ks); }
    }
    const float bra = P.in[I_BRA][ch], brx = P.in[I_BRX][ch], lam = P.in[I_LAM][ch];
    float hin = 0.f;
    if (PASS == 2) {
        if (prompt) {
            const f32x2* ls = (const f32x2*)(P.ws + WS_LSUM) + (size_t)seq * 64 * LW + ch;
            f32x2 sm[16];
#pragma unroll
            for (int i = 0; i < 16; ++i) { const int ci = 16 * g + i; sm[i] = ci < chunk ? ls[(size_t)ci * LW] : (f32x2){1.f, 0.f}; }
            float Ag = 1.f, Hg = 0.f;
#pragma unroll
            for (int i = 0; i < 16; ++i) { Hg = sm[i][0] * Hg + sm[i][1]; Ag *= sm[i][0]; }
#pragma unroll
            for (int q = 0; q < 4; ++q) { const float Aq = __shfl(Ag, c + 16 * q), Hq = __shfl(Hg, c + 16 * q); hin = Aq * hin + Hq; }
        } else hin = P.in[I_SH][(seq - NB) * LW + ch];
    }
    {
        const int t = tid >> 3, cg = (tid & 7) * 16, col = n * 128 + cg;
        const bool live = t < rows;
        f32x4 xv[4][4], wv[4][4], xc[4];
#pragma unroll
        for (int i = 0; i < 4; ++i) { const int tt = t - 3 + i;
            const bool fromx = tt >= 0 || (prompt && chunk > 0), froms = !fromx && !prompt;
            const float* src = froms ? P.in[I_SCONV] + (size_t)((seq - NB) * 3 + 3 + tt) * LW : XR + (size_t)(m0 + ((fromx && live) ? tt : 0)) * LW;
            const float wsc = (live && (fromx || froms)) ? 1.f : 0.f;
#pragma unroll
            for (int q = 0; q < 4; ++q) { xv[i][q] = *(const f32x4*)(src + col + 4 * q); wv[i][q] = *(const f32x4*)(P.in[I_CONVW] + (size_t)i * LW + col + 4 * q) * wsc; } }
#pragma unroll
        for (int q = 0; q < 4; ++q) { xc[q] = live ? *(const f32x4*)(P.in[I_CONVB] + col + 4 * q) : (f32x4){0.f, 0.f, 0.f, 0.f};
#pragma unroll
            for (int i = 0; i < 4; ++i) xc[q] += wv[i][q] * xv[i][q]; }
#pragma unroll
        for (int q = 0; q < 4; ++q) *(LAS f32x4*)(XF + t * 132 + cg + 4 * q) = xc[q];
        u32x4 w0, w1; w0.x = cvt_pk_bf16(xc[0][0], xc[0][1]); w0.y = cvt_pk_bf16(xc[0][2], xc[0][3]); w0.z = cvt_pk_bf16(xc[1][0], xc[1][1]); w0.w = cvt_pk_bf16(xc[1][2], xc[1][3]);
        w1.x = cvt_pk_bf16(xc[2][0], xc[2][1]); w1.y = cvt_pk_bf16(xc[2][2], xc[2][3]); w1.z = cvt_pk_bf16(xc[3][0], xc[3][1]); w1.w = cvt_pk_bf16(xc[3][2], xc[3][3]);
        *(LAS u32x4*)(XB + t * 136 + cg) = w0; *(LAS u32x4*)(XB + t * 136 + cg + 8) = w1;
    }
    __syncthreads();
    f32x4 accA[4], accX[4];
#pragma unroll
    for (int mt = 0; mt < 4; ++mt) { accA[mt] = (f32x4){0.f, 0.f, 0.f, 0.f}; accX[mt] = (f32x4){0.f, 0.f, 0.f, 0.f};
#pragma unroll
        for (int ks = 0; ks < 4; ++ks) { const bf16x8 af = *(const LAS bf16x8*)(XB + (16 * mt + c) * 136 + 32 * ks + 8 * g);
            accA[mt] = __builtin_amdgcn_mfma_f32_16x16x32_bf16(af, ba[ks], accA[mt], 0, 0, 0); accX[mt] = __builtin_amdgcn_mfma_f32_16x16x32_bf16(af, bx[ks], accX[mt], 0, 0, 0); } }
    const float c8 = -8.0f * log1pf(__expf(-lam));
    float av[4][4], bv[4][4];
#pragma unroll
    for (int mt = 0; mt < 4; ++mt)
#pragma unroll
        for (int e = 0; e < 4; ++e) { const float r = fast_sigmoid(accA[mt][e] + bra), ig = fast_sigmoid(accX[mt][e] + brx), la = c8 * r;
            const float a = __builtin_amdgcn_exp2f(la * LOG2E); av[mt][e] = a; bv[mt][e] = __builtin_amdgcn_sqrtf(neg_expm1(2.0f * la, a * a)) * ig * XF[(16 * mt + 4 * g + e) * 132 + cw]; }
    if (PASS == 1) {
        float Am[4], Bm[4];
#pragma unroll
        for (int mt = 0; mt < 4; ++mt) { Am[mt] = av[mt][0] * av[mt][1] * av[mt][2] * av[mt][3]; Bm[mt] = ((bv[mt][0] * av[mt][1] + bv[mt][1]) * av[mt][2] + bv[mt][2]) * av[mt][3] + bv[mt][3]; }
#pragma unroll
        for (int mt = 0; mt < 4; ++mt) { const float Ao = __shfl_xor(Am[mt], 16), Bo = __shfl_xor(Bm[mt], 16);
            const float A1 = (g & 1) ? Ao : Am[mt], B1 = (g & 1) ? Bo : Bm[mt], A2 = (g & 1) ? Am[mt] : Ao, B2 = (g & 1) ? Bm[mt] : Bo; Am[mt] = A1 * A2; Bm[mt] = A2 * B1 + B2; }
#pragma unroll
        for (int mt = 0; mt < 4; ++mt) { const float Ao = __shfl_xor(Am[mt], 32), Bo = __shfl_xor(Bm[mt], 32);
            const float A1 = (g & 2) ? Ao : Am[mt], B1 = (g & 2) ? Bo : Bm[mt], A2 = (g & 2) ? Am[mt] : Ao, B2 = (g & 2) ? Bm[mt] : Bo; Am[mt] = A1 * A2; Bm[mt] = A2 * B1 + B2; }
        float at = Am[0], ht = Bm[0];
#pragma unroll
        for (int mt = 1; mt < 4; ++mt) { ht = Am[mt] * ht + Bm[mt]; at *= Am[mt]; }
        if (g == 0) ((f32x2*)(P.ws + WS_LSUM))[((size_t)seq * 64 + chunk) * LW + ch] = (f32x2){at, ht};
        f32x4* ab = (f32x4*)(P.ws + WS_AB) + ((size_t)unit * 8 + wave) * 512 + lane;
#pragma unroll
        for (int mt = 0; mt < 4; ++mt) { ab[mt * 64] = (f32x4){av[mt][0], av[mt][1], av[mt][2], av[mt][3]}; ab[(4 + mt) * 64] = (f32x4){bv[mt][0], bv[mt][1], bv[mt][2], bv[mt][3]}; }
        __syncthreads();
        return;
    }
    float atot = 1.f;
    const int lastmt = rows / 16 - 1;
#pragma unroll
    for (int mt = 0; mt < 4; ++mt) {
        float A = av[mt][0] * av[mt][1] * av[mt][2] * av[mt][3];
        float B = ((bv[mt][0] * av[mt][1] + bv[mt][1]) * av[mt][2] + bv[mt][2]) * av[mt][3] + bv[mt][3];
        { const float Ap = __shfl_up(A, 16), Bp = __shfl_up(B, 16); if (g >= 1) { B = A * Bp + B; A = A * Ap; } }
        { const float Ap = __shfl_up(A, 32), Bp = __shfl_up(B, 32); if (g >= 2) { B = A * Bp + B; A = A * Ap; } }
        const float hend = A * hin + B;
        const float hprev = __shfl_up(hend, 16);
        if (PASS == 2) {
            float h = g == 0 ? hin : hprev;
#pragma unroll
            for (int e = 0; e < 4; ++e) { h = av[mt][e] * h + bv[mt][e]; XF[(16 * mt + 4 * g + e) * 132 + cw] = h; }
            if (mt == lastmt && g == 3 && (!prompt || chunk == 63)) { if (prompt) P.out[O_HP + (size_t)seq * LW + ch] = h; else P.out[O_HS + (size_t)(seq - NB) * LW + ch] = h; }
        }
        hin = __shfl(hend, c + 48); atot *= __shfl(A, c + 48);
    }
    if (PASS == 1) {
        if (g == 0) ((f32x2*)(P.ws + WS_LSUM))[((size_t)seq * 64 + chunk) * LW + ch] = (f32x2){atot, hin};
        f32x4* ab = (f32x4*)(P.ws + WS_AB) + ((size_t)unit * 8 + wave) * 512 + lane;
#pragma unroll
        for (int mt = 0; mt < 4; ++mt) { ab[mt * 64] = (f32x4){av[mt][0], av[mt][1], av[mt][2], av[mt][3]}; ab[(4 + mt) * 64] = (f32x4){bv[mt][0], bv[mt][1], bv[mt][2], bv[mt][3]}; }
    }
    if (PASS == 2) {
        __syncthreads();
        const int t = tid >> 3, cg = (tid & 7) * 16;
        if (t < rows) {
            const bf16* gp = (const bf16*)(P.ws + WS_GG) + (size_t)(m0 + t) * LW + n * 128 + cg; bf16* op = (bf16*)(P.ws + WS_MIX) + (size_t)(m0 + t) * D + AW + n * 128 + cg;
#pragma unroll
            for (int q = 0; q < 2; ++q) { const u32x4 gw4 = *(const u32x4*)(gp + 8 * q); const f32x4 h0 = *(const LAS f32x4*)(XF + t * 132 + cg + 8 * q), h1 = *(const LAS f32x4*)(XF + t * 132 + cg + 8 * q + 4);
                u32x4 w;
                w.x = cvt_pk_bf16(h0[0] * gelu_tanh(__uint_as_float(gw4.x << 16)), h0[1] * gelu_tanh(__uint_as_float(gw4.x & 0xffff0000u))); w.y = cvt_pk_bf16(h0[2] * gelu_tanh(__uint_as_float(gw4.y << 16)), h0[3] * gelu_tanh(__uint_as_float(gw4.y & 0xffff0000u)));
                w.z = cvt_pk_bf16(h1[0] * gelu_tanh(__uint_as_float(gw4.z << 16)), h1[1] * gelu_tanh(__uint_as_float(gw4.z & 0xffff0000u))); w.w = cvt_pk_bf16(h1[2] * gelu_tanh(__uint_as_float(gw4.w << 16)), h1[3] * gelu_tanh(__uint_as_float(gw4.w & 0xffff0000u)));
                *(u32x4*)(op + 8 * q) = w; }
        }
    }
    __syncthreads();
}

__device__ __forceinline__ void lru_final_wave(const Params& P, int wu, int lane) {
    asm volatile("" : "+v"(lane));
    const int unit = wu >> 3, w = wu & 7, n = unit & 15, chunk = (unit >> 4) & 63, seq = unit >> 10;
    const int c = lane & 15, g = lane >> 4, cw = w * 16 + c, ch = n * 128 + cw, m0 = seq * T + chunk * 64;
    const f32x4* ab = (const f32x4*)(P.ws + WS_AB) + (size_t)wu * 512 + lane;
    f32x4 a4[4], b4[4];
#pragma unroll
    for (int mt = 0; mt < 4; ++mt) { a4[mt] = ab[mt * 64]; b4[mt] = ab[(4 + mt) * 64]; }
    const bf16* gp = (const bf16*)(P.ws + WS_GG) + (size_t)m0 * LW + ch;
    bf16 gg[4][4];
#pragma unroll
    for (int mt = 0; mt < 4; ++mt)
#pragma unroll
        for (int e = 0; e < 4; ++e) gg[mt][e] = gp[(size_t)(16 * mt + 4 * g + e) * LW];
    float hin = 0.f;
    {
        const f32x2* ls = (const f32x2*)(P.ws + WS_LSUM) + (size_t)seq * 64 * LW + ch;
        f32x2 sm[16];
#pragma unroll
        for (int i = 0; i < 16; ++i) { const int ci = 16 * g + i; sm[i] = ci < chunk ? ls[(size_t)ci * LW] : (f32x2){1.f, 0.f}; }
        float Ag = 1.f, Hg = 0.f;
#pragma unroll
        for (int i = 0; i < 16; ++i) { Hg = sm[i][0] * Hg + sm[i][1]; Ag *= sm[i][0]; }
#pragma unroll
        for (int q = 0; q < 4; ++q) { const float Aq = __shfl(Ag, c + 16 * q), Hq = __shfl(Hg, c + 16 * q); hin = Aq * hin + Hq; }
    }
    bf16* op = (bf16*)(P.ws + WS_MIX) + (size_t)m0 * D + AW + ch;
#pragma unroll
    for (int mt = 0; mt < 4; ++mt) {
        float A = a4[mt][0] * a4[mt][1] * a4[mt][2] * a4[mt][3];
        float B = ((b4[mt][0] * a4[mt][1] + b4[mt][1]) * a4[mt][2] + b4[mt][2]) * a4[mt][3] + b4[mt][3];
        { const float Ap = __shfl_up(A, 16), Bp = __shfl_up(B, 16); if (g >= 1) { B = A * Bp + B; A = A * Ap; } }
        { const float Ap = __shfl_up(A, 32), Bp = __shfl_up(B, 32); if (g >= 2) { B = A * Bp + B; A = A * Ap; } }
        const float hend = A * hin + B;
        const float hprev = __shfl_up(hend, 16);
        float h = g == 0 ? hin : hprev;
#pragma unroll
        for (int e = 0; e < 4; ++e) { h = a4[mt][e] * h + b4[mt][e]; op[(size_t)(16 * mt + 4 * g + e) * D] = (bf16)f2bf(h * gelu_tanh(__uint_as_float((unsigned)gg[mt][e] << 16))); }
        if (mt == 3 && g == 3 && chunk == 63) P.out[O_HP + (size_t)seq * LW + ch] = h;
        hin = __shfl(hend, c + 48);
    }
}
#ifndef MK_N_LAUNCHES
#define MK_N_LAUNCHES 1
#endif
constexpr int N_PHASES = 8;
constexpr int LRU1_IN_P2 = 1152;
#ifndef PG8_SP2
#define PG8_SP2 true
#endif
#ifndef PG8_ALIGN
#define PG8_ALIGN true
#endif
#ifdef PROBE_SAME
struct SameOrder { int ntf; __device__ bool next(int i, pg8::Unit& u) const { if (i >= 12) return false; u.pm = PROBE_SAME ? (int)(blockIdx.x & 7) : 0; u.pn = PROBE_SAME ? (int)((blockIdx.x >> 3) & 3) + 4 * (i & 1) : 0; u.kb = 0; u.nt = ntf; u.part = -1; return true; }
    __device__ __forceinline__ void a_ready(const pg8::Unit&) const {} __device__ __forceinline__ void done(const pg8::Unit&) const {} };
#endif
__global__ void __launch_bounds__(NWAVES * 64, 2) fwd(Params P) {
    extern __shared__ __attribute__((aligned(16))) unsigned char lds_raw[];
    LAS unsigned char* lds = (LAS unsigned char*)lds_raw;
    const int tid = threadIdx.x, lane = tid & 63, wave = __builtin_amdgcn_readfirstlane(tid >> 6);
    const int G = gridDim.x, gw = blockIdx.x * NWAVES + wave, NGW = G * NWAVES;
    volatile LAS unsigned* MISC = (volatile LAS unsigned*)(lds + MISC_OFF);
    if (tid < 32) MISC[tid] = 0u;
    __syncthreads();
    unsigned* ctl = (unsigned*)(P.ws + WS_CTL);
    XcdBarrier bar; bar.bar = ctl + CW_BAR; bar.x = 0; bar.st = nullptr;
    if (MK_N_LAUNCHES == 1) bar = xcd_barrier_post(ctl + CW_BAR, MISC + 8);
    const int lo = P.ph_lo, hi = P.ph_hi;
#ifndef PHASE_MASK
#define PHASE_MASK 0xff
#endif
#define IN(k) (((PHASE_MASK >> (k)) & 1) && lo <= (k) && (k) < hi)
#define SEAM(k) do { if (IN(k) && IN((k) + 1)) xcd_barrier(bar); } while (0)
    unsigned char* ws = P.ws;
    float* mod = (float*)(ws + WS_MOD);
    bf16* U = (bf16*)(ws + WS_U);

#ifdef PROBE_NT
    if (lo == 9) {
        pg8::Gemm g{U, (const bf16*)(ws + WS_WGU), NTOK, 2 * DFF, D};
#ifdef PROBE_SAME
        SameOrder S; S.ntf = PROBE_NT;
        EpiGlu<0> E{(bf16*)(ws + WS_END), 1.0f, nullptr, nullptr};
#ifndef PROBE_VAR
#define PROBE_VAR 0
#endif
        pg8::gemm_phase<EpiGlu<0>, SameOrder, PG8_ALIGN, PG8_SP2, PROBE_VAR>(lds, g, S, E);
#else
        pg8::StaticOrder S; S.init(NTOK, 2 * DFF, D, G, (int)blockIdx.x); S.ntf = PROBE_NT;
        EpiGlu<0> E{(bf16*)(ws + WS_END), 1.0f, nullptr, nullptr};
        pg8::gemm_phase<EpiGlu<0>, pg8::StaticOrder, PG8_ALIGN, PG8_SP2>(lds, g, S, E);
#endif
    }
#endif
    if (IN(0)) {
#if P0_MALL
        for (int up = 0; up < 2; ++up) { p0_amax_gu(P, gw, NGW, lane, up); xcd_barrier(bar); p0_conv_gu(P, lds, gw, NGW, wave, lane, up); }
        p0_amax_win(P, gw, NGW, lane); xcd_barrier(bar); p0_conv_win8(P, lds, gw, NGW, wave, lane);
#else
        p0_amax_gu(P, gw, NGW, lane, 0); p0_amax_gu(P, gw, NGW, lane, 1); p0_amax_win(P, gw, NGW, lane);
        VM_WAIT(); __syncthreads();
        if (tid == 0) { __builtin_amdgcn_fence(__ATOMIC_RELEASE, "agent"); VM_WAIT(); __hip_atomic_fetch_add(ctl + CW_ARRIVE + 896, 1u, __ATOMIC_RELAXED, __HIP_MEMORY_SCOPE_AGENT); }
#endif
        if (P.sub & 16) p0_mod(P, lds, tid, wave, lane);
        VM_WAIT(); __syncthreads();
        if (tid == 0) { __builtin_amdgcn_fence(__ATOMIC_RELEASE, "agent"); VM_WAIT(); __hip_atomic_fetch_add(ctl + CW_ARRIVE + 512, 1u, __ATOMIC_RELAXED, __HIP_MEMORY_SCOPE_AGENT); }
        if (P.sub & 32) p0_convert(P, lds, gw, NGW, wave, lane);
    }
    if (IN(1)) {
        if (tid == 0) {
            unsigned sp = 0;
            while (__hip_atomic_load(ctl + CW_ARRIVE + 512, __ATOMIC_RELAXED, __HIP_MEMORY_SCOPE_AGENT) < (unsigned)G) { __builtin_amdgcn_s_sleep(2);
                if ((++sp & 255u) == 0u) { if (__hip_atomic_load(ctl + CW_TMO2, __ATOMIC_RELAXED, __HIP_MEMORY_SCOPE_AGENT)) break; if (sp > (1u << 20)) { __hip_atomic_store(ctl + CW_TMO2, 1u, __ATOMIC_RELAXED, __HIP_MEMORY_SCOPE_AGENT); break; } } }
            __builtin_amdgcn_fence(__ATOMIC_ACQUIRE, "agent"); VM_WAIT();
        }
        __syncthreads();
        norm_sample_split<false, 3>(P, lds, P.in[I_XS], P.in[I_G1], mod, 0 * D, 1 * D, U, nullptr, nullptr, wave, lane, (float*)(ws + WS_CTL + WS_SU1), ws + WS_U8);
        norm_rows<false, 3>(P.in[I_XP], P.in[I_XS], P.in[I_G1], mod, 0 * D, 1 * D, U, nullptr, nullptr, NPR, gw, NGW, lane, (float*)(ws + WS_CTL + WS_SU1), ws + WS_U8);
    }
    SEAM(1);
    if (IN(2)) {
        pg8::Gemm g{U, (const bf16*)(ws + WS_WIN), NTOK, INC, D};
        EpiIn<0> E{(bf16*)(ws + WS_Q), (bf16*)(ws + WS_K), (bf16*)(ws + WS_VTP), (bf16*)(ws + WS_VTS), (float*)(ws + WS_XR), (bf16*)(ws + WS_GG), P.out, P.in[I_QG], P.in[I_KG], (LAS float*)(lds + XCH_OFF), nullptr, nullptr};
        { XrOrder S; S.init(G, (int)blockIdx.x); pg8::gemm_phase<EpiIn<0>, XrOrder, PG8_ALIGN, PG8_SP2>(lds, g, S, E); }
        VM_WAIT(); __syncthreads();
        if (tid == 0) { __builtin_amdgcn_fence(__ATOMIC_RELEASE, "agent"); VM_WAIT(); __hip_atomic_fetch_add(ctl + CW_ARRIVE, 1u, __ATOMIC_RELAXED, __HIP_MEMORY_SCOPE_AGENT); }
        { B2Order S; S.init(G, (int)blockIdx.x); pg8::gemm_phase<EpiIn<0>, B2Order, PG8_ALIGN, PG8_SP2>(lds, g, S, E); }
        if (tid == 0) {
            unsigned sp = 0;
            while (__hip_atomic_load(ctl + CW_ARRIVE, __ATOMIC_RELAXED, __HIP_MEMORY_SCOPE_AGENT) < (unsigned)G) { __builtin_amdgcn_s_sleep(2);
                if ((++sp & 255u) == 0u) { if (__hip_atomic_load(ctl + CW_TMO2, __ATOMIC_RELAXED, __HIP_MEMORY_SCOPE_AGENT)) break; if (sp > (1u << 20)) { __hip_atomic_store(ctl + CW_TMO2, 1u, __ATOMIC_RELAXED, __HIP_MEMORY_SCOPE_AGENT); break; } } }
            __builtin_amdgcn_fence(__ATOMIC_ACQUIRE, "agent"); VM_WAIT();
        }
        __syncthreads();
        if (P.sub & 1) {
            unsigned nextu = 0; if (tid == 0) nextu = __hip_atomic_fetch_add(ctl + CW_LQ, 1u, __ATOMIC_RELAXED, __HIP_MEMORY_SCOPE_AGENT);
            for (;;) {
                if (tid == 0) MISC[16] = nextu;
                __syncthreads();
                const int u = (int)MISC[16];
                if (u >= LRU1_IN_P2) break;
                if (tid == 0) nextu = __hip_atomic_fetch_add(ctl + CW_LQ, 1u, __ATOMIC_RELAXED, __HIP_MEMORY_SCOPE_AGENT);
                lru_unit<1>(P, lds, u, tid, wave, lane);
            }
        }
        { pg8::Gemm g8{(const bf16*)(ws + WS_U8), (const bf16*)(ws + WS_WIN8), NTOK, INC, D / 2}; I8Order S8; S8.init(G, (int)blockIdx.x);
          EpiIn<2> E8{(bf16*)(ws + WS_Q), (bf16*)(ws + WS_K), (bf16*)(ws + WS_VTP), (bf16*)(ws + WS_VTS), (float*)(ws + WS_XR), (bf16*)(ws + WS_GG), P.out, P.in[I_QG], P.in[I_KG], (LAS float*)(lds + XCH_OFF),
                      (const float*)(ws + WS_CTL + WS_SU1), (const float*)(ws + WS_CTL + WS_AMAX1)};
          pg8::gemm_phase<EpiIn<2>, I8Order, PG8_ALIGN, PG8_SP2, 0, 2>(lds, g8, S8, E8); }
    }
    SEAM(2);
    if (IN(3)) {
        if (P.sub & 1) for (int u = LRU1_IN_P2 + (int)blockIdx.x; u < NB * 64 * 16; u += G) lru_unit<1>(P, lds, u, tid, wave, lane);
        VM_WAIT(); __syncthreads();
        if (tid == 0) { __builtin_amdgcn_fence(__ATOMIC_RELEASE, "agent"); VM_WAIT(); __hip_atomic_fetch_add(ctl + CW_ARRIVE + 768, 1u, __ATOMIC_RELAXED, __HIP_MEMORY_SCOPE_AGENT); }
        attn_phase(P, lds, tid, wave, lane);
        if (P.sub & 8) {
            constexpr int NWU = NB * 64 * 16 * 8; const int per = (NWU + G - 1) / G, w0 = (int)blockIdx.x * per, w1 = w0 + per < NWU ? w0 + per : NWU;
            for (;;) {
                int idx = 0; if (lane == 0) idx = (int)__hip_atomic_fetch_add((LAS unsigned*)(lds + MISC_OFF) + 17, 1u, __ATOMIC_RELAXED, __HIP_MEMORY_SCOPE_WORKGROUP);
                idx = __builtin_amdgcn_readfirstlane(idx);
                if (w0 + idx >= w1) break;
                lru_final_wave(P, w0 + idx, lane);
            }
        }
        __syncthreads();
        if (P.sub & 8) for (int u = NB * 64 * 16 + blockIdx.x; u < NB * 64 * 16 + SB * 16; u += G) lru_unit<2>(P, lds, u, tid, wave, lane);
    }
    SEAM(3);
    if (IN(4)) {
        pg8::Gemm g{(const bf16*)(ws + WS_MIX), (const bf16*)(ws + WS_WOUT), NTOK, D, D}; SplitOrder S; S.init(D, G, (int)blockIdx.x);
        EpiRes<false, true> E{P.in[I_XP], ws + WS_X1, mod + 2 * D, (float*)(ws + WS_SLAB), (P.sub >> 6) & 1, 1.0f};
        pg8::gemm_phase<EpiRes<false, true>, SplitOrder, PG8_ALIGN, PG8_SP2>(lds, g, S, E);
    }
    SEAM(4);
    if (IN(5)) {
        norm_sample_split<true, 2>(P, lds, P.in[I_XS], P.in[I_G2], mod, 3 * D, 4 * D, U, (const float*)(ws + WS_SLAB), (float*)(ws + WS_X1) + (size_t)NPR * D, wave, lane, (float*)(ws + WS_CTL + WS_SU));
        norm_rows<true, 2>((const float*)(ws + WS_X1), P.in[I_XS], P.in[I_G2], mod, 3 * D, 4 * D, U, nullptr, nullptr, NPR, gw, NGW, lane, (float*)(ws + WS_CTL + WS_SU));
    }
    SEAM(5);
    if (IN(6)) {
        pg8::Gemm g{U, (const bf16*)(ws + WS_WGU), NTOK, 2 * DFF, D / 2}; GluOrder S; S.init(D / 2, G, (int)blockIdx.x); S.mode = 1;
        EpiGlu<2> E{(bf16*)(ws + WS_H), 1.0f, (const float*)(ws + WS_CTL + WS_SU), (const float*)(ws + WS_CTL + WS_AMAX)};
        pg8::gemm_phase<EpiGlu<2>, GluOrder, PG8_ALIGN, PG8_SP2, 0, 2>(lds, g, S, E);
        VM_WAIT(); __syncthreads();
        if (tid == 0) { __builtin_amdgcn_fence(__ATOMIC_RELEASE, "agent"); VM_WAIT(); __hip_atomic_fetch_add(ctl + CW_ARRIVE + 256, 1u, __ATOMIC_RELAXED, __HIP_MEMORY_SCOPE_AGENT); }
        S.mode = 0;
        pg8::gemm_phase<EpiGlu<2>, GluOrder, PG8_ALIGN, PG8_SP2, 0, 2>(lds, g, S, E);
        if (tid == 0) {
            unsigned sp = 0;
            while (__hip_atomic_load(ctl + CW_ARRIVE + 256, __ATOMIC_RELAXED, __HIP_MEMORY_SCOPE_AGENT) < (unsigned)G) { __builtin_amdgcn_s_sleep(2);
                if ((++sp & 255u) == 0u) { if (__hip_atomic_load(ctl + CW_TMO2, __ATOMIC_RELAXED, __HIP_MEMORY_SCOPE_AGENT)) break; if (sp > (1u << 20)) { __hip_atomic_store(ctl + CW_TMO2, 1u, __ATOMIC_RELAXED, __HIP_MEMORY_SCOPE_AGENT); break; } } }
            __builtin_amdgcn_fence(__ATOMIC_ACQUIRE, "agent"); VM_WAIT();
        }
        __syncthreads();
        constexpr int KD = F8_DOWN ? DFF / 2 : DFF;
        pg8::Gemm g2{(const bf16*)(ws + WS_H), (const bf16*)(ws + WS_WD), NTOK, D, KD}; TailSplit S2; S2.init(KD, G, (int)blockIdx.x);
        EpiRes<true, false> E2{ws + WS_X1, P.out + O_Y, mod + 5 * D, (float*)(ws + WS_SLAB), 0, F8_DOWN ? W8_INV : 1.0f};
        pg8::gemm_phase<EpiRes<true, false>, TailSplit, PG8_ALIGN, PG8_SP2, 0, F8_DOWN ? 1 : 0>(lds, g2, S2, E2);
    }
    SEAM(6);
    if (IN(7)) {
        {
            const float* slab = (const float*)(ws + WS_SLAB); const float* x1s = (const float*)(ws + WS_X1) + (size_t)NPR * D; float* ys = P.out + O_Y + (size_t)NPR * D;
            for (int t = gw; t < NSA * 4; t += NGW) {
                const int r = t >> 2, col0 = 1024 * (t & 3);
                f32x4 v[4];
#pragma unroll
                for (int j = 0; j < 4; ++j) v[j] = *(const f32x4*)(x1s + (size_t)r * D + col0 + 4 * (lane + 64 * j));
#pragma unroll
                for (int q = 0; q < 8; ++q)
#pragma unroll
                    for (int j = 0; j < 4; ++j) v[j] += *(const f32x4*)(slab + ((size_t)q * NSA + r) * D + col0 + 4 * (lane + 64 * j));
#pragma unroll
                for (int j = 0; j < 4; ++j) *(f32x4*)(ys + (size_t)r * D + col0 + 4 * (lane + 64 * j)) = v[j];
            }
        }
        constexpr int KD = F8_DOWN ? DFF / 2 : DFF;
        pg8::Gemm g{(const bf16*)(ws + WS_H), (const bf16*)(ws + WS_WD), NTOK, D, KD}; pg8::StaticOrder S; S.init(NPR, D, KD, G, (int)blockIdx.x);
        EpiRes<true, false> E{ws + WS_X1, P.out + O_Y, mod + 5 * D, (float*)(ws + WS_SLAB), (P.sub >> 6) & 1, F8_DOWN ? W8_INV : 1.0f};
        pg8::gemm_phase<EpiRes<true, false>, pg8::StaticOrder, PG8_ALIGN, PG8_SP2, 0, F8_DOWN ? 1 : 0>(lds, g, S, E);
    }
#undef IN
#undef SEAM
}

extern "C" void kernel_launch(void* const* d_in, const int* in_sizes, int n_in, void* d_out, int out_size, void* d_ws, size_t ws_size, hipStream_t stream) {
    static int grid = 0;
    if (grid == 0) {
        if (n_in != 27 || in_sizes[0] != NPR * D || out_size != (int)O_END || ws_size < WS_END2) {
            fprintf(stderr, "kernel_launch: built for 27 inputs, x_prompt of %d floats, %zu outputs, >= %zu bytes of workspace; got n_in %d, in0 %d, out %d, ws %zu; nothing launched\n", NPR * D, (size_t)O_END, (size_t)WS_END2, n_in, n_in > 0 ? in_sizes[0] : -1, out_size, ws_size);
            grid = -1; return; }
        int dev = 0, cus = 0, per_cu = 0;
        if (hipGetDevice(&dev) != hipSuccess || hipDeviceGetAttribute(&cus, hipDeviceAttributeMultiprocessorCount, dev) != hipSuccess) { fprintf(stderr, "kernel_launch: device query failed\n"); grid = -1; return; }
        if (hipFuncSetAttribute((const void*)fwd, hipFuncAttributeMaxDynamicSharedMemorySize, LDS_BYTES) != hipSuccess) { fprintf(stderr, "kernel_launch: hipFuncSetAttribute failed\n"); grid = -1; return; }
        if (hipOccupancyMaxActiveBlocksPerMultiprocessor(&per_cu, (const void*)fwd, NWAVES * 64, LDS_BYTES) != hipSuccess || per_cu < 1)
            fprintf(stderr, "kernel_launch: note: occupancy query reports %d workgroups per CU\n", per_cu);
        (void)hipGetLastError();
        grid = cus;
    }
    if (grid < 0) return;
    if (hipMemsetAsync((char*)d_ws + WS_CTL, 0, CTL_ZERO_BYTES, stream) != hipSuccess) { fprintf(stderr, "kernel_launch: hipMemsetAsync failed\n"); return; }
    Params p{};
    for (int i = 0; i < 27; ++i) p.in[i] = (const float*)d_in[i];
    p.out = (float*)d_out; p.ws = (unsigned char*)d_ws; p.sub = 63;
#ifdef PROBE_PREFIX
    p.ph_lo = 0; p.ph_hi = PROBE_PREFIX;
#ifdef PROBE_SUB
    p.sub = PROBE_SUB;
#endif
    hipLaunchKernelGGL(fwd, dim3(grid), dim3(NWAVES * 64), LDS_BYTES, stream, p);
    (void)hipMemsetAsync((char*)d_ws + WS_CTL, 0, CTL_ZERO_BYTES, stream);
    p.sub = 63;
#endif
    for (int li = 0; li < MK_N_LAUNCHES; ++li) {
        p.ph_lo = (MK_N_LAUNCHES == 1) ? 0 : li; p.ph_hi = (MK_N_LAUNCHES == 1) ? N_PHASES : li + 1;
        hipLaunchKernelGGL(fwd, dim3(grid), dim3(NWAVES * 64), LDS_BYTES, stream, p);
        const hipError_t le = hipPeekAtLastError();
        if (le != hipSuccess) { fprintf(stderr, "kernel_launch: launch %d failed: %s\n", li, hipGetErrorName(le)); break; }
    }
#ifdef PROBE_PHASE
    p.ph_lo = PROBE_PHASE; p.ph_hi = PROBE_PHASE + 1;
#ifdef PROBE_SUB
    p.sub = PROBE_SUB;
#endif
    hipLaunchKernelGGL(fwd, dim3(grid), dim3(NWAVES * 64), LDS_BYTES, stream, p);
#endif
}
```
